# Optimizing an MI355X kernel written in HIP

```python
import jax, jax.numpy as jnp
from jax import lax
import numpy as np

D_MODEL = 2048
BATCH = 8
SEQ = 2048
DEPTH = 2

GRID_W = 64
CTX_LEN = 256
HEAD_DIM = 128
NA_HEADS = 8
NA_WIN_H = 8
NA_WIN_W = 16
GQA_HEADS = 8
GQA_KV_HEADS = 2
MLA_HEADS = 8
MLA_Q_RANK = 512
MLA_KV_RANK = 512
MLA_NOPE = 128
MLA_ROPE = 64
MLA_V = 128
A_W = NA_HEADS * HEAD_DIM
B_QW = GQA_HEADS * HEAD_DIM
B_KVW = GQA_KV_HEADS * HEAD_DIM
C_W = MLA_HEADS * MLA_V
D_FF = -(-8 * D_MODEL // (3 * 256)) * 256
IN_SIZES = (A_W, A_W, A_W, B_QW, B_KVW, B_KVW, MLA_Q_RANK, MLA_KV_RANK, MLA_ROPE, D_MODEL, D_MODEL, D_MODEL)
IN_WIDTH = sum(IN_SIZES)
ROPE_THETA = 10000.0
Q_BLOCK = 128
EPS = 1e-6
NEG_INF = -1e30

kernel_name = 'hybrid_natten_gqa_mla_prefix_dit'


def _rms_norm(x, g):
    xf = x.astype(jnp.float32)
    y = xf * lax.rsqrt(jnp.mean(xf * xf, axis=-1, keepdims=True) + EPS)
    return (y * g.astype(jnp.float32)).astype(x.dtype)


def _rope_1d(x, pos):
    d = x.shape[-1]
    freqs = ROPE_THETA ** (-jnp.arange(0, d, 2, dtype=jnp.float32) / d)
    ang = pos.astype(jnp.float32)[:, None] * freqs[None, :]
    cos, sin = jnp.cos(ang), jnp.sin(ang)
    xf = x.astype(jnp.float32)
    x1, x2 = xf[..., : d // 2], xf[..., d // 2:]
    return jnp.concatenate([x1 * cos - x2 * sin, x2 * cos + x1 * sin], axis=-1).astype(x.dtype)


def _rope_2d(x, row, col):
    half = x.shape[-1] // 2
    return jnp.concatenate([_rope_1d(x[..., :half], row), _rope_1d(x[..., half:], col)], axis=-1)


def _heads(z, n):
    b, t, _ = z.shape
    return z.reshape(b, t, n, -1).transpose(0, 2, 1, 3)


def _merge_heads(o):
    b, h, t, d = o.shape
    return o.transpose(0, 2, 1, 3).reshape(b, t, h * d)


def _project_in(h, w_in):
    z = jnp.einsum('btd,de->bte', h, w_in)
    return jnp.split(z, np.cumsum(IN_SIZES)[:-1].tolist(), axis=-1)


def _attend(q, k, v, scale):
    s = jnp.einsum('bhgqd,bhkd->bhgqk', q, k, preferred_element_type=jnp.float32) * scale
    p = jax.nn.softmax(s, axis=-1).astype(v.dtype)
    return jnp.einsum('bhgqk,bhkd->bhgqd', p, v)


def _blocked_attention(q, k, v, k_ctx, v_ctx, scale):
    b, hk, g, s, d = q.shape
    nb = s // Q_BLOCK
    k_all = jnp.concatenate([k, k_ctx], axis=2)
    v_all = jnp.concatenate([v, v_ctx], axis=2)
    qb = jnp.moveaxis(q.reshape(b, hk, g, nb, Q_BLOCK, d), 3, 0)
    o = lax.map(lambda qi: _attend(qi, k_all, v_all, scale), qb)
    return jnp.moveaxis(o, 0, 3).reshape(b, hk, g, s, v.shape[-1])


def _neighborhood_attention(q, k, v, k_ctx, v_ctx, rpb):
    b, h, s, d = q.shape
    rows = s // GRID_W
    kh, kw = min(NA_WIN_H, rows), NA_WIN_W
    scale = d ** -0.5
    qg = q.reshape(b, h, rows, GRID_W, d)
    kg = k.reshape(b, h, rows, GRID_W, d)
    vg = v.reshape(b, h, rows, GRID_W, d)
    qc = np.arange(GRID_W)
    c0 = np.clip(qc - kw // 2, 0, GRID_W - kw)
    in_win = (qc[None, :] >= c0[:, None]) & (qc[None, :] < c0[:, None] + kw)
    col_mask = jnp.where(jnp.asarray(in_win), 0.0, NEG_INF)[:, None, :]
    dc_idx = np.clip(qc[None, :] - qc[:, None], -(kw - 1), kw - 1) + (NA_WIN_W - 1)

    def row_block(r):
        r0 = jnp.clip(r - kh // 2, 0, rows - kh)
        q_r = lax.dynamic_index_in_dim(qg, r, axis=2, keepdims=False)
        k_b = lax.dynamic_slice_in_dim(kg, r0, kh, axis=2)
        v_b = lax.dynamic_slice_in_dim(vg, r0, kh, axis=2)
        dr_idx = r0 + jnp.arange(kh) - r + (NA_WIN_H - 1)
        bias = rpb[:, dr_idx[None, :, None], dc_idx[:, None, :]]
        s_win = jnp.einsum('bhqd,bhiwd->bhqiw', q_r, k_b, preferred_element_type=jnp.float32) * scale + bias + col_mask
        s_ctx = jnp.einsum('bhqd,bhcd->bhqc', q_r, k_ctx, preferred_element_type=jnp.float32) * scale
        s_all = jnp.concatenate([s_win.reshape(b, h, GRID_W, kh * GRID_W), s_ctx], axis=-1)
        p = jax.nn.softmax(s_all, axis=-1).astype(v.dtype)
        p_win = p[..., : kh * GRID_W].reshape(b, h, GRID_W, kh, GRID_W)
        p_ctx = p[..., kh * GRID_W:]
        return (jnp.einsum('bhqiw,bhiwd->bhqd', p_win, v_b)
                + jnp.einsum('bhqc,bhcd->bhqd', p_ctx, v_ctx))

    o = lax.map(row_block, jnp.arange(rows))
    return jnp.moveaxis(o, 0, 2).reshape(b, h, s, d)


def _gqa_qkv(bq, bk, bv, q_norm, k_norm, row, col):
    q = _rms_norm(_heads(bq, GQA_HEADS), q_norm)
    k = _rms_norm(_heads(bk, GQA_KV_HEADS), k_norm)
    v = _heads(bv, GQA_KV_HEADS)
    if row is not None:
        q, k = _rope_2d(q, row, col), _rope_2d(k, row, col)
    b, hq, t, d = q.shape
    return q.reshape(b, GQA_KV_HEADS, hq // GQA_KV_HEADS, t, d), k, v


def _mla_qkv(cq, ckv, ckr, q_norm, kv_norm, w_uq, w_ukv, row, col):
    q = _heads(jnp.einsum('btr,re->bte', _rms_norm(cq, q_norm), w_uq), MLA_HEADS)
    kv = _heads(jnp.einsum('btr,re->bte', _rms_norm(ckv, kv_norm), w_ukv), MLA_HEADS)
    q_nope, q_rope = q[..., :MLA_NOPE], q[..., MLA_NOPE:]
    k_nope, v = kv[..., :MLA_NOPE], kv[..., MLA_NOPE:]
    k_rope = ckr[:, None]
    if row is not None:
        q_rope, k_rope = _rope_2d(q_rope, row, col), _rope_2d(k_rope, row, col)
    k_rope = jnp.broadcast_to(k_rope, k_nope.shape[:-1] + (MLA_ROPE,))
    q = jnp.concatenate([q_nope, q_rope], axis=-1)[:, :, None]
    k = jnp.concatenate([k_nope, k_rope], axis=-1)
    return q, k, v


def _merge(o_a, o_b, o_c, ga, gb, gc, w_br_a, w_br_b, w_br_c, w_o):
    def branch(o, w):
        return jnp.einsum('bte,ed->btd', _merge_heads(o), w)
    y = (jax.nn.sigmoid(ga) * branch(o_a, w_br_a)
         + jax.nn.sigmoid(gb) * branch(o_b, w_br_b)
         + jax.nn.sigmoid(gc) * branch(o_c, w_br_c))
    return jnp.einsum('btd,de->bte', y, w_o)


def _token_mixer(h, hc, w_in, rpb, gqa_qn, gqa_kn, mla_qn, mla_kvn, w_uq, w_ukv,
                 w_br_a, w_br_b, w_br_c, w_o, row, col, ctx_out):
    aq, ak, av, bq, bk, bv, cq, ckv, ckr, ga, gb, gc = _project_in(h, w_in)
    aq_c, ak_c, av_c, bq_c, bk_c, bv_c, cq_c, ckv_c, ckr_c, ga_c, gb_c, gc_c = _project_in(hc, w_in)
    ka_c, va_c = _heads(ak_c, NA_HEADS), _heads(av_c, NA_HEADS)
    o_a = _neighborhood_attention(_heads(aq, NA_HEADS), _heads(ak, NA_HEADS), _heads(av, NA_HEADS), ka_c, va_c, rpb)
    qb, kb, vb = _gqa_qkv(bq, bk, bv, gqa_qn, gqa_kn, row, col)
    qb_c, kb_c, vb_c = _gqa_qkv(bq_c, bk_c, bv_c, gqa_qn, gqa_kn, None, None)
    scale_b = HEAD_DIM ** -0.5
    o_b = _blocked_attention(qb, kb, vb, kb_c, vb_c, scale_b)
    o_b = o_b.reshape(o_b.shape[0], GQA_HEADS, o_b.shape[3], HEAD_DIM)
    qc, kc, vc = _mla_qkv(cq, ckv, ckr, mla_qn, mla_kvn, w_uq, w_ukv, row, col)
    qc_c, kc_c, vc_c = _mla_qkv(cq_c, ckv_c, ckr_c, mla_qn, mla_kvn, w_uq, w_ukv, None, None)
    scale_c = (MLA_NOPE + MLA_ROPE) ** -0.5
    o_c = _blocked_attention(qc, kc, vc, kc_c, vc_c, scale_c)[:, :, 0]
    y = _merge(o_a, o_b, o_c, ga, gb, gc, w_br_a, w_br_b, w_br_c, w_o)
    if not ctx_out:
        return y, None
    o_a_c = _attend(_heads(aq_c, NA_HEADS)[:, :, None], ka_c, va_c, HEAD_DIM ** -0.5)[:, :, 0]
    o_b_c = _attend(qb_c, kb_c, vb_c, scale_b)
    o_b_c = o_b_c.reshape(o_b_c.shape[0], GQA_HEADS, o_b_c.shape[3], HEAD_DIM)
    o_c_c = _attend(qc_c, kc_c, vc_c, scale_c)[:, :, 0]
    yc = _merge(o_a_c, o_b_c, o_c_c, ga_c, gb_c, gc_c, w_br_a, w_br_b, w_br_c, w_o)
    return y, yc


def _swiglu(h, w1, w3, w2):
    a = jnp.einsum('btd,df->btf', h, w1)
    g = jnp.einsum('btd,df->btf', h, w3)
    return jnp.einsum('btf,fd->btd', jax.nn.silu(a) * g, w2)


def setup_inputs(seed: int = 0) -> dict:
    key = jax.random.key(seed)
    ks = jax.random.split(key, 25)
    L, D = DEPTH, D_MODEL

    def nrm(k, shape, std):
        return jax.random.normal(k, shape, jnp.float32) * std

    def gain(k, shape):
        return 1.0 + 0.1 * jax.random.normal(k, shape, jnp.float32)

    return {
        'x': nrm(ks[0], (BATCH, SEQ, D), 1.0),
        'c': nrm(ks[1], (BATCH, D), 1.0),
        'ctx': nrm(ks[2], (BATCH, CTX_LEN, D), 1.0),
        'c_ctx': nrm(ks[3], (D,), 1.0),
        'w_ada': nrm(ks[4], (L, D, 6 * D), 0.5 * D ** -0.5),
        'b_ada': nrm(ks[5], (L, 6 * D), 0.01),
        'g_pre1': gain(ks[6], (L, D)),
        'g_post1': gain(ks[7], (L, D)),
        'g_pre2': gain(ks[8], (L, D)),
        'g_post2': gain(ks[9], (L, D)),
        'w_in': nrm(ks[10], (L, D, IN_WIDTH), D ** -0.5),
        'rpb': nrm(ks[11], (L, NA_HEADS, 2 * NA_WIN_H - 1, 2 * NA_WIN_W - 1), 0.5),
        'gqa_q_norm': gain(ks[12], (L, HEAD_DIM)),
        'gqa_k_norm': gain(ks[13], (L, HEAD_DIM)),
        'mla_q_norm': gain(ks[14], (L, MLA_Q_RANK)),
        'mla_kv_norm': gain(ks[15], (L, MLA_KV_RANK)),
        'w_uq': nrm(ks[16], (L, MLA_Q_RANK, MLA_HEADS * (MLA_NOPE + MLA_ROPE)), MLA_Q_RANK ** -0.5),
        'w_ukv': nrm(ks[17], (L, MLA_KV_RANK, MLA_HEADS * (MLA_NOPE + MLA_V)), MLA_KV_RANK ** -0.5),
        'w_br_a': nrm(ks[18], (L, A_W, D), A_W ** -0.5),
        'w_br_b': nrm(ks[19], (L, B_QW, D), B_QW ** -0.5),
        'w_br_c': nrm(ks[20], (L, C_W, D), C_W ** -0.5),
        'w_o': nrm(ks[21], (L, D, D), D ** -0.5),
        'w_ff1': nrm(ks[22], (L, D, D_FF), D ** -0.5),
        'w_ff3': nrm(ks[23], (L, D, D_FF), D ** -0.5),
        'w_ff2': nrm(ks[24], (L, D_FF, D), D_FF ** -0.5),
    }


def reference(x, c, ctx, c_ctx, w_ada, b_ada, g_pre1, g_post1, g_pre2, g_post2, w_in, rpb,
              gqa_q_norm, gqa_k_norm, mla_q_norm, mla_kv_norm, w_uq, w_ukv,
              w_br_a, w_br_b, w_br_c, w_o, w_ff1, w_ff3, w_ff2):
    seq = x.shape[1]
    t = jnp.arange(seq)
    row, col = t // GRID_W, t % GRID_W
    cx = ctx
    silu_c = jax.nn.silu(c)
    silu_cc = jax.nn.silu(c_ctx)
    for l in range(DEPTH):
        ctx_out = l < DEPTH - 1
        mod = jnp.einsum('bd,de->be', silu_c, w_ada[l]) + b_ada[l]
        sh1, sc1, gt1, sh2, sc2, gt2 = [m[:, None, :] for m in jnp.split(mod, 6, axis=-1)]
        mod_c = jnp.einsum('d,de->e', silu_cc, w_ada[l]) + b_ada[l]
        sh1c, sc1c, gt1c, sh2c, sc2c, gt2c = jnp.split(mod_c, 6, axis=-1)
        h = _rms_norm(x, g_pre1[l]) * (1.0 + sc1) + sh1
        hc = _rms_norm(cx, g_pre1[l]) * (1.0 + sc1c) + sh1c
        y, yc = _token_mixer(h, hc, w_in[l], rpb[l], gqa_q_norm[l], gqa_k_norm[l], mla_q_norm[l], mla_kv_norm[l],
                             w_uq[l], w_ukv[l], w_br_a[l], w_br_b[l], w_br_c[l], w_o[l], row, col, ctx_out)
        x = x + gt1 * _rms_norm(y, g_post1[l])
        h2 = _rms_norm(x, g_pre2[l]) * (1.0 + sc2) + sh2
        x = x + gt2 * _rms_norm(_swiglu(h2, w_ff1[l], w_ff3[l], w_ff2[l]), g_post2[l])
        if ctx_out:
            cx = cx + gt1c * _rms_norm(yc, g_post1[l])
            h2c = _rms_norm(cx, g_pre2[l]) * (1.0 + sc2c) + sh2c
            cx = cx + gt2c * _rms_norm(_swiglu(h2c, w_ff1[l], w_ff3[l], w_ff2[l]), g_post2[l])
    return x
```

```cpp
#include <hip/hip_runtime.h>
#include <hip/hip_cooperative_groups.h>
#include <cstdio>
#include <cstdint>
namespace cg = cooperative_groups;

constexpr int DM = 2048, NB = 8, SEQ = 2048, CTXL = 256, NLAT = NB * SEQ, NCTX = NB * CTXL, MTOT = NLAT + NCTX;
constexpr int INW = 11840, LDZ = 11840, NZP = 12032, DFF = 5632, LDO = 3072, LDQC = 1536, LDKVC = 2112;
constexpr int MODW = 6 * DM;
constexpr float EPS = 1e-6f;
constexpr int ZC_AQ = 0, ZC_AK = 1024, ZC_AV = 2048, ZC_BQ = 3072, ZC_GA = 4096, ZC_BK = 10240, ZC_BV = 10496, ZC_CQ = 10752, ZC_CKV = 11264, ZC_CKR = 11776;
constexpr size_t WS_MOD = 0;
constexpr size_t WS_BAR = 901120;
constexpr size_t WS_CX = 1u << 20;
constexpr size_t WS_WIN = WS_CX + (size_t)NCTX * DM * 4;
constexpr size_t WS_WUQ = WS_WIN + (size_t)NZP * DM * 2;
constexpr size_t WS_WUKV = WS_WUQ + (size_t)1536 * 512 * 2;
constexpr size_t WS_WBR = WS_WUKV + (size_t)2048 * 512 * 2;
constexpr size_t WS_WO = WS_WBR + (size_t)3 * 2048 * 1024 * 2;
constexpr size_t WS_W13 = WS_WO + (size_t)2048 * 2048 * 2;
constexpr size_t WS_W2 = WS_W13 + (size_t)2 * DFF * DM * 2;
constexpr size_t WS_H = WS_W2 + (size_t)DM * DFF * 2;
constexpr size_t WS_Z = WS_H + (size_t)MTOT * DM * 2;
constexpr size_t WS_T = WS_Z;
constexpr size_t WS_U = WS_Z + (size_t)MTOT * DM * 4;
constexpr size_t WS_TP = WS_U + (size_t)MTOT * DFF * 2;
constexpr size_t WS_KVC = WS_Z + (size_t)MTOT * LDZ * 2;
constexpr size_t WS_O = WS_KVC + (size_t)MTOT * LDKVC * 2;
constexpr size_t WS_H8 = WS_O + (size_t)MTOT * LDO * 2;
constexpr size_t WS_WG8 = WS_H8 + (size_t)MTOT * DM;
constexpr size_t WS_END = WS_WG8 + (size_t)6144 * DM;
static_assert(WS_END <= 921975872ull, "workspace budget (sum of the inputs)");
static_assert(WS_TP + (size_t)4 * NCTX * DM * 4 <= WS_KVC, "overlay");
constexpr int LDS_BYTES = 147456;

typedef unsigned short bf16_t;
typedef short bf16x8 __attribute__((ext_vector_type(8)));
typedef short s16x4 __attribute__((ext_vector_type(4)));
typedef float f32x4 __attribute__((ext_vector_type(4)));
typedef float f32x16 __attribute__((ext_vector_type(16)));
typedef unsigned u32x4 __attribute__((ext_vector_type(4)));
typedef unsigned u32x2 __attribute__((ext_vector_type(2)));
typedef int i32x8 __attribute__((ext_vector_type(8)));
typedef int i32x4 __attribute__((ext_vector_type(4)));
#define LAS __attribute__((address_space(3)))

__device__ __forceinline__ int opaque_tid() { int t = threadIdx.x; asm volatile("" : "+v"(t)); return t; }
__device__ __forceinline__ unsigned cvtpk(float lo, float hi) { unsigned r; asm volatile("v_cvt_pk_bf16_f32 %0, %1, %2" : "=v"(r) : "v"(lo), "v"(hi)); return r; }
__device__ __forceinline__ float bf2f(unsigned short s) { return __uint_as_float(((unsigned)s) << 16); }
__device__ __forceinline__ float bflo(unsigned w) { return __uint_as_float(w << 16); }
__device__ __forceinline__ float bfhi(unsigned w) { return __uint_as_float(w & 0xffff0000u); }
__device__ __forceinline__ float wave_sum(float v) {
#pragma unroll
    for (int o = 1; o < 64; o <<= 1) v += __shfl_xor(v, o);
    return v;
}
__device__ __forceinline__ float sigmoidf_(float x) { return __builtin_amdgcn_rcpf(1.f + __builtin_amdgcn_exp2f(-1.4426950408889634f * x)); }

namespace pg8 {
constexpr int BM = 256, BK = 64, HALF = 128, HTB = HALF * BK * 2, STAGE_BYTES = 8 * HTB, NXCD = 8, WGM = 8;
__device__ __forceinline__ int lds_byte(int r, int c) { const int st = (r >> 4) * 2 + (c >> 5), rr = r & 15, cc = c & 31, ob = rr * 64 + cc * 2; return st * 1024 + (ob ^ (((ob >> 9) & 1) << 5)); }
__device__ __forceinline__ void stage_rc(int b, int& R, int& C) { const int st = b / 1024, sb = b % 1024, swz = sb ^ (((sb >> 9) & 1) << 5); R = (st >> 1) * 16 + swz / 64; C = (st & 1) * 32 + (swz % 64) / 2; }
__device__ __forceinline__ int perm32(int rho) { const int n = rho >> 4, i = rho & 15; return 8 * (i >> 2) + 4 * n + (i & 3); }
struct Unit { int pm, pn, sub; };

struct TileSched {
    int nM, nN, nwg, G, c, nsub; const char* A; const char* B; size_t aT, bT, aS, bS;
    int pn_split, pn_skip, pn_boff;
    int nx;
    __device__ __forceinline__ bool next(int i, Unit& u) const {
        const int ti = i / nsub; u.sub = i - ti * nsub;
        const long L = (long)ti * G + c;
        if (L >= nwg) { const int k = (int)(L - nwg); if (k >= nx) return false; const int t = k / 13, idx = k - t * 13; u.pm = 64 + t;
            u.pn = idx < 8 ? 4 + idx : (idx < 10 ? 32 + idx : (idx < 12 ? 34 + idx : 46)); return true; }
        int wgid = (int)L; { const int q = nwg / NXCD, r = nwg % NXCD, xcd = wgid % NXCD, off = wgid / NXCD; wgid = (xcd < r ? xcd * (q + 1) : r * (q + 1) + (xcd - r) * q) + off; }
        const int nig = WGM * nN, gid = wgid / nig, fm = gid * WGM, gsz = (nM - fm) < WGM ? (nM - fm) : WGM;
        u.pm = fm + ((wgid % nig) % gsz); const int idx = (wgid % nig) / gsz; u.pn = idx < pn_split ? idx : idx + pn_skip; return true;
    }
    __device__ __forceinline__ const char* ptrA(const Unit& u) const { return A + (size_t)u.pm * aT + (size_t)u.sub * aS; }
    __device__ __forceinline__ const char* ptrB(const Unit& u) const { return B + (size_t)(u.pn - pn_boff) * bT + (size_t)u.sub * bS; }
};
struct DualSched {
    int G, c, n0, n1, nN0, nN1; const char *A0, *A1, *B0, *B1; size_t aT, bT;
    __device__ __forceinline__ bool next(int i, Unit& u) const {
        int L = i * G + c;
        if (L < n0) { u.sub = 0; u.pm = L / nN0; u.pn = L - u.pm * nN0; return true; }
        L -= n0; if (L >= n1) return false;
        u.sub = 1; u.pm = L / nN1; u.pn = L - u.pm * nN1; return true;
    }
    __device__ __forceinline__ const char* ptrA(const Unit& u) const { return (u.sub ? A1 : A0) + (size_t)u.pm * aT; }
    __device__ __forceinline__ const char* ptrB(const Unit& u) const { return (u.sub ? B1 : B0) + (size_t)u.pn * bT; }
};

struct EpiZ {
    static constexpr bool PERM = true;
    bf16_t* Z;
    __device__ __forceinline__ void operator()(const f32x4 (&acc)[2][2][4][2], const Unit& u, int wr, int wc, int fr, int fq) const {
        const int row0 = u.pm * BM + wr * 64 + fr, col0 = u.pn * BM + wc * 32 + 8 * fq;
#pragma unroll
        for (int ai = 0; ai < 2; ++ai)
#pragma unroll
            for (int m = 0; m < 4; ++m) { bf16_t* rowp = Z + (size_t)(row0 + ai * HALF + m * 16) * LDZ + col0;
#pragma unroll
                for (int bj = 0; bj < 2; ++bj) { const f32x4 v0 = acc[ai][bj][m][0], v1 = acc[ai][bj][m][1];
                    u32x4 w; w.x = cvtpk(v0[0], v0[1]); w.y = cvtpk(v0[2], v0[3]); w.z = cvtpk(v1[0], v1[1]); w.w = cvtpk(v1[2], v1[3]);
                    if (col0 + bj * HALF < LDZ) *(u32x4*)(rowp + bj * HALF) = w; } }
    }
};
struct EpiZ8 {
    static constexpr bool PERM = false, ALIGN = true;
    bf16_t* Z;
    __device__ __forceinline__ void operator()(const f32x4 (&acc)[2][2][4][2], const Unit& u, int wr, int wc, int fr, int fq) const {
        const int row0 = u.pm * BM + wr * 64 + fr, col0 = u.pn * BM + wc * 32 + 4 * fq;
#pragma unroll
        for (int ai = 0; ai < 2; ++ai)
#pragma unroll
            for (int m = 0; m < 4; ++m) { bf16_t* rowp = Z + (size_t)(row0 + ai * HALF + m * 16) * LDZ + col0;
#pragma unroll
                for (int bj = 0; bj < 2; ++bj)
#pragma unroll
                    for (int n = 0; n < 2; ++n) { const f32x4 v = acc[ai][bj][m][n]; u32x2 w; w.x = cvtpk(v[0], v[1]); w.y = cvtpk(v[2], v[3]); *(u32x2*)(rowp + bj * HALF + n * 16) = w; } }
    }
};
struct EpiQKV {
    static constexpr bool PERM = true;
    bf16_t* O0; bf16_t* O1; int ld0, ld1;
    __device__ __forceinline__ void operator()(const f32x4 (&acc)[2][2][4][2], const Unit& u, int wr, int wc, int fr, int fq) const {
        bf16_t* O = u.sub ? O1 : O0; const int ldc = u.sub ? ld1 : ld0;
        const int row0 = u.pm * BM + wr * 64 + fr, col0 = u.pn * BM + wc * 32 + 8 * fq;
#pragma unroll
        for (int ai = 0; ai < 2; ++ai)
#pragma unroll
            for (int m = 0; m < 4; ++m) { bf16_t* rowp = O + (size_t)(row0 + ai * HALF + m * 16) * ldc + col0;
#pragma unroll
                for (int bj = 0; bj < 2; ++bj) { const f32x4 v0 = acc[ai][bj][m][0], v1 = acc[ai][bj][m][1];
                    u32x4 w; w.x = cvtpk(v0[0], v0[1]); w.y = cvtpk(v0[2], v0[3]); w.z = cvtpk(v1[0], v1[1]); w.w = cvtpk(v1[2], v1[3]);
                    *(u32x4*)(rowp + bj * HALF) = w; } }
    }
};
struct EpiMerge {
    static constexpr bool PERM = true;
    bf16_t* Y; const bf16_t* Z;
    __device__ __forceinline__ void operator()(const f32x4 (&acc)[2][2][4][2], const Unit& u, int wr, int wc, int fr, int fq) const {
        const int row0 = u.pm * BM + wr * 64 + fr, col0 = u.pn * BM + wc * 32 + 8 * fq;
        const bool rmw = (u.sub > 0);
#pragma unroll
        for (int ai = 0; ai < 2; ++ai) {
            u32x4 g[4][2], pv[4][2];
#pragma unroll
            for (int m = 0; m < 4; ++m) { const size_t row = (size_t)(row0 + ai * HALF + m * 16);
#pragma unroll
                for (int bj = 0; bj < 2; ++bj) { g[m][bj] = *(const u32x4*)(Z + row * LDZ + ZC_GA + 2048 * u.sub + col0 + bj * HALF);
                    pv[m][bj] = rmw ? *(const u32x4*)(Y + row * DM + col0 + bj * HALF) : (u32x4){0u, 0u, 0u, 0u}; } }
            asm volatile("" ::: "memory");
#pragma unroll
            for (int m = 0; m < 4; ++m) { bf16_t* yp = Y + (size_t)(row0 + ai * HALF + m * 16) * DM + col0;
#pragma unroll
                for (int bj = 0; bj < 2; ++bj) { const f32x4 a0 = acc[ai][bj][m][0], a1 = acc[ai][bj][m][1]; const u32x4 gg = g[m][bj], p = pv[m][bj];
                    float v[8] = { a0[0] * sigmoidf_(bflo(gg.x)), a0[1] * sigmoidf_(bfhi(gg.x)), a0[2] * sigmoidf_(bflo(gg.y)), a0[3] * sigmoidf_(bfhi(gg.y)), a1[0] * sigmoidf_(bflo(gg.z)), a1[1] * sigmoidf_(bfhi(gg.z)), a1[2] * sigmoidf_(bflo(gg.w)), a1[3] * sigmoidf_(bfhi(gg.w)) };
                    v[0] += bflo(p.x); v[1] += bfhi(p.x); v[2] += bflo(p.y); v[3] += bfhi(p.y); v[4] += bflo(p.z); v[5] += bfhi(p.z); v[6] += bflo(p.w); v[7] += bfhi(p.w);
                    u32x4 w; w.x = cvtpk(v[0], v[1]); w.y = cvtpk(v[2], v[3]); w.z = cvtpk(v[4], v[5]); w.w = cvtpk(v[6], v[7]);
                    *(u32x4*)(yp + bj * HALF) = w; } }
        }
    }
};
struct EpiSwiglu {
    static constexpr bool PERM = false;
    bf16_t* U;
    __device__ __forceinline__ void operator()(const f32x4 (&acc)[2][2][4][2], const Unit& u, int wr, int wc, int fr, int fq) const {
        const int row0 = u.pm * BM + wr * 64 + fr, col0 = u.pn * 128 + wc * 16 + 4 * fq;
#pragma unroll
        for (int ai = 0; ai < 2; ++ai)
#pragma unroll
            for (int m = 0; m < 4; ++m) { bf16_t* rowp = U + (size_t)(row0 + ai * HALF + m * 16) * DFF + col0;
#pragma unroll
                for (int bj = 0; bj < 2; ++bj) { const f32x4 a = acc[ai][bj][m][0], g = acc[ai][bj][m][1]; float o[4];
#pragma unroll
                    for (int j = 0; j < 4; ++j) o[j] = a[j] * sigmoidf_(a[j]) * g[j];
                    u32x2 w; w.x = cvtpk(o[0], o[1]); w.y = cvtpk(o[2], o[3]);
                    *(u32x2*)(rowp + bj * 64) = w; } }
    }
};

struct CtxSplitSched {
    int G, c; const char* A; const char* B; size_t aT, bT, kqB;
    __device__ __forceinline__ bool next(int i, Unit& u) const { const int L = i * G + c; if (L >= 256) return false; u.sub = L & 3; const int t = L >> 2; u.pm = 64 + (t >> 3); u.pn = t & 7; return true; }
    __device__ __forceinline__ const char* ptrA(const Unit& u) const { return A + (size_t)u.pm * aT + (size_t)u.sub * kqB; }
    __device__ __forceinline__ const char* ptrB(const Unit& u) const { return B + (size_t)u.pn * bT + (size_t)u.sub * kqB; }
};
struct EpiSlab {
    static constexpr bool PERM = false;
    float* C;
    __device__ __forceinline__ void operator()(const f32x4 (&acc)[2][2][4][2], const Unit& u, int wr, int wc, int fr, int fq) const {
        const int row0 = (u.pm - 64) * BM + wr * 64 + fr, col0 = u.pn * BM + wc * 32 + 4 * fq;
        float* Cs = C + (size_t)u.sub * NCTX * DM;
#pragma unroll
        for (int ai = 0; ai < 2; ++ai)
#pragma unroll
            for (int m = 0; m < 4; ++m) { float* rowp = Cs + (size_t)(row0 + ai * HALF + m * 16) * DM + col0;
#pragma unroll
                for (int bj = 0; bj < 2; ++bj)
#pragma unroll
                    for (int n = 0; n < 2; ++n) *(f32x4*)(rowp + bj * HALF + n * 16) = acc[ai][bj][m][n]; }
    }
};

template <bool F8 = false, class Epi, class Sched>
__device__ __forceinline__ void gemm_phase(LAS unsigned char* lds, const int lda, const int ldb, const int K, const Sched& S, const Epi& E) {
    const int tid = opaque_tid(), wid = __builtin_amdgcn_readfirstlane(tid >> 6), lane = tid & 63, wr = wid >> 2, wc = wid & 3, fr = lane & 15, fq = lane >> 4;
    const int nt = K / BK;
    unsigned voffA[2], voffB[2];
#pragma unroll
    for (int i = 0; i < 2; ++i) { int R, C; stage_rc(tid * 16 + i * 8192, R, C); const int Rb = Epi::PERM ? ((R & ~31) + perm32(R & 31)) : R;
        voffA[i] = (unsigned)(R * lda + C) * 2u; voffB[i] = (unsigned)(Rb * ldb + C) * 2u; }
    const size_t kstep = (size_t)(BK * 2);
    const size_t hstepA = (size_t)HALF * lda * 2, hstepB = (size_t)HALF * ldb * 2;
    const unsigned ldsw = (unsigned)wid * 1024u;
    const int aoff = lds_byte(wr * 64 + fr, fq * 8), boff = lds_byte(wc * 32 + fr, fq * 8);
#define PG8_SA(b, h) (((b) * 2 + (h)) * HTB)
#define PG8_SB(b, h) ((4 + (b) * 2 + (h)) * HTB)
#define PG8_STAGE(bufoff, gbase, voff) do { _Pragma("unroll") for (int _i = 0; _i < 2; ++_i) \
        __builtin_amdgcn_global_load_lds((const unsigned*)((const char*)(gbase) + (voff)[_i]), (LAS unsigned*)(lds + (bufoff) + ldsw + _i * 8192), 16, 0, 0); } while (0)
#define PG8_LDA(dst, b, h) do { if constexpr (F8) { _Pragma("unroll") for (int m = 0; m < 4; ++m) { const i32x4 _l = *(const LAS i32x4*)(lds + PG8_SA(b, h) + aoff + m * 2048), _u = *(const LAS i32x4*)(lds + PG8_SA(b, h) + aoff + m * 2048 + 1024); \
          dst##8[m] = __builtin_shufflevector(_l, _u, 0, 1, 2, 3, 4, 5, 6, 7); } } \
        else { _Pragma("unroll") for (int m = 0; m < 4; ++m) _Pragma("unroll") for (int k = 0; k < 2; ++k) dst[m][k] = *(const LAS bf16x8*)(lds + PG8_SA(b, h) + aoff + m * 2048 + k * 1024); } } while (0)
#define PG8_LDB(dst, b, h) do { if constexpr (F8) { _Pragma("unroll") for (int n = 0; n < 2; ++n) { const i32x4 _l = *(const LAS i32x4*)(lds + PG8_SB(b, h) + boff + n * 2048), _u = *(const LAS i32x4*)(lds + PG8_SB(b, h) + boff + n * 2048 + 1024); \
          dst##8[n] = __builtin_shufflevector(_l, _u, 0, 1, 2, 3, 4, 5, 6, 7); } } \
        else { _Pragma("unroll") for (int n = 0; n < 2; ++n) _Pragma("unroll") for (int k = 0; k < 2; ++k) dst[n][k] = *(const LAS bf16x8*)(lds + PG8_SB(b, h) + boff + n * 2048 + k * 1024); } } while (0)
#define PG8_MMA(ai, bj, At, Bt) do { __builtin_amdgcn_s_setprio(1); _Pragma("unroll") for (int m = 0; m < 4; ++m) _Pragma("unroll") for (int n = 0; n < 2; ++n) { \
        if constexpr (F8)   \
            asm volatile("v_mfma_scale_f32_16x16x128_f8f6f4 %0, %1, %2, %0, %3, %4 op_sel_hi:[0,0,0]" : "+v"(acc[ai][bj][m][n]) : "v"(Bt##8[n]), "v"(At##8[m]), "v"(f8s), "v"(f8s)); \
        else { _Pragma("unroll") for (int k = 0; k < 2; ++k) acc[ai][bj][m][n] = __builtin_amdgcn_mfma_f32_16x16x32_bf16(Bt[n][k], At[m][k], acc[ai][bj][m][n], 0, 0, 0); } } \
        __builtin_amdgcn_s_setprio(0); } while (0)
#define PG8_WAIT_V(n) asm volatile("s_waitcnt vmcnt(" #n ")" ::: "memory")
#define PG8_WAIT_L(n) asm volatile("s_waitcnt lgkmcnt(" #n ")" ::: "memory")
#define PG8_BAR __builtin_amdgcn_s_barrier()
#define PG8_SCHED __builtin_amdgcn_sched_barrier(0)
    Unit cur, nxt; int ui = 0;
    if (!S.next(0, cur)) return;
    f32x4 acc[2][2][4][2];
#pragma unroll
    for (int a = 0; a < 2; ++a)
#pragma unroll
        for (int b = 0; b < 2; ++b)
#pragma unroll
            for (int m = 0; m < 4; ++m)
#pragma unroll
                for (int n = 0; n < 2; ++n) acc[a][b][m][n] = (f32x4){0.f, 0.f, 0.f, 0.f};
    bf16x8 At[4][2], B0[2][2], B1[2][2];
    i32x8 At8[4], B08[2], B18[2];
    const int f8s = 0x7C7C7C7C;
    const char* cA = S.ptrA(cur); const char* cB = S.ptrB(cur);
    PG8_STAGE(PG8_SB(0, 0), cB, voffB); PG8_STAGE(PG8_SB(0, 1), cB + hstepB, voffB); PG8_STAGE(PG8_SA(0, 0), cA, voffA); PG8_STAGE(PG8_SA(0, 1), cA + hstepA, voffA);
    if (wr == 1) PG8_BAR;
    PG8_WAIT_V(2); PG8_BAR;
    PG8_STAGE(PG8_SB(1, 0), cB + kstep, voffB); PG8_STAGE(PG8_SA(1, 0), cA + kstep, voffA); PG8_STAGE(PG8_SB(1, 1), cB + hstepB + kstep, voffB);
    PG8_WAIT_V(6); PG8_BAR;
    for (;;) {
        const bool has_next = S.next(ui + 1, nxt);
        const char* nA = has_next ? S.ptrA(nxt) : cA; const char* nB = has_next ? S.ptrB(nxt) : cB;
        for (int t = 0; t < nt; t += 2) {
            const bool last = (t == nt - 2);
            const char* a1 = cA + (size_t)(t + 1) * kstep;
            const char* a2 = last ? nA : cA + (size_t)(t + 2) * kstep; const char* b2 = last ? nB : cB + (size_t)(t + 2) * kstep;
            const char* a3 = a2 + kstep; const char* b3 = b2 + kstep;
            PG8_LDB(B0, 0, 0); PG8_LDB(B1, 0, 1); PG8_SCHED; PG8_LDA(At, 0, 0); PG8_STAGE(PG8_SA(1, 1), a1 + hstepA, voffA);
            PG8_WAIT_V(8); PG8_WAIT_L(0); PG8_BAR; PG8_MMA(0, 0, At, B0); PG8_MMA(0, 1, At, B1); PG8_BAR; PG8_SCHED;
            PG8_LDA(At, 0, 1); PG8_STAGE(PG8_SB(0, 0), b2, voffB); PG8_STAGE(PG8_SB(0, 1), b2 + hstepB, voffB); PG8_STAGE(PG8_SA(0, 0), a2, voffA);
            PG8_WAIT_V(8); PG8_WAIT_L(0); PG8_BAR; PG8_MMA(1, 0, At, B0); PG8_MMA(1, 1, At, B1); PG8_BAR; PG8_SCHED;
            PG8_LDB(B0, 1, 0); PG8_LDB(B1, 1, 1); PG8_SCHED; PG8_LDA(At, 1, 0); PG8_STAGE(PG8_SA(0, 1), a2 + hstepA, voffA);
            PG8_WAIT_V(8); PG8_WAIT_L(0); PG8_BAR; PG8_MMA(0, 0, At, B0); PG8_MMA(0, 1, At, B1); PG8_BAR; PG8_SCHED;
            PG8_LDA(At, 1, 1); PG8_STAGE(PG8_SB(1, 0), b3, voffB); PG8_STAGE(PG8_SB(1, 1), b3 + hstepB, voffB); PG8_STAGE(PG8_SA(1, 0), a3, voffA);
            PG8_WAIT_V(8); PG8_WAIT_L(0); PG8_BAR; PG8_MMA(1, 0, At, B0); PG8_MMA(1, 1, At, B1); PG8_BAR; PG8_SCHED;
        }
        if (wr == 0) PG8_BAR;
        E(acc, cur, wr, wc, fr, fq);
        if (!has_next) break;
#pragma unroll
        for (int a = 0; a < 2; ++a)
#pragma unroll
            for (int b = 0; b < 2; ++b)
#pragma unroll
                for (int m = 0; m < 4; ++m)
#pragma unroll
                    for (int n = 0; n < 2; ++n) acc[a][b][m][n] = (f32x4){0.f, 0.f, 0.f, 0.f};
        cur = nxt; cA = nA; cB = nB; ++ui;
        if (wr == 1) PG8_BAR;
    }
    PG8_WAIT_V(0);
    PG8_BAR;
#undef PG8_SA
#undef PG8_SB
#undef PG8_STAGE
#undef PG8_LDA
#undef PG8_LDB
#undef PG8_MMA
#undef PG8_WAIT_V
#undef PG8_WAIT_L
#undef PG8_BAR
#undef PG8_SCHED
}
}

namespace att {
constexpr int SHM_V = 64 * 128 * 2;
constexpr int SHM_K = 64 * 192 * 2;
constexpr int OFF_K = 2 * SHM_V, OFF_WS = OFF_K + 2 * SHM_K, OFF_RPB = OFF_WS + 8 * 64 * 4, ATT_LDS = OFF_RPB + 2048;
constexpr float THR = 8.f;
__device__ __forceinline__ int crow(int r, int hi) { return (r & 3) + 8 * (r >> 2) + 4 * hi; }
__device__ __forceinline__ int v_st(int k, int c) { const int kk = (k & ~0xC) | ((k & 4) << 1) | ((k & 8) >> 1); return ((kk >> 3) * 4 + (c >> 5)) * 512 + ((kk & 7) * 32 + (c & 31)) * 2; }
__device__ __forceinline__ int v_rd_base(int lane) { return ((lane & 3) << 3) | (((lane >> 2) & 3) << 6) | (((lane >> 4) & 1) << 5) | (((lane >> 5) & 1) << 8); }
constexpr int v_rd_off(int d0, int ks, int half) { return d0 * 512 + ks * 4096 + half * 2048; }
template <int OFF> __device__ __forceinline__ s16x4 tr_read(int vb) {
    s16x4 r; asm volatile("ds_read_b64_tr_b16 %0, %1 offset:%2" : "=&v"(r) : "v"(vb), "i"(OFF) : "memory"); return r;
}
template <int D0> __device__ __forceinline__ void pv_one(f32x16& od, int vb, bf16x8 pa0, bf16x8 pa1, bf16x8 pa2, bf16x8 pa3) {
    const s16x4 l0 = tr_read<v_rd_off(D0, 0, 0)>(vb), h0 = tr_read<v_rd_off(D0, 0, 1)>(vb), l1 = tr_read<v_rd_off(D0, 1, 0)>(vb), h1 = tr_read<v_rd_off(D0, 1, 1)>(vb);
    const s16x4 l2 = tr_read<v_rd_off(D0, 2, 0)>(vb), h2 = tr_read<v_rd_off(D0, 2, 1)>(vb), l3 = tr_read<v_rd_off(D0, 3, 0)>(vb), h3 = tr_read<v_rd_off(D0, 3, 1)>(vb);
    asm volatile("s_waitcnt lgkmcnt(0)" ::: "memory"); __builtin_amdgcn_sched_barrier(0);
#define PK(L, H) (bf16x8){L[0], L[1], L[2], L[3], H[0], H[1], H[2], H[3]}
    od = __builtin_amdgcn_mfma_f32_32x32x16_bf16(pa0, PK(l0, h0), od, 0, 0, 0);
    od = __builtin_amdgcn_mfma_f32_32x32x16_bf16(pa1, PK(l1, h1), od, 0, 0, 0);
    od = __builtin_amdgcn_mfma_f32_32x32x16_bf16(pa2, PK(l2, h2), od, 0, 0, 0);
    od = __builtin_amdgcn_mfma_f32_32x32x16_bf16(pa3, PK(l3, h3), od, 0, 0, 0);
#undef PK
}

struct UnitP {
    const bf16_t* Q; int ldq;
    const bf16_t* K1; int ldk1;
    const bf16_t* K2; int ldk2;
    const bf16_t* V; int ldv;
    bf16_t* O; int ldo;
    int NT, nlat, row_lat0, row_ctx0;
    float C, thr_raw;
    int rope_q, qpos0;
    int qgrow0, krow0;
};

template <int DQK, bool NA>
__device__ __forceinline__ void attn_unit(const UnitP& P, char* lds) {
    constexpr int NQ = DQK / 16, KROWB = DQK * 2;
    const int tid = opaque_tid(), wid = __builtin_amdgcn_readfirstlane(tid >> 6), lane = tid & 63, r32 = lane & 31, hi = lane >> 5;
    char* V_lds = lds; char* K_lds = lds + OFF_K;
    float* wsf = (float*)(lds + OFF_WS) + wid * 64; float* li_l = wsf; float* al_l = wsf + 32;
    const float* rpbs = (const float*)(lds + OFF_RPB);
    float m_reg = -1e30f, l_reg = 0.f; f32x16 o[4];
#pragma unroll
    for (int d = 0; d < 4; ++d)
#pragma unroll
        for (int r = 0; r < 16; ++r) o[d][r] = 0.f;
    bf16x8 qr[NQ];
    { const bf16_t* Qw = P.Q + (size_t)(wid * 32 + r32) * P.ldq + hi * 8;
#pragma unroll
      for (int d0 = 0; d0 < NQ; ++d0) qr[d0] = *reinterpret_cast<const bf16x8*>(Qw + d0 * 16); }
    if constexpr (DQK == 192) {
        if (P.rope_q) {
            const int s = P.qpos0 + wid * 32 + r32; const float prow = (float)(s >> 6), pcol = (float)(s & 63);
#pragma unroll
            for (int e = 0; e < 8; ++e) {
                const float fr_ = __builtin_amdgcn_exp2f(-(float)(hi * 8 + e) * (13.287712379549449f / 16.f));
                const float ar = prow * fr_, ac = pcol * fr_;
                const float cr = __cosf(ar), sr = __sinf(ar), cc = __cosf(ac), sc = __sinf(ac);
                const float x1 = bf2f((unsigned short)qr[8][e]), x2 = bf2f((unsigned short)qr[9][e]), y1 = bf2f((unsigned short)qr[10][e]), y2 = bf2f((unsigned short)qr[11][e]);
                const unsigned w0 = cvtpk(x1 * cr - x2 * sr, x2 * cr + x1 * sr), w1 = cvtpk(y1 * cc - y2 * sc, y2 * cc + y1 * sc);
                qr[8][e] = (short)(w0 & 0xffffu); qr[9][e] = (short)(w0 >> 16); qr[10][e] = (short)(w1 & 0xffffu); qr[11][e] = (short)(w1 >> 16);
            }
        }
    }
    const int vb0 = (int)(uintptr_t)V_lds + v_rd_base(lane);
#define KSWZ(row, colB) ((row) * KROWB + ((colB) ^ (((row) & 7) << 4)))
#define TROW(t) ((t) < P.nlat ? P.row_lat0 + 64 * (t) : P.row_ctx0 + 64 * ((t) - P.nlat))
    LAS char* ldsl = (LAS char*)lds;
    constexpr int NKI = DQK / 64;
    int voffe[2]; const bf16_t* kbase[NKI]; int kld[NKI];
#pragma unroll
    for (int j = 0; j < 2; ++j) { const int X = (wid * 2 + j) * 1024 + lane * 16, st = X >> 9, kk = ((st >> 2) << 3) | ((X >> 6) & 7), c = ((st & 3) << 5) | ((X >> 1) & 31);
        const int k = (kk & ~0xC) | ((kk & 4) << 1) | ((kk & 8) >> 1); voffe[j] = k * P.ldv + c; }
#pragma unroll
    for (int j = 0; j < NKI; ++j) { const int X = (wid * NKI + j) * 1024 + lane * 16, row = X / KROWB, cb = X - row * KROWB, colB = cb ^ ((row & 7) << 4);
        if (DQK == 192 && colB >= 256) { kbase[j] = P.K2 + (size_t)row * P.ldk2 + ((colB - 256) >> 1); kld[j] = P.ldk2; }
        else { kbase[j] = P.K1 + (size_t)row * P.ldk1 + (colB >> 1); kld[j] = P.ldk1; } }
#define DMA(t, b) do { const size_t rb = (size_t)TROW(t); \
        _Pragma("unroll") for (int _j = 0; _j < 2; ++_j) __builtin_amdgcn_global_load_lds((const unsigned*)(P.V + rb * P.ldv + voffe[_j]), (LAS unsigned*)(ldsl + (b) * SHM_V + (wid * 2 + _j) * 1024), 16, 0, 0); \
        _Pragma("unroll") for (int _j = 0; _j < NKI; ++_j) __builtin_amdgcn_global_load_lds((const unsigned*)(kbase[_j] + rb * kld[_j]), (LAS unsigned*)(ldsl + OFF_K + (b) * SHM_K + (wid * NKI + _j) * 1024), 16, 0, 0); } while (0)
    const int qgrow = P.qgrow0 + (wid >> 1), qc = (wid & 1) * 32 + r32;
    const int r0w = min(max(qgrow - 4, 0), 24), c0 = min(max(qc - 8, 0), 48);
    DMA(0, 0); __syncthreads();
    for (int t = 0; t < P.NT; ++t) {
        if (t + 1 < P.NT) DMA(t + 1, (t + 1) & 1);
        bool act = true;
        if constexpr (NA) act = (t >= P.nlat) || ((unsigned)(P.krow0 + t - r0w) < 8u);
        if (act) {
            const char* Kb = K_lds + (t & 1) * SHM_K;
            f32x16 p0, p1;
#pragma unroll
            for (int r = 0; r < 16; ++r) { p0[r] = 0.f; p1[r] = 0.f; }
#pragma unroll
            for (int d0 = 0; d0 < NQ; ++d0) { const int cb = (d0 * 16 + hi * 8) * 2;
                const bf16x8 b0 = *reinterpret_cast<const bf16x8*>(Kb + KSWZ(r32, cb));
                const bf16x8 b1 = *reinterpret_cast<const bf16x8*>(Kb + KSWZ(32 + r32, cb));
                p0 = __builtin_amdgcn_mfma_f32_32x32x16_bf16(b0, qr[d0], p0, 0, 0, 0);
                p1 = __builtin_amdgcn_mfma_f32_32x32x16_bf16(b1, qr[d0], p1, 0, 0, 0); }
            if constexpr (NA) {
                if (t < P.nlat) {
                    const int dr = P.krow0 + t - qgrow + 7; const float* rp = rpbs + dr * 31;
                    int qcx = qc, c0x = c0, hix = hi; asm volatile("" : "+v"(qcx), "+v"(c0x), "+v"(hix));
#pragma unroll
                    for (int r = 0; r < 16; ++r) { const int kc0 = crow(r, hix), kc1 = 32 + kc0;
                        const float b0 = rp[min(max(kc0 - qcx + 15, 0), 30)], b1 = rp[min(max(kc1 - qcx + 15, 0), 30)];
                        p0[r] = ((unsigned)(kc0 - c0x) < 16u) ? p0[r] + b0 : -1e30f;
                        p1[r] = ((unsigned)(kc1 - c0x) < 16u) ? p1[r] + b1 : -1e30f;
                        if ((r & 3) == 3) asm volatile("" ::: "memory"); }
                }
            }
            float pmax = p0[0];
#pragma unroll
            for (int r = 1; r < 16; ++r) pmax = fmaxf(pmax, p0[r]);
#pragma unroll
            for (int r = 0; r < 16; ++r) pmax = fmaxf(pmax, p1[r]);
            { auto rr = __builtin_amdgcn_permlane32_swap(__float_as_uint(pmax), __float_as_uint(pmax), false, false);
              pmax = fmaxf(__uint_as_float(rr[0]), __uint_as_float(rr[1])); }
            float mn, alpha;
            if (__all(pmax - m_reg <= P.thr_raw)) { mn = m_reg; alpha = 1.f; }
            else { mn = fmaxf(m_reg, pmax); alpha = __builtin_amdgcn_exp2f((m_reg - mn) * P.C); m_reg = mn; }
            const float mnC = -mn * P.C;
            float ps = 0.f;
#pragma unroll
            for (int r = 0; r < 16; ++r) { p0[r] = __builtin_amdgcn_exp2f(fmaf(p0[r], P.C, mnC)); p1[r] = __builtin_amdgcn_exp2f(fmaf(p1[r], P.C, mnC)); ps += p0[r] + p1[r]; }
            { auto rr = __builtin_amdgcn_permlane32_swap(__float_as_uint(ps), __float_as_uint(ps), false, false);
              ps = __uint_as_float(rr[0]) + __uint_as_float(rr[1]); }
            l_reg = l_reg * alpha + ps;
            if (__any(alpha < 1.f)) { if (hi == 0) al_l[r32] = alpha; asm volatile("s_waitcnt lgkmcnt(0)" ::: "memory");
#pragma unroll
                for (int r = 0; r < 16; ++r) { const float a = al_l[crow(r, hi)];
#pragma unroll
                    for (int d = 0; d < 4; ++d) o[d][r] *= a; } }
            bf16x8 pa0, pa1, pa2, pa3;
#define PK4(Pv, BASE, OUT) do { unsigned a0 = cvtpk(Pv[BASE + 0], Pv[BASE + 1]), a1 = cvtpk(Pv[BASE + 2], Pv[BASE + 3]);   \
    unsigned b0 = cvtpk(Pv[BASE + 4], Pv[BASE + 5]), b1 = cvtpk(Pv[BASE + 6], Pv[BASE + 7]);                              \
    auto r0 = __builtin_amdgcn_permlane32_swap(a0, b0, false, false); auto r1 = __builtin_amdgcn_permlane32_swap(a1, b1, false, false); \
    u32x4 w = {r0[0], r1[0], r0[1], r1[1]}; OUT = *reinterpret_cast<bf16x8*>(&w); } while (0)
            PK4(p0, 0, pa0); PK4(p0, 8, pa1); PK4(p1, 0, pa2); PK4(p1, 8, pa3);
#undef PK4
            const int vb = vb0 + (t & 1) * SHM_V;
            pv_one<0>(o[0], vb, pa0, pa1, pa2, pa3); pv_one<1>(o[1], vb, pa0, pa1, pa2, pa3); pv_one<2>(o[2], vb, pa0, pa1, pa2, pa3); pv_one<3>(o[3], vb, pa0, pa1, pa2, pa3);
        }
        __syncthreads();
    }
    if (hi == 0) li_l[r32] = l_reg;
    asm volatile("s_waitcnt lgkmcnt(0)" ::: "memory");
    bf16_t* Ow = P.O + (size_t)(wid * 32) * P.ldo;
#pragma unroll
    for (int r = 0; r < 16; ++r) { const int orow = crow(r, hi); const float rl = __builtin_amdgcn_rcpf(li_l[orow]);
#pragma unroll
        for (int d0 = 0; d0 < 4; ++d0) Ow[(size_t)orow * P.ldo + d0 * 32 + r32] = (bf16_t)(cvtpk(o[d0][r] * rl, 0.f) & 0xffffu); }
    __syncthreads();
#undef KSWZ
#undef TROW
#undef DMA
}
}

#define XB_TMO      128
#define XB_XCNT(j)  (256  + 64 * (j))
#define XB_XSUB(j)  (1280 + 64 * (j))
#define XB_XGEN(j)  (2304 + 64 * (j))
#define XB_TOP      3328
#define XB_TOPGEN   3392
#define XCD_BAR_WORDS 3456
#define XB_SPIN_CAP (1u << 22)
__device__ __forceinline__ unsigned xb_ld(unsigned* p)              { return __hip_atomic_load(p, __ATOMIC_RELAXED, __HIP_MEMORY_SCOPE_AGENT); }
__device__ __forceinline__ unsigned xb_add(unsigned* p, unsigned v) { return __hip_atomic_fetch_add(p, v, __ATOMIC_RELAXED, __HIP_MEMORY_SCOPE_AGENT); }
__device__ __forceinline__ unsigned xb_xcc_id() { return (unsigned)__builtin_amdgcn_readfirstlane((int)((unsigned)__builtin_amdgcn_s_getreg((3 << 11) | 20) & 0xFu)); }
#define XB_SPIN(cond, bar) do { unsigned _sp = 0; while (cond) { __builtin_amdgcn_s_sleep(1); \
    if ((++_sp & 255u) == 0u) { if (xb_ld(&(bar)[XB_TMO])) break; if (_sp > XB_SPIN_CAP) { atomicAdd(&(bar)[XB_TMO], 1u); break; } } } } while (0)
struct XcdBarrier { unsigned* bar; unsigned x; volatile LAS unsigned* st; };
__device__ __forceinline__ XcdBarrier xcd_barrier_post(unsigned* bar, volatile LAS unsigned* st) {
    XcdBarrier b; b.bar = bar; b.x = 0; b.st = st;
    if (threadIdx.x == 0) (void)xb_add(&bar[XB_XCNT(xb_xcc_id())], 1u);
    return b;
}
__device__ __forceinline__ void xcd_barrier_complete(unsigned* bar, unsigned x, unsigned& nloc, unsigned& nx) {
    const unsigned G = gridDim.x * gridDim.y * gridDim.z;
    unsigned sum, cnt, mine, sp = 0u;
    for (;;) {
        sum = 0u; cnt = 0u; mine = 0u;
#pragma unroll
        for (unsigned j = 0; j < 16; ++j) { const unsigned c = xb_ld(&bar[XB_XCNT(j)]); sum += c; cnt += (c > 0u) ? 1u : 0u; mine = (j == x) ? c : mine; }
        if (sum == G) break;
        __builtin_amdgcn_s_sleep(1);
        if ((++sp & 255u) == 0u) { if (xb_ld(&bar[XB_TMO])) break; if (sp > XB_SPIN_CAP) { atomicAdd(&bar[XB_TMO], 1u); break; } }
    }
    nloc = mine > 0u ? mine : 1u; nx = cnt > 0u ? cnt : 1u;
}
__device__ __forceinline__ void xcd_barrier(const XcdBarrier& b) {
    asm volatile("s_waitcnt vmcnt(0)" ::: "memory");
    __syncthreads();
    if (threadIdx.x == 0) {
        unsigned* bar = b.bar; const unsigned bx = xb_xcc_id();
        __builtin_amdgcn_s_waitcnt(0);
        unsigned nloc = b.st[0], nx = b.st[1];
        if (nloc == 0u) { xcd_barrier_complete(bar, bx, nloc, nx); b.st[0] = nloc; b.st[1] = nx; }
        const unsigned old = xb_add(&bar[XB_XSUB(bx)], 1u);
        const unsigned gen = old / nloc;
        if (old + 1u == (gen + 1u) * nloc) {
            __builtin_amdgcn_fence(__ATOMIC_RELEASE, "agent");
            asm volatile("s_waitcnt vmcnt(0)" ::: "memory");
            const unsigned og = xb_add(&bar[XB_TOP], 1u);
            const unsigned tg = og / nx;
            if (og + 1u == (tg + 1u) * nx) xb_add(&bar[XB_TOPGEN], 1u);
            else XB_SPIN(xb_ld(&bar[XB_TOPGEN]) == tg, bar);
            __builtin_amdgcn_fence(__ATOMIC_ACQUIRE, "agent");
            xb_add(&bar[XB_XGEN(bx)], 1u);
            asm volatile("s_waitcnt vmcnt(0)" ::: "memory");
        } else {
            XB_SPIN(xb_ld(&bar[XB_XGEN(bx)]) == gen, bar);
            __builtin_amdgcn_fence(__ATOMIC_ACQUIRE, "agent");
            asm volatile("s_waitcnt vmcnt(0)" ::: "memory");
        }
    }
    __syncthreads();
}

struct Args { const float* in[25]; float* out; unsigned char* ws; };
enum { I_X = 0, I_C, I_CTX, I_CCTX, I_WADA, I_BADA, I_GPRE1, I_GPOST1, I_GPRE2, I_GPOST2, I_WIN, I_RPB, I_GQN, I_GKN, I_MQN, I_MKVN, I_WUQ, I_WUKV, I_WBRA, I_WBRB, I_WBRC, I_WO, I_WFF1, I_WFF3, I_WFF2 };

struct TItem { const float* W; bf16_t* WT; int K, N, k0, n0, dbase; bool mode13, gate8; };
__device__ __forceinline__ TItem titem_get(const Args& a, int l, int it) {
    unsigned char* ws = a.ws; TItem d;
    constexpr int I_IN = 32 * 370, I_13 = 32 * 176, I_2 = 88 * 64, I_O = 32 * 64, I_BR = 16 * 64, I_UQ = 8 * 48;
    int r = it; d.mode13 = false; d.gate8 = false;
    if (r < I_IN) { const int kb = r / 370, nb = r % 370, n0 = nb * 32; d.W = a.in[I_WIN] + (size_t)l * DM * INW; d.K = DM; d.N = INW; d.WT = (bf16_t*)(ws + WS_WIN);
        d.k0 = kb * 64; d.n0 = n0; d.dbase = n0 < 4096 ? n0 : (n0 < 5696 ? n0 + 6144 : n0 - 1600);
        if (n0 >= 5696) { d.gate8 = true; d.dbase = n0 - 5696; d.WT = (bf16_t*)(ws + WS_WG8); }
        return d; }
    r -= I_IN;
    if (r < 2 * I_13) { const int which = r / I_13; r -= which * I_13; const int kb = r / 176, nb = r % 176; d.W = a.in[which ? I_WFF3 : I_WFF1] + (size_t)l * DM * DFF; d.K = DM; d.N = DFF; d.WT = (bf16_t*)(ws + WS_W13);
        d.k0 = kb * 64; d.n0 = nb * 32; d.dbase = 64 * nb + 16 * which; d.mode13 = true; return d; }
    r -= 2 * I_13;
    if (r < I_2) { const int kb = r / 64, nb = r % 64; d.W = a.in[I_WFF2] + (size_t)l * DFF * DM; d.K = DFF; d.N = DM; d.WT = (bf16_t*)(ws + WS_W2); d.k0 = kb * 64; d.n0 = nb * 32; d.dbase = nb * 32; return d; }
    r -= I_2;
    if (r < I_O) { const int kb = r / 64, nb = r % 64; d.W = a.in[I_WO] + (size_t)l * DM * DM; d.K = DM; d.N = DM; d.WT = (bf16_t*)(ws + WS_WO); d.k0 = kb * 64; d.n0 = nb * 32; d.dbase = nb * 32; return d; }
    r -= I_O;
    if (r < 3 * I_BR) { const int br = r / I_BR; r -= br * I_BR; const int kb = r / 64, nb = r % 64; d.W = a.in[I_WBRA + br] + (size_t)l * 1024 * DM; d.K = 1024; d.N = DM; d.WT = (bf16_t*)(ws + WS_WBR) + (size_t)br * 2048 * 1024;
        d.k0 = kb * 64; d.n0 = nb * 32; d.dbase = nb * 32; return d; }
    r -= 3 * I_BR;
    if (r < I_UQ) { const int kb = r / 48, nb = r % 48; d.W = a.in[I_WUQ] + (size_t)l * 512 * 1536; d.K = 512; d.N = 1536; d.WT = (bf16_t*)(ws + WS_WUQ); d.k0 = kb * 64; d.n0 = nb * 32; d.dbase = nb * 32; return d; }
    r -= I_UQ;
    { const int kb = r / 64, nb = r % 64; d.W = a.in[I_WUKV] + (size_t)l * 512 * 2048; d.K = 512; d.N = 2048; d.WT = (bf16_t*)(ws + WS_WUKV); d.k0 = kb * 64; d.n0 = nb * 32; d.dbase = nb * 32; return d; }
}
__device__ __forceinline__ void titem_load(const TItem& d, int lane, f32x4 (&v)[8]) {
    const int kq = lane >> 3, nq = (lane & 7) * 4;
    const float* Wp = d.W + (size_t)(d.k0 + kq) * d.N + d.n0 + nq;
#pragma unroll
    for (int i = 0; i < 8; ++i) v[i] = __builtin_nontemporal_load((const f32x4*)(Wp + (size_t)(8 * i) * d.N));
}
__device__ __forceinline__ void titem_store(const TItem& d, int lane, const f32x4 (&v)[8], LAS float* scr) {
    { const int kq = lane >> 3, nq = (lane & 7) * 4;
#pragma unroll
      for (int i = 0; i < 8; ++i) { LAS float* p = scr + (8 * i + kq) * 33 + nq; p[0] = v[i].x; p[1] = v[i].y; p[2] = v[i].z; p[3] = v[i].w; } }
    asm volatile("s_waitcnt lgkmcnt(0)" ::: "memory");
    const int c = lane & 7;
#pragma unroll
    for (int j = 0; j < 4; ++j) { const int n = (lane >> 3) + 8 * j; const LAS float* s = scr + (8 * c) * 33 + n;
        u32x4 o; o.x = cvtpk(s[0 * 33], s[1 * 33]); o.y = cvtpk(s[2 * 33], s[3 * 33]); o.z = cvtpk(s[4 * 33], s[5 * 33]); o.w = cvtpk(s[6 * 33], s[7 * 33]);
        const int drow = d.mode13 ? d.dbase + 32 * (n >> 4) + (n & 15) : d.dbase + n;
        if (d.gate8) { int w0 = 0, w1 = 0;
            w0 = __builtin_amdgcn_cvt_pk_fp8_f32(s[0 * 33] * 64.f, s[1 * 33] * 64.f, w0, false); w0 = __builtin_amdgcn_cvt_pk_fp8_f32(s[2 * 33] * 64.f, s[3 * 33] * 64.f, w0, true);
            w1 = __builtin_amdgcn_cvt_pk_fp8_f32(s[4 * 33] * 64.f, s[5 * 33] * 64.f, w1, false); w1 = __builtin_amdgcn_cvt_pk_fp8_f32(s[6 * 33] * 64.f, s[7 * 33] * 64.f, w1, true);
            *(u32x2*)((unsigned char*)d.WT + (size_t)drow * d.K + d.k0 + 8 * c) = (u32x2){(unsigned)w0, (unsigned)w1}; }
        else *(u32x4*)(d.WT + (size_t)drow * d.K + d.k0 + 8 * c) = o; }
    asm volatile("s_waitcnt lgkmcnt(0)" ::: "memory");
}
__device__ __forceinline__ void convert_weights(const Args& a, int l, int gw, int NGW, int lane, LAS float* scr) {
    lane = opaque_tid() & 63;
    constexpr int NITEMS = 32 * 370 + 2 * 32 * 176 + 88 * 64 + 32 * 64 + 3 * 16 * 64 + 8 * 48 + 8 * 64;
    if (gw >= NITEMS) return;
    TItem cur = titem_get(a, l, gw); f32x4 vc[8]; titem_load(cur, lane, vc);
    for (int it = gw; it < NITEMS; it += NGW) {
        const int nx = it + NGW; const bool has = nx < NITEMS;
        TItem nxt = cur; f32x4 vn[8];
        if (has) { nxt = titem_get(a, l, nx); titem_load(nxt, lane, vn); }
        titem_store(cur, lane, vc, scr);
        if (has) { cur = nxt;
#pragma unroll
            for (int i = 0; i < 8; ++i) vc[i] = vn[i]; }
    }
}

__device__ __forceinline__ void mod_phase(const Args& a, unsigned char* lds, int bid, int G, int tid) {
    if (bid >= 192) return;
    const int wid = tid >> 6, lane = tid & 63;
    float* sv = (float*)lds;
    float* red = (float*)(lds + 9 * 2048 * 4);
    for (int i = tid; i < 9 * 2048; i += 512) { const int j = i >> 11, d = i & 2047; const float v = (j < 8) ? a.in[I_C][j * 2048 + d] : a.in[I_CCTX][d]; sv[i] = v * sigmoidf_(v); }
    __syncthreads();
    for (int item = bid; item < 192; item += G) {
    const int l = item / 96, e0 = (item % 96) * 128;
    const float* W = a.in[I_WADA] + (size_t)l * DM * MODW + e0 + 2 * lane;
    float acc[9][2];
#pragma unroll
    for (int j = 0; j < 9; ++j) { acc[j][0] = 0.f; acc[j][1] = 0.f; }
    const int dbeg = wid * 256;
    for (int d = dbeg; d < dbeg + 256; d += 16) {
        float2 w[16];
#pragma unroll
        for (int q = 0; q < 16; ++q) w[q] = *(const float2*)(W + (size_t)(d + q) * MODW);
#pragma unroll
        for (int q = 0; q < 16; ++q) {
#pragma unroll
            for (int j = 0; j < 9; ++j) { const float s = sv[j * 2048 + d + q]; acc[j][0] = fmaf(s, w[q].x, acc[j][0]); acc[j][1] = fmaf(s, w[q].y, acc[j][1]); }
            if ((q & 1) == 1) asm volatile("" ::: "memory"); }
    }
#pragma unroll
    for (int j = 0; j < 9; ++j) { red[((wid * 9 + j) * 2 + 0) * 64 + lane] = acc[j][0]; red[((wid * 9 + j) * 2 + 1) * 64 + lane] = acc[j][1]; }
    __syncthreads();
    float* mod = (float*)(a.ws + WS_MOD);
    for (int i = tid; i < 9 * 128; i += 512) { const int j = i >> 7, t = i & 127, ln = t >> 1, q = t & 1; float s = 0.f;
#pragma unroll
        for (int w = 0; w < 8; ++w) s += red[((w * 9 + j) * 2 + q) * 64 + ln];
        mod[(size_t)(l * 9 + j) * MODW + e0 + t] = s + a.in[I_BADA][l * MODW + e0 + t]; }
    __syncthreads();
    }
}

template <bool HAS_T, bool HAS_H>
__device__ __forceinline__ void row_phase(int bid, int G, int nrows, const float* xl_src, const float* xc_src, float* xl_dst, float* xc_dst,
                                          const bf16_t* T, const float* Tp, const float* modL, int gt_off, const float* g_post,
                                          const float* g_pre, const float* modN, int sh_off, int sc_off, bf16_t* H, unsigned char* H8, unsigned char* lds) {
    const int tid = opaque_tid(), lane = tid & 63, wave = tid >> 6;
    f32x4* P4 = (f32x4*)lds;
    for (int part = 0; part < 2; ++part) {
    int rb, re;
    if (part == 0) { const int per = (NLAT + G - 1) / G; rb = bid * per; re = min(rb + per, NLAT); }
    else { if (nrows <= NLAT) break; const int per = (nrows - NLAT + G - 1) / G; rb = NLAT + bid * per; re = min(rb + per, nrows); }
    for (int sb = rb; sb < re;) {
        const int j = sb < NLAT ? (sb >> 11) : 8;
        const int jend = j < 8 ? ((j + 1) << 11) : nrows, se = min(re, jend);
        __syncthreads();
        if constexpr (HAS_T) { P4[tid] = ((const f32x4*)(modL + (size_t)j * MODW + gt_off))[tid]; P4[512 + tid] = ((const f32x4*)g_post)[tid]; }
        if constexpr (HAS_H) { P4[1024 + tid] = ((const f32x4*)g_pre)[tid]; P4[1536 + tid] = ((const f32x4*)(modN + (size_t)j * MODW + sc_off))[tid]; P4[2048 + tid] = ((const f32x4*)(modN + (size_t)j * MODW + sh_off))[tid]; }
        __syncthreads();
        for (int r0 = sb + wave * 2; r0 < se; r0 += 16) {
            const bool two = (r0 + 1 < se); const int r1 = two ? r0 + 1 : r0;
            const bool lat = r0 < NLAT;
            const int c0 = r0 - NLAT, c1 = r1 - NLAT;
            const int a0 = lat ? ((r0 & ~2047) | ((r0 & 63) << 5) | ((r0 & 2047) >> 6)) : (NLAT + ((c0 & 7) << 8) + (c0 >> 3));
            const int a1 = lat ? ((r1 & ~2047) | ((r1 & 63) << 5) | ((r1 & 2047) >> 6)) : (NLAT + ((c1 & 7) << 8) + (c1 >> 3));
            const f32x4* s0 = (const f32x4*)(lat ? xl_src + (size_t)a0 * DM : xc_src + (size_t)(a0 - NLAT) * DM) + lane;
            const f32x4* s1 = (const f32x4*)(lat ? xl_src + (size_t)a1 * DM : xc_src + (size_t)(a1 - NLAT) * DM) + lane;
            f32x4 va[8], vb[8];
#pragma unroll
            for (int q = 0; q < 8; ++q) { va[q] = __builtin_nontemporal_load(s0 + 64 * q); vb[q] = __builtin_nontemporal_load(s1 + 64 * q); }
            if constexpr (HAS_T) {
                const u32x2* t0 = (const u32x2*)(T + (size_t)a0 * DM) + lane; const u32x2* t1 = (const u32x2*)(T + (size_t)a1 * DM) + lane;
                f32x4 fa[8], fb[8];
                if (lat || Tp == nullptr) {
#pragma unroll
                    for (int q = 0; q < 8; ++q) { const u32x2 ta = __builtin_nontemporal_load(t0 + 64 * q), tb = __builtin_nontemporal_load(t1 + 64 * q);
                        fa[q] = (f32x4){bflo(ta.x), bfhi(ta.x), bflo(ta.y), bfhi(ta.y)}; fb[q] = (f32x4){bflo(tb.x), bfhi(tb.x), bflo(tb.y), bfhi(tb.y)}; }
                } else {
                    const f32x4* p0 = (const f32x4*)(Tp + (size_t)(a0 - NLAT) * DM) + lane; const f32x4* p1 = (const f32x4*)(Tp + (size_t)(a1 - NLAT) * DM) + lane;
                    constexpr size_t SL = (size_t)NCTX * DM / 4;
                    f32x4 ua[8];
#pragma unroll
                    for (int q = 0; q < 8; ++q) { fa[q] = p0[64 * q]; ua[q] = p0[SL + 64 * q]; }
                    asm volatile("" ::: "memory");
#pragma unroll
                    for (int q = 0; q < 8; ++q) { fa[q] = fa[q] + ua[q]; fb[q] = p1[64 * q]; ua[q] = p0[2 * SL + 64 * q]; }
                    asm volatile("" ::: "memory");
#pragma unroll
                    for (int q = 0; q < 8; ++q) { fa[q] = fa[q] + ua[q]; ua[q] = p0[3 * SL + 64 * q]; }
                    asm volatile("" ::: "memory");
#pragma unroll
                    for (int q = 0; q < 8; ++q) { fa[q] = fa[q] + ua[q]; ua[q] = p1[SL + 64 * q]; }
                    asm volatile("" ::: "memory");
#pragma unroll
                    for (int q = 0; q < 8; ++q) { fb[q] = fb[q] + ua[q]; ua[q] = p1[2 * SL + 64 * q]; }
                    asm volatile("" ::: "memory");
#pragma unroll
                    for (int q = 0; q < 8; ++q) { fb[q] = fb[q] + ua[q]; ua[q] = p1[3 * SL + 64 * q]; }
                    asm volatile("" ::: "memory");
#pragma unroll
                    for (int q = 0; q < 8; ++q) fb[q] = fb[q] + ua[q];
                }
                float sa = 0.f, sbb = 0.f;
#pragma unroll
                for (int q = 0; q < 8; ++q) { sa += (fa[q].x * fa[q].x + fa[q].y * fa[q].y) + (fa[q].z * fa[q].z + fa[q].w * fa[q].w); sbb += (fb[q].x * fb[q].x + fb[q].y * fb[q].y) + (fb[q].z * fb[q].z + fb[q].w * fb[q].w); }
                const float ra = rsqrtf(wave_sum(sa) * (1.f / DM) + EPS), rbb = rsqrtf(wave_sum(sbb) * (1.f / DM) + EPS);
                f32x4* d0 = (f32x4*)(lat ? xl_dst + (size_t)a0 * DM : xc_dst + (size_t)(a0 - NLAT) * DM) + lane;
                f32x4* d1 = (f32x4*)(lat ? xl_dst + (size_t)a1 * DM : xc_dst + (size_t)(a1 - NLAT) * DM) + lane;
#pragma unroll
                for (int q = 0; q < 8; ++q) { const f32x4 w = P4[lane + 64 * q] * P4[512 + lane + 64 * q];
                    va[q] = va[q] + w * (fa[q] * ra); vb[q] = vb[q] + w * (fb[q] * rbb);
                    __builtin_nontemporal_store(va[q], d0 + 64 * q); if (two) __builtin_nontemporal_store(vb[q], d1 + 64 * q); }
            }
            if constexpr (HAS_H) {
                float sa = 0.f, sbb = 0.f;
#pragma unroll
                for (int q = 0; q < 8; ++q) { sa += (va[q].x * va[q].x + va[q].y * va[q].y) + (va[q].z * va[q].z + va[q].w * va[q].w); sbb += (vb[q].x * vb[q].x + vb[q].y * vb[q].y) + (vb[q].z * vb[q].z + vb[q].w * vb[q].w); }
                const float ra = rsqrtf(wave_sum(sa) * (1.f / DM) + EPS), rbb = rsqrtf(wave_sum(sbb) * (1.f / DM) + EPS);
                u32x2* h0 = (u32x2*)(H + (size_t)a0 * DM) + lane; u32x2* h1 = (u32x2*)(H + (size_t)a1 * DM) + lane;
#pragma unroll
                for (int q = 0; q < 8; ++q) { const f32x4 g = P4[1024 + lane + 64 * q] * (P4[1536 + lane + 64 * q] + 1.f), sh = P4[2048 + lane + 64 * q];
                    const f32x4 ha = (va[q] * ra) * g + sh, hb = (vb[q] * rbb) * g + sh;
                    u32x2 wa; wa.x = cvtpk(ha.x, ha.y); wa.y = cvtpk(ha.z, ha.w); h0[64 * q] = wa;
                    if (two) { u32x2 wb; wb.x = cvtpk(hb.x, hb.y); wb.y = cvtpk(hb.z, hb.w); h1[64 * q] = wb; }
                    if (H8) { int ea = 0, eb = 0;
                        ea = __builtin_amdgcn_cvt_pk_fp8_f32(ha.x, ha.y, ea, false); ea = __builtin_amdgcn_cvt_pk_fp8_f32(ha.z, ha.w, ea, true);
                        eb = __builtin_amdgcn_cvt_pk_fp8_f32(hb.x, hb.y, eb, false); eb = __builtin_amdgcn_cvt_pk_fp8_f32(hb.z, hb.w, eb, true);
                        ((int*)(H8 + (size_t)a0 * DM))[lane + 64 * q] = ea; if (two) ((int*)(H8 + (size_t)a1 * DM))[lane + 64 * q] = eb; } }
            }
        }
        sb = se;
    }
    }
    __syncthreads();
}

__device__ __forceinline__ float half_sum(float v) {
#pragma unroll
    for (int o = 1; o < 32; o <<= 1) v += __shfl_xor(v, o);
    return v;
}
__device__ __forceinline__ void prep_phase(const Args& a, int l, int gw, int NGW, int lane_in) {
    const int lane = opaque_tid() & 63, half = lane >> 5, hl = lane & 31;
    bf16_t* Z = (bf16_t*)(a.ws + WS_Z);
    const float* gqn = a.in[I_GQN] + l * 128; const float* gkn = a.in[I_GKN] + l * 128;
    const float* mqn = a.in[I_MQN] + l * 512; const float* mkvn = a.in[I_MKVN] + l * 512;
    constexpr float L2T = 13.287712379549449f;
    float gq[4], gk[4], gf[4];
#pragma unroll
    for (int e = 0; e < 4; ++e) { gq[e] = gqn[4 * hl + e]; gk[e] = gkn[4 * hl + e]; gf[e] = __builtin_amdgcn_exp2f(-(float)(((4 * hl) & 31) + e) * (L2T / 32.f)); }
    const bool is_x1 = ((hl & 15) < 8);
    const float kf0 = __builtin_amdgcn_exp2f(-(float)((2 * hl) & 15) * (L2T / 16.f)), kf1 = __builtin_amdgcn_exp2f(-(float)(((2 * hl) & 15) + 1) * (L2T / 16.f));
    for (int rp = gw; rp < MTOT / 2; rp += NGW) {
        const int r = 2 * rp + half;
        bf16_t* zr = Z + (size_t)r * LDZ;
        const bool lat = r < NLAT; const int s = r & 2047; const float prow = (float)(s >> 6), pcol = (float)(s & 63);
        const float pos = (hl >> 4) ? pcol : prow;
        float gc[4], gs[4];
#pragma unroll
        for (int e = 0; e < 4; ++e) { gc[e] = lat ? __cosf(pos * gf[e]) : 1.f; gs[e] = lat ? __sinf(pos * gf[e]) : 0.f; if (is_x1) gs[e] = -gs[e]; }
        u32x2 wq[10]; u32x4 wa[2], wb[2];
#pragma unroll
        for (int hh = 0; hh < 10; ++hh) wq[hh] = ((const u32x2*)(zr + (hh < 8 ? ZC_BQ + hh * 128 : ZC_BK + (hh - 8) * 128)))[hl];
#pragma unroll
        for (int w2 = 0; w2 < 2; ++w2) { const u32x4* p = (const u32x4*)(zr + (w2 ? ZC_CKV : ZC_CQ)) + 2 * hl; wa[w2] = p[0]; wb[w2] = p[1]; }
        const unsigned wk = ((const unsigned*)(zr + ZC_CKR))[hl];
        asm volatile("" ::: "memory");
        float ssq[10];
#pragma unroll
        for (int hh = 0; hh < 10; ++hh) { const float x0 = bflo(wq[hh].x), x1 = bfhi(wq[hh].x), x2 = bflo(wq[hh].y), x3 = bfhi(wq[hh].y); ssq[hh] = (x0 * x0 + x1 * x1) + (x2 * x2 + x3 * x3); }
#pragma unroll
        for (int o = 1; o < 32; o <<= 1)
#pragma unroll
            for (int hh = 0; hh < 10; ++hh) ssq[hh] += __shfl_xor(ssq[hh], o);
#pragma unroll
        for (int hh = 0; hh < 10; ++hh) {
            const float x[4] = { bflo(wq[hh].x), bfhi(wq[hh].x), bflo(wq[hh].y), bfhi(wq[hh].y) };
            const float rstd = rsqrtf(ssq[hh] * (1.f / 128.f) + EPS);
            float y[4], o[4];
#pragma unroll
            for (int e = 0; e < 4; ++e) y[e] = x[e] * rstd * (hh < 8 ? gq[e] : gk[e]);
#pragma unroll
            for (int e = 0; e < 4; ++e) { const float q = __shfl_xor(y[e], 8); o[e] = y[e] * gc[e] + q * gs[e]; }
            u32x2 ow; ow.x = cvtpk(o[0], o[1]); ow.y = cvtpk(o[2], o[3]);
            ((u32x2*)(zr + (hh < 8 ? ZC_BQ + hh * 128 : ZC_BK + (hh - 8) * 128)))[hl] = ow;
        }
#pragma unroll
        for (int w2 = 0; w2 < 2; ++w2) {
            u32x4* p = (u32x4*)(zr + (w2 ? ZC_CKV : ZC_CQ)) + 2 * hl; const float* g = (w2 ? mkvn : mqn) + 16 * hl;
            const u32x4 va = wa[w2], vb = wb[w2];
            float x[16] = { bflo(va.x), bfhi(va.x), bflo(va.y), bfhi(va.y), bflo(va.z), bfhi(va.z), bflo(va.w), bfhi(va.w), bflo(vb.x), bfhi(vb.x), bflo(vb.y), bfhi(vb.y), bflo(vb.z), bfhi(vb.z), bflo(vb.w), bfhi(vb.w) };
            float ss = 0.f;
#pragma unroll
            for (int e = 0; e < 16; ++e) ss += x[e] * x[e];
            const float rstd = rsqrtf(half_sum(ss) * (1.f / 512.f) + EPS);
#pragma unroll
            for (int e = 0; e < 16; ++e) x[e] = x[e] * rstd * g[e];
            u32x4 oa, ob; oa.x = cvtpk(x[0], x[1]); oa.y = cvtpk(x[2], x[3]); oa.z = cvtpk(x[4], x[5]); oa.w = cvtpk(x[6], x[7]);
            ob.x = cvtpk(x[8], x[9]); ob.y = cvtpk(x[10], x[11]); ob.z = cvtpk(x[12], x[13]); ob.w = cvtpk(x[14], x[15]);
            p[0] = oa; p[1] = ob;
        }
        {
            float c0 = lat ? __cosf(pos * kf0) : 1.f, s0 = lat ? __sinf(pos * kf0) : 0.f, c1 = lat ? __cosf(pos * kf1) : 1.f, s1 = lat ? __sinf(pos * kf1) : 0.f;
            if (is_x1) { s0 = -s0; s1 = -s1; }
            const float y0 = bflo(wk), y1 = bfhi(wk);
            const float q0 = __shfl_xor(y0, 8), q1 = __shfl_xor(y1, 8);
            if (lat) ((unsigned*)(zr + ZC_CKR))[hl] = cvtpk(y0 * c0 + q0 * s0, y1 * c1 + q1 * s1);
        }
    }
}

__device__ __forceinline__ void attn_phase(const Args& a, int l, bool ctx_out, int vcu, int G, char* lds) {
    const bf16_t* Z = (const bf16_t*)(a.ws + WS_Z); const bf16_t* QC = (const bf16_t*)(a.ws + WS_H); const bf16_t* KVC = (const bf16_t*)(a.ws + WS_KVC);
    bf16_t* O = (bf16_t*)(a.ws + WS_O);
    const float C128 = 0.08838834764831845f * 1.4426950408889634f, C192 = 0.07216878364870323f * 1.4426950408889634f;
    const float T128 = att::THR / 0.08838834764831845f, T192 = att::THR / 0.07216878364870323f;
    for (int uidx = vcu; uidx < 512; uidx += G) {
        const int b = (uidx & 255) >> 5, j = uidx & 31, rd = uidx >> 8, qb = j & 7;
        const size_t qrow = (size_t)b * SEQ + qb * 256;
        {
            const int kvh = rd, head = kvh * 4 + (j >> 3);
            att::UnitP P; P.Q = Z + qrow * LDZ + ZC_BQ + head * 128; P.ldq = LDZ; P.K1 = Z + ZC_BK + kvh * 128; P.ldk1 = LDZ; P.K2 = nullptr; P.ldk2 = 0;
            P.V = Z + ZC_BV + kvh * 128; P.ldv = LDZ; P.O = O + qrow * LDO + 1024 + head * 128; P.ldo = LDO;
            P.NT = 36; P.nlat = 32; P.row_lat0 = b * SEQ; P.row_ctx0 = NLAT + b * CTXL; P.C = C128; P.thr_raw = T128; P.rope_q = 0; P.qpos0 = 0; P.qgrow0 = 0; P.krow0 = 0;
            att::attn_unit<128, false>(P, lds);
        }
        const int head = rd * 4 + (j >> 3);
        {
            att::UnitP P; P.Q = QC + qrow * LDQC + head * 192; P.ldq = LDQC; P.K1 = KVC + head * 256; P.ldk1 = LDKVC; P.K2 = Z + ZC_CKR; P.ldk2 = LDZ;
            P.V = KVC + head * 256 + 128; P.ldv = LDKVC; P.O = O + qrow * LDO + 2048 + head * 128; P.ldo = LDO;
            P.NT = 36; P.nlat = 32; P.row_lat0 = b * SEQ; P.row_ctx0 = NLAT + b * CTXL; P.C = C192; P.thr_raw = T192; P.rope_q = 1; P.qpos0 = qb * 256; P.qgrow0 = 0; P.krow0 = 0;
            att::attn_unit<192, false>(P, lds);
        }
        {
            const int g0 = 4 * qb, krow0 = min(max(g0 - 4, 0), 24), klast = min(max(g0 + 3 - 4, 0), 24) + 7, nr = klast - krow0 + 1;
            float* rpbs = (float*)(lds + att::OFF_RPB);
            const float* rpb = a.in[I_RPB] + ((size_t)l * 8 + head) * 465;
            for (int i = opaque_tid(); i < 465; i += 512) rpbs[i] = rpb[i] * 11.313708498984761f;
            att::UnitP P; P.Q = Z + qrow * LDZ + ZC_AQ + head * 128; P.ldq = LDZ; P.K1 = Z + ZC_AK + head * 128; P.ldk1 = LDZ; P.K2 = nullptr; P.ldk2 = 0;
            P.V = Z + ZC_AV + head * 128; P.ldv = LDZ; P.O = O + qrow * LDO + head * 128; P.ldo = LDO;
            P.NT = nr + 4; P.nlat = nr; P.row_lat0 = b * SEQ + krow0 * 64; P.row_ctx0 = NLAT + b * CTXL; P.C = C128; P.thr_raw = T128; P.rope_q = 0; P.qpos0 = 0; P.qgrow0 = g0; P.krow0 = krow0;
            att::attn_unit<128, true>(P, lds);
        }
    }
    if (ctx_out) {
        for (int u = vcu; u < 192; u += G) {
            const int mixer = u / 64, b = (u % 64) >> 3, head = u & 7;
            const size_t qrow = (size_t)NLAT + (size_t)b * CTXL;
            att::UnitP P; P.NT = 4; P.nlat = 0; P.row_lat0 = 0; P.row_ctx0 = NLAT + b * CTXL; P.rope_q = 0; P.qpos0 = 0; P.qgrow0 = 0; P.krow0 = 0; P.K2 = nullptr; P.ldk2 = 0; P.ldo = LDO;
            if (mixer == 0) { P.Q = Z + qrow * LDZ + ZC_AQ + head * 128; P.ldq = LDZ; P.K1 = Z + ZC_AK + head * 128; P.ldk1 = LDZ; P.V = Z + ZC_AV + head * 128; P.ldv = LDZ;
                P.O = O + qrow * LDO + head * 128; P.C = C128; P.thr_raw = T128; att::attn_unit<128, false>(P, lds); }
            else if (mixer == 1) { const int kvh = head >> 2; P.Q = Z + qrow * LDZ + ZC_BQ + head * 128; P.ldq = LDZ; P.K1 = Z + ZC_BK + kvh * 128; P.ldk1 = LDZ; P.V = Z + ZC_BV + kvh * 128; P.ldv = LDZ;
                P.O = O + qrow * LDO + 1024 + head * 128; P.C = C128; P.thr_raw = T128; att::attn_unit<128, false>(P, lds); }
            else { P.Q = QC + qrow * LDQC + head * 192; P.ldq = LDQC; P.K1 = KVC + head * 256; P.ldk1 = LDKVC; P.K2 = Z + ZC_CKR; P.ldk2 = LDZ; P.V = KVC + head * 256 + 128; P.ldv = LDKVC;
                P.O = O + qrow * LDO + 2048 + head * 128; P.C = C192; P.thr_raw = T192; att::attn_unit<192, false>(P, lds); }
        }
    }
}

__global__ void __launch_bounds__(512, 2) fwd_megakernel(Args a) {
    extern __shared__ __attribute__((aligned(16))) unsigned char lds[];
    cg::grid_group grid = cg::this_grid();
    const int tid = threadIdx.x, lane = tid & 63, wave = __builtin_amdgcn_readfirstlane(tid >> 6);
    const int G = gridDim.x, bid = blockIdx.x;
    const int vcu = (G % 8 == 0) ? (bid % 8) * (G / 8) + bid / 8 : bid;
    const int gw = vcu * 8 + wave, NGW = G * 8;
    unsigned char* ws = a.ws;
    LAS unsigned char* ldsl = (LAS unsigned char*)lds;
    LAS float* scr = (LAS float*)(ldsl + wave * 16384);
    float* mod = (float*)(ws + WS_MOD); float* CX = (float*)(ws + WS_CX);
    bf16_t* H = (bf16_t*)(ws + WS_H); bf16_t* Z = (bf16_t*)(ws + WS_Z); bf16_t* QC = (bf16_t*)(ws + WS_H); bf16_t* KVC = (bf16_t*)(ws + WS_KVC);
    bf16_t* Y = (bf16_t*)(ws + WS_KVC); bf16_t* O = (bf16_t*)(ws + WS_O); bf16_t* T = (bf16_t*)(ws + WS_T); bf16_t* U = (bf16_t*)(ws + WS_U); float* TP = (float*)(ws + WS_TP);

    unsigned* barw = (unsigned*)(ws + WS_BAR);
    volatile LAS unsigned* bst = (volatile LAS unsigned*)(ldsl + 131072 + 64);
    if (bid == 0) for (int i = tid; i < XCD_BAR_WORDS; i += 512) barw[i] = 0u;
    if (tid < 2) bst[tid] = 0u;
    __syncthreads();
    mod_phase(a, lds, bid, G, tid);
    convert_weights(a, 0, gw, NGW, lane, scr);
    grid.sync();
    const XcdBarrier xb = xcd_barrier_post(barw, bst);
#define GSYNC() xcd_barrier(xb)
    row_phase<false, true>(bid, G, MTOT, a.in[I_X], a.in[I_CTX], nullptr, nullptr, nullptr, nullptr, nullptr, 0, nullptr, a.in[I_GPRE1], mod, 0, 2048, H, ws + WS_H8, lds);
    GSYNC();
    for (int l = 0; l < 2; ++l) {
        const bool ctx_out = (l == 0);
        const int nMr = ctx_out ? MTOT / 256 : NLAT / 256;
        const float* modL = mod + (size_t)l * 9 * MODW;
        { pg8::TileSched S; S.nM = ctx_out ? MTOT / 256 : NLAT / 256; S.nN = 23; S.nwg = S.nM * S.nN; S.G = G; S.c = bid; S.nsub = 1; S.A = (const char*)H; S.B = (const char*)(ws + WS_WIN);
          S.aT = (size_t)256 * DM * 2; S.bT = (size_t)256 * DM * 2; S.aS = 0; S.bS = 0; S.nx = ctx_out ? 0 : 104;
          S.pn_split = 16; S.pn_skip = 24; S.pn_boff = 0;
          pg8::EpiZ E{Z}; pg8::gemm_phase(ldsl, DM, DM, DM, S, E); }
        { pg8::TileSched S; S.nM = ctx_out ? MTOT / 256 : NLAT / 256; S.nN = 24; S.nwg = S.nM * S.nN; S.G = G; S.c = bid; S.nsub = 1; S.A = (const char*)(ws + WS_H8); S.B = (const char*)(ws + WS_WG8);
          S.aT = (size_t)256 * DM; S.bT = (size_t)256 * DM; S.aS = 0; S.bS = 0; S.nx = 0; S.pn_split = 0; S.pn_skip = 16; S.pn_boff = 16;
          pg8::EpiZ8 E{Z}; pg8::gemm_phase<true>(ldsl, DM / 2, DM / 2, DM / 2, S, E); }
        GSYNC();
        prep_phase(a, l, gw, NGW, lane);
        GSYNC();
        { pg8::DualSched S; S.G = G; S.c = bid; S.n0 = (MTOT / 256) * 6; S.n1 = (MTOT / 256) * 8; S.nN0 = 6; S.nN1 = 8;
          S.A0 = (const char*)(Z + ZC_CQ); S.A1 = (const char*)(Z + ZC_CKV); S.B0 = (const char*)(ws + WS_WUQ); S.B1 = (const char*)(ws + WS_WUKV);
          S.aT = (size_t)256 * LDZ * 2; S.bT = (size_t)256 * 512 * 2;
          pg8::EpiQKV E{QC, KVC, LDQC, LDKVC}; pg8::gemm_phase(ldsl, LDZ, 512, 512, S, E); }
        GSYNC();
        attn_phase(a, l, ctx_out, vcu, G, (char*)lds);
        GSYNC();
        { pg8::TileSched S; S.nM = nMr; S.nN = 8; S.nwg = S.nM * S.nN; S.G = G; S.c = bid; S.nsub = 3; S.A = (const char*)O; S.B = (const char*)(ws + WS_WBR);
          S.aT = (size_t)256 * LDO * 2; S.bT = (size_t)256 * 1024 * 2; S.aS = (size_t)1024 * 2; S.bS = (size_t)2048 * 1024 * 2; S.nx = 0; S.pn_split = 1 << 30; S.pn_skip = 0; S.pn_boff = 0;
          pg8::EpiMerge E{Y, Z}; pg8::gemm_phase(ldsl, LDO, 1024, 1024, S, E); }
        GSYNC();
        { pg8::TileSched S; S.nM = NLAT / 256; S.nN = 8; S.nwg = S.nM * S.nN; S.G = G; S.c = bid; S.nsub = 1; S.A = (const char*)Y; S.B = (const char*)(ws + WS_WO);
          S.aT = (size_t)256 * DM * 2; S.bT = (size_t)256 * DM * 2; S.aS = 0; S.bS = 0; S.nx = 0; S.pn_split = 1 << 30; S.pn_skip = 0; S.pn_boff = 0;
          pg8::EpiQKV E{T, T, DM, DM}; pg8::gemm_phase(ldsl, DM, DM, DM, S, E); }
        if (ctx_out) { pg8::CtxSplitSched S; S.G = G; S.c = bid; S.A = (const char*)Y; S.B = (const char*)(ws + WS_WO); S.aT = (size_t)256 * DM * 2; S.bT = (size_t)256 * DM * 2; S.kqB = (size_t)(DM / 4) * 2;
          pg8::EpiSlab E{TP}; pg8::gemm_phase(ldsl, DM, DM, DM / 4, S, E); }
        GSYNC();
        row_phase<true, true>(bid, G, ctx_out ? MTOT : NLAT, l == 0 ? a.in[I_X] : a.out, a.in[I_CTX], a.out, CX, T, ctx_out ? TP : nullptr, modL, 4096, a.in[I_GPOST1] + l * DM,
                              a.in[I_GPRE2] + l * DM, modL, 6144, 8192, H, nullptr, lds);
        GSYNC();
        { pg8::TileSched S; S.nM = nMr; S.nN = 2 * DFF / 256; S.nwg = S.nM * S.nN; S.G = G; S.c = bid; S.nsub = 1; S.A = (const char*)H; S.B = (const char*)(ws + WS_W13);
          S.aT = (size_t)256 * DM * 2; S.bT = (size_t)256 * DM * 2; S.aS = 0; S.bS = 0; S.nx = 0; S.pn_split = 1 << 30; S.pn_skip = 0; S.pn_boff = 0;
          pg8::EpiSwiglu E{U}; pg8::gemm_phase(ldsl, DM, DM, DM, S, E); }
        GSYNC();
        { pg8::TileSched S; S.nM = NLAT / 256; S.nN = 8; S.nwg = S.nM * S.nN; S.G = G; S.c = bid; S.nsub = 1; S.A = (const char*)U; S.B = (const char*)(ws + WS_W2);
          S.aT = (size_t)256 * DFF * 2; S.bT = (size_t)256 * DFF * 2; S.aS = 0; S.bS = 0; S.nx = 0; S.pn_split = 1 << 30; S.pn_skip = 0; S.pn_boff = 0;
          pg8::EpiQKV E{T, T, DM, DM}; pg8::gemm_phase(ldsl, DFF, DFF, DFF, S, E); }
        if (ctx_out) { pg8::CtxSplitSched S; S.G = G; S.c = bid; S.A = (const char*)U; S.B = (const char*)(ws + WS_W2); S.aT = (size_t)256 * DFF * 2; S.bT = (size_t)256 * DFF * 2; S.kqB = (size_t)(DFF / 4) * 2;
          pg8::EpiSlab E{TP}; pg8::gemm_phase(ldsl, DFF, DFF, DFF / 4, S, E); }
        GSYNC();
        if (l == 0) {
            row_phase<true, true>(bid, G, MTOT, a.out, CX, a.out, CX, T, TP, modL, 10240, a.in[I_GPOST2], a.in[I_GPRE1] + DM, mod + (size_t)9 * MODW, 0, 2048, H, ws + WS_H8, lds);
            convert_weights(a, 1, gw, NGW, lane, scr);
            GSYNC();
        } else {
            row_phase<true, false>(bid, G, NLAT, a.out, nullptr, a.out, nullptr, T, nullptr, modL, 10240, a.in[I_GPOST2] + DM, nullptr, nullptr, 0, 0, nullptr, nullptr, lds);
        }
    }
}

extern "C" void kernel_launch(void* const* d_in, const int* in_sizes, int n_in, void* d_out, int out_size, void* d_ws, size_t ws_size, hipStream_t stream) {
    static int grid = 0;
    if (grid == 0) {
        if (n_in != 25 || out_size != NLAT * DM || ws_size < WS_END) { fprintf(stderr, "kernel_launch: unexpected shapes: n_in %d out %d ws %zu (need %zu)\n", n_in, out_size, ws_size, (size_t)WS_END); grid = -1; return; }
        int dev = 0, cus = 0, per_cu = 0;
        if (hipGetDevice(&dev) != hipSuccess || hipDeviceGetAttribute(&cus, hipDeviceAttributeMultiprocessorCount, dev) != hipSuccess) { grid = -1; return; }
        if (hipFuncSetAttribute((const void*)fwd_megakernel, hipFuncAttributeMaxDynamicSharedMemorySize, LDS_BYTES) != hipSuccess) { fprintf(stderr, "kernel_launch: hipFuncSetAttribute failed\n"); grid = -1; return; }
        if (hipOccupancyMaxActiveBlocksPerMultiprocessor(&per_cu, (const void*)fwd_megakernel, 512, LDS_BYTES) != hipSuccess || per_cu < 1) { fprintf(stderr, "kernel_launch: occupancy query says %d\n", per_cu); per_cu = 1; }
        (void)hipGetLastError();
        grid = cus * 1;
    }
    if (grid < 0) return;
    Args a{};
    for (int i = 0; i < 25; ++i) a.in[i] = (const float*)d_in[i];
    a.out = (float*)d_out; a.ws = (unsigned char*)d_ws;
    void* args[] = {&a};
    hipError_t e = hipLaunchCooperativeKernel((const void*)fwd_megakernel, dim3(grid), dim3(512), args, LDS_BYTES, stream);
    if (e != hipSuccess) fprintf(stderr, "kernel_launch: cooperative launch failed: %s (grid %d)\n", hipGetErrorString(e), grid);
}
```

```cpp
#include <hip/hip_runtime.h>
#include <hip/hip_cooperative_groups.h>
#include <cstdio>
#include <cstdint>
namespace cg = cooperative_groups;

constexpr int DM = 2048, NB = 8, SEQ = 2048, CTXL = 256, NLAT = NB * SEQ, NCTX = NB * CTXL, MTOT = NLAT + NCTX;
constexpr int INW = 11840, LDZ = 11840, NZP = 12032, DFF = 5632, LDO = 3072, LDQC = 1536, LDKVC = 2112;
constexpr int MODW = 6 * DM;
constexpr float EPS = 1e-6f;
constexpr int ZC_AQ = 0, ZC_AK = 1024, ZC_AV = 2048, ZC_BQ = 3072, ZC_GA = 4096, ZC_BK = 10240, ZC_BV = 10496, ZC_CQ = 10752, ZC_CKV = 11264, ZC_CKR = 11776;
constexpr size_t WS_MOD = 0;
constexpr size_t WS_BAR = 901120;
constexpr size_t WS_CX = 1u << 20;
constexpr size_t WS_WIN = WS_CX + (size_t)NCTX * DM * 4;
constexpr size_t WS_WUQ = WS_WIN + (size_t)NZP * DM * 2;
constexpr size_t WS_WUKV = WS_WUQ + (size_t)1536 * 512 * 2;
constexpr size_t WS_WBR = WS_WUKV + (size_t)2048 * 512 * 2;
constexpr size_t WS_WO = WS_WBR + (size_t)3 * 2048 * 1024 * 2;
constexpr size_t WS_W13 = WS_WO + (size_t)2048 * 2048 * 2;
constexpr size_t WS_W2 = WS_W13 + (size_t)2 * DFF * DM * 2;
constexpr size_t WS_H = WS_W2 + (size_t)DM * DFF * 2;
constexpr size_t WS_Z = WS_H + (size_t)MTOT * DM * 2;
constexpr size_t WS_T = WS_Z;
constexpr size_t WS_U = WS_Z + (size_t)MTOT * DM * 4;
constexpr size_t WS_TP = WS_U + (size_t)MTOT * DFF * 2;
constexpr size_t WS_KVC = WS_Z + (size_t)MTOT * LDZ * 2;
constexpr size_t WS_O = WS_KVC + (size_t)MTOT * LDKVC * 2;
constexpr size_t WS_H8 = WS_O + (size_t)MTOT * LDO * 2;
constexpr size_t WS_WG8 = WS_H8 + (size_t)MTOT * DM;
constexpr size_t WS_END = WS_WG8 + (size_t)6144 * DM;
static_assert(WS_END <= 921975872ull, "workspace budget (sum of the inputs)");
static_assert(WS_TP + (size_t)4 * NCTX * DM * 4 <= WS_KVC, "overlay");
constexpr int LDS_BYTES = 147456;

typedef unsigned short bf16_t;
typedef short bf16x8 __attribute__((ext_vector_type(8)));
typedef short s16x4 __attribute__((ext_vector_type(4)));
typedef float f32x4 __attribute__((ext_vector_type(4)));
typedef float f32x16 __attribute__((ext_vector_type(16)));
typedef unsigned u32x4 __attribute__((ext_vector_type(4)));
typedef unsigned u32x2 __attribute__((ext_vector_type(2)));
typedef int i32x8 __attribute__((ext_vector_type(8)));
typedef int i32x4 __attribute__((ext_vector_type(4)));
#define LAS __attribute__((address_space(3)))

__device__ __forceinline__ int opaque_tid() { int t = threadIdx.x; asm volatile("" : "+v"(t)); return t; }
__device__ __forceinline__ unsigned cvtpk(float lo, float hi) { unsigned r; asm volatile("v_cvt_pk_bf16_f32 %0, %1, %2" : "=v"(r) : "v"(lo), "v"(hi)); return r; }
__device__ __forceinline__ float bf2f(unsigned short s) { return __uint_as_float(((unsigned)s) << 16); }
__device__ __forceinline__ float bflo(unsigned w) { return __uint_as_float(w << 16); }
__device__ __forceinline__ float bfhi(unsigned w) { return __uint_as_float(w & 0xffff0000u); }
__device__ __forceinline__ float wave_sum(float v) {
#pragma unroll
    for (int o = 1; o < 64; o <<= 1) v += __shfl_xor(v, o);
    return v;
}
__device__ __forceinline__ float sigmoidf_(float x) { return __builtin_amdgcn_rcpf(1.f + __builtin_amdgcn_exp2f(-1.4426950408889634f * x)); }

namespace pg8 {
constexpr int BM = 256, BK = 64, HALF = 128, HTB = HALF * BK * 2, STAGE_BYTES = 8 * HTB, NXCD = 8, WGM = 8;
__device__ __forceinline__ int lds_byte(int r, int c) { const int st = (r >> 4) * 2 + (c >> 5), rr = r & 15, cc = c & 31, ob = rr * 64 + cc * 2; return st * 1024 + (ob ^ (((ob >> 9) & 1) << 5)); }
__device__ __forceinline__ void stage_rc(int b, int& R, int& C) { const int st = b / 1024, sb = b % 1024, swz = sb ^ (((sb >> 9) & 1) << 5); R = (st >> 1) * 16 + swz / 64; C = (st & 1) * 32 + (swz % 64) / 2; }
__device__ __forceinline__ int perm32(int rho) { const int n = rho >> 4, i = rho & 15; return 8 * (i >> 2) + 4 * n + (i & 3); }
struct Unit { int pm, pn, sub; };

struct TileSched {
    int nM, nN, nwg, G, c, nsub; const char* A; const char* B; size_t aT, bT, aS, bS;
    int pn_split, pn_skip, pn_boff;
    int nx;
    __device__ __forceinline__ bool next(int i, Unit& u) const {
        const int ti = i / nsub; u.sub = i - ti * nsub;
        const long L = (long)ti * G + c;
        if (L >= nwg) { const int k = (int)(L - nwg); if (k >= nx) return false; const int t = k / 13, idx = k - t * 13; u.pm = 64 + t;
            u.pn = idx < 8 ? 4 + idx : (idx < 10 ? 32 + idx : (idx < 12 ? 34 + idx : 46)); return true; }
        int wgid = (int)L; { const int q = nwg / NXCD, r = nwg % NXCD, xcd = wgid % NXCD, off = wgid / NXCD; wgid = (xcd < r ? xcd * (q + 1) : r * (q + 1) + (xcd - r) * q) + off; }
        const int nig = WGM * nN, gid = wgid / nig, fm = gid * WGM, gsz = (nM - fm) < WGM ? (nM - fm) : WGM;
        u.pm = fm + ((wgid % nig) % gsz); const int idx = (wgid % nig) / gsz; u.pn = idx < pn_split ? idx : idx + pn_skip; return true;
    }
    __device__ __forceinline__ const char* ptrA(const Unit& u) const { return A + (size_t)u.pm * aT + (size_t)u.sub * aS; }
    __device__ __forceinline__ const char* ptrB(const Unit& u) const { return B + (size_t)(u.pn - pn_boff) * bT + (size_t)u.sub * bS; }
};
struct DualSched {
    int G, c, n0, n1, nN0, nN1; const char *A0, *A1, *B0, *B1; size_t aT, bT;
    __device__ __forceinline__ bool next(int i, Unit& u) const {
        int L = i * G + c;
        if (L < n0) { u.sub = 0; u.pm = L / nN0; u.pn = L - u.pm * nN0; return true; }
        L -= n0; if (L >= n1) return false;
        u.sub = 1; u.pm = L / nN1; u.pn = L - u.pm * nN1; return true;
    }
    __device__ __forceinline__ const char* ptrA(const Unit& u) const { return (u.sub ? A1 : A0) + (size_t)u.pm * aT; }
    __device__ __forceinline__ const char* ptrB(const Unit& u) const { return (u.sub ? B1 : B0) + (size_t)u.pn * bT; }
};

struct EpiZ {
    static constexpr bool PERM = true;
    bf16_t* Z;
    __device__ __forceinline__ void operator()(const f32x4 (&acc)[2][2][4][2], const Unit& u, int wr, int wc, int fr, int fq) const {
        const int row0 = u.pm * BM + wr * 64 + fr, col0 = u.pn * BM + wc * 32 + 8 * fq;
#pragma unroll
        for (int ai = 0; ai < 2; ++ai)
#pragma unroll
            for (int m = 0; m < 4; ++m) { bf16_t* rowp = Z + (size_t)(row0 + ai * HALF + m * 16) * LDZ + col0;
#pragma unroll
                for (int bj = 0; bj < 2; ++bj) { const f32x4 v0 = acc[ai][bj][m][0], v1 = acc[ai][bj][m][1];
                    u32x4 w; w.x = cvtpk(v0[0], v0[1]); w.y = cvtpk(v0[2], v0[3]); w.z = cvtpk(v1[0], v1[1]); w.w = cvtpk(v1[2], v1[3]);
                    if (col0 + bj * HALF < LDZ) *(u32x4*)(rowp + bj * HALF) = w; } }
    }
};
struct EpiZ8 {
    static constexpr bool PERM = false, ALIGN = true;
    bf16_t* Z;
    __device__ __forceinline__ void operator()(const f32x4 (&acc)[2][2][4][2], const Unit& u, int wr, int wc, int fr, int fq) const {
        const int row0 = u.pm * BM + wr * 64 + fr, col0 = u.pn * BM + wc * 32 + 4 * fq;
#pragma unroll
        for (int ai = 0; ai < 2; ++ai)
#pragma unroll
            for (int m = 0; m < 4; ++m) { bf16_t* rowp = Z + (size_t)(row0 + ai * HALF + m * 16) * LDZ + col0;
#pragma unroll
                for (int bj = 0; bj < 2; ++bj)
#pragma unroll
                    for (int n = 0; n < 2; ++n) { const f32x4 v = acc[ai][bj][m][n]; u32x2 w; w.x = cvtpk(v[0], v[1]); w.y = cvtpk(v[2], v[3]); *(u32x2*)(rowp + bj * HALF + n * 16) = w; } }
    }
};
struct EpiQKV {
    static constexpr bool PERM = true;
    bf16_t* O0; bf16_t* O1; int ld0, ld1;
    __device__ __forceinline__ void operator()(const f32x4 (&acc)[2][2][4][2], const Unit& u, int wr, int wc, int fr, int fq) const {
        bf16_t* O = u.sub ? O1 : O0; const int ldc = u.sub ? ld1 : ld0;
        const int row0 = u.pm * BM + wr * 64 + fr, col0 = u.pn * BM + wc * 32 + 8 * fq;
#pragma unroll
        for (int ai = 0; ai < 2; ++ai)
#pragma unroll
            for (int m = 0; m < 4; ++m) { bf16_t* rowp = O + (size_t)(row0 + ai * HALF + m * 16) * ldc + col0;
#pragma unroll
                for (int bj = 0; bj < 2; ++bj) { const f32x4 v0 = acc[ai][bj][m][0], v1 = acc[ai][bj][m][1];
                    u32x4 w; w.x = cvtpk(v0[0], v0[1]); w.y = cvtpk(v0[2], v0[3]); w.z = cvtpk(v1[0], v1[1]); w.w = cvtpk(v1[2], v1[3]);
                    *(u32x4*)(rowp + bj * HALF) = w; } }
    }
};
struct EpiMerge {
    static constexpr bool PERM = true;
    bf16_t* Y; const bf16_t* Z;
    __device__ __forceinline__ void operator()(const f32x4 (&acc)[2][2][4][2], const Unit& u, int wr, int wc, int fr, int fq) const {
        const int row0 = u.pm * BM + wr * 64 + fr, col0 = u.pn * BM + wc * 32 + 8 * fq;
        const bool rmw = (u.sub > 0);
#pragma unroll
        for (int ai = 0; ai < 2; ++ai) {
            u32x4 g[4][2], pv[4][2];
#pragma unroll
            for (int m = 0; m < 4; ++m) { const size_t row = (size_t)(row0 + ai * HALF + m * 16);
#pragma unroll
                for (int bj = 0; bj < 2; ++bj) { g[m][bj] = *(const u32x4*)(Z + row * LDZ + ZC_GA + 2048 * u.sub + col0 + bj * HALF);
                    pv[m][bj] = rmw ? *(const u32x4*)(Y + row * DM + col0 + bj * HALF) : (u32x4){0u, 0u, 0u, 0u}; } }
            asm volatile("" ::: "memory");
#pragma unroll
            for (int m = 0; m < 4; ++m) { bf16_t* yp = Y + (size_t)(row0 + ai * HALF + m * 16) * DM + col0;
#pragma unroll
                for (int bj = 0; bj < 2; ++bj) { const f32x4 a0 = acc[ai][bj][m][0], a1 = acc[ai][bj][m][1]; const u32x4 gg = g[m][bj], p = pv[m][bj];
                    float v[8] = { a0[0] * sigmoidf_(bflo(gg.x)), a0[1] * sigmoidf_(bfhi(gg.x)), a0[2] * sigmoidf_(bflo(gg.y)), a0[3] * sigmoidf_(bfhi(gg.y)), a1[0] * sigmoidf_(bflo(gg.z)), a1[1] * sigmoidf_(bfhi(gg.z)), a1[2] * sigmoidf_(bflo(gg.w)), a1[3] * sigmoidf_(bfhi(gg.w)) };
                    v[0] += bflo(p.x); v[1] += bfhi(p.x); v[2] += bflo(p.y); v[3] += bfhi(p.y); v[4] += bflo(p.z); v[5] += bfhi(p.z); v[6] += bflo(p.w); v[7] += bfhi(p.w);
                    u32x4 w; w.x = cvtpk(v[0], v[1]); w.y = cvtpk(v[2], v[3]); w.z = cvtpk(v[4], v[5]); w.w = cvtpk(v[6], v[7]);
                    *(u32x4*)(yp + bj * HALF) = w; } }
        }
    }
};
struct EpiSwiglu {
    static constexpr bool PERM = false;
    bf16_t* U;
    __device__ __forceinline__ void operator()(const f32x4 (&acc)[2][2][4][2], const Unit& u, int wr, int wc, int fr, int fq) const {
        const int row0 = u.pm * BM + wr * 64 + fr, col0 = u.pn * 128 + wc * 16 + 4 * fq;
#pragma unroll
        for (int ai = 0; ai < 2; ++ai)
#pragma unroll
            for (int m = 0; m < 4; ++m) { bf16_t* rowp = U + (size_t)(row0 + ai * HALF + m * 16) * DFF + col0;
#pragma unroll
                for (int bj = 0; bj < 2; ++bj) { const f32x4 a = acc[ai][bj][m][0], g = acc[ai][bj][m][1]; float o[4];
#pragma unroll
                    for (int j = 0; j < 4; ++j) o[j] = a[j] * sigmoidf_(a[j]) * g[j];
                    u32x2 w; w.x = cvtpk(o[0], o[1]); w.y = cvtpk(o[2], o[3]);
                    *(u32x2*)(rowp + bj * 64) = w; } }
    }
};

struct CtxSplitSched {
    int G, c; const char* A; const char* B; size_t aT, bT, kqB;
    __device__ __forceinline__ bool next(int i, Unit& u) const { const int L = i * G + c; if (L >= 256) return false; u.sub = L & 3; const int t = L >> 2; u.pm = 64 + (t >> 3); u.pn = t & 7; return true; }
    __device__ __forceinline__ const char* ptrA(const Unit& u) const { return A + (size_t)u.pm * aT + (size_t)u.sub * kqB; }
    __device__ __forceinline__ const char* ptrB(const Unit& u) const { return B + (size_t)u.pn * bT + (size_t)u.sub * kqB; }
};
struct EpiSlab {
    static constexpr bool PERM = false;
    float* C;
    __device__ __forceinline__ void operator()(const f32x4 (&acc)[2][2][4][2], const Unit& u, int wr, int wc, int fr, int fq) const {
        const int row0 = (u.pm - 64) * BM + wr * 64 + fr, col0 = u.pn * BM + wc * 32 + 4 * fq;
        float* Cs = C + (size_t)u.sub * NCTX * DM;
#pragma unroll
        for (int ai = 0; ai < 2; ++ai)
#pragma unroll
            for (int m = 0; m < 4; ++m) { float* rowp = Cs + (size_t)(row0 + ai * HALF + m * 16) * DM + col0;
#pragma unroll
                for (int bj = 0; bj < 2; ++bj)
#pragma unroll
                    for (int n = 0; n < 2; ++n) *(f32x4*)(rowp + bj * HALF + n * 16) = acc[ai][bj][m][n]; }
    }
};

template <bool F8 = false, class Epi, class Sched>
__device__ __forceinline__ void gemm_phase(LAS unsigned char* lds, const int lda, const int ldb, const int K, const Sched& S, const Epi& E) {
    const int tid = opaque_tid(), wid = __builtin_amdgcn_readfirstlane(tid >> 6), lane = tid & 63, wr = wid >> 2, wc = wid & 3, fr = lane & 15, fq = lane >> 4;
    const int nt = K / BK;
    unsigned voffA[2], voffB[2];
#pragma unroll
    for (int i = 0; i < 2; ++i) { int R, C; stage_rc(tid * 16 + i * 8192, R, C); const int Rb = Epi::PERM ? ((R & ~31) + perm32(R & 31)) : R;
        voffA[i] = (unsigned)(R * lda + C) * 2u; voffB[i] = (unsigned)(Rb * ldb + C) * 2u; }
    const size_t kstep = (size_t)(BK * 2);
    const size_t hstepA = (size_t)HALF * lda * 2, hstepB = (size_t)HALF * ldb * 2;
    const unsigned ldsw = (unsigned)wid * 1024u;
    const int aoff = lds_byte(wr * 64 + fr, fq * 8), boff = lds_byte(wc * 32 + fr, fq * 8);
#define PG8_SA(b, h) (((b) * 2 + (h)) * HTB)
#define PG8_SB(b, h) ((4 + (b) * 2 + (h)) * HTB)
#define PG8_STAGE(bufoff, gbase, voff) do { _Pragma("unroll") for (int _i = 0; _i < 2; ++_i) \
        __builtin_amdgcn_global_load_lds((const unsigned*)((const char*)(gbase) + (voff)[_i]), (LAS unsigned*)(lds + (bufoff) + ldsw + _i * 8192), 16, 0, 0); } while (0)
#define PG8_LDA(dst, b, h) do { if constexpr (F8) { _Pragma("unroll") for (int m = 0; m < 4; ++m) { const i32x4 _l = *(const LAS i32x4*)(lds + PG8_SA(b, h) + aoff + m * 2048), _u = *(const LAS i32x4*)(lds + PG8_SA(b, h) + aoff + m * 2048 + 1024); \
          dst##8[m] = __builtin_shufflevector(_l, _u, 0, 1, 2, 3, 4, 5, 6, 7); } } \
        else { _Pragma("unroll") for (int m = 0; m < 4; ++m) _Pragma("unroll") for (int k = 0; k < 2; ++k) dst[m][k] = *(const LAS bf16x8*)(lds + PG8_SA(b, h) + aoff + m * 2048 + k * 1024); } } while (0)
#define PG8_LDB(dst, b, h) do { if constexpr (F8) { _Pragma("unroll") for (int n = 0; n < 2; ++n) { const i32x4 _l = *(const LAS i32x4*)(lds + PG8_SB(b, h) + boff + n * 2048), _u = *(const LAS i32x4*)(lds + PG8_SB(b, h) + boff + n * 2048 + 1024); \
          dst##8[n] = __builtin_shufflevector(_l, _u, 0, 1, 2, 3, 4, 5, 6, 7); } } \
        else { _Pragma("unroll") for (int n = 0; n < 2; ++n) _Pragma("unroll") for (int k = 0; k < 2; ++k) dst[n][k] = *(const LAS bf16x8*)(lds + PG8_SB(b, h) + boff + n * 2048 + k * 1024); } } while (0)
#define PG8_MMA(ai, bj, At, Bt) do { __builtin_amdgcn_s_setprio(1); _Pragma("unroll") for (int m = 0; m < 4; ++m) _Pragma("unroll") for (int n = 0; n < 2; ++n) { \
        if constexpr (F8)   \
            asm volatile("v_mfma_scale_f32_16x16x128_f8f6f4 %0, %1, %2, %0, %3, %4 op_sel_hi:[0,0,0]" : "+v"(acc[ai][bj][m][n]) : "v"(Bt##8[n]), "v"(At##8[m]), "v"(f8s), "v"(f8s)); \
        else { _Pragma("unroll") for (int k = 0; k < 2; ++k) acc[ai][bj][m][n] = __builtin_amdgcn_mfma_f32_16x16x32_bf16(Bt[n][k], At[m][k], acc[ai][bj][m][n], 0, 0, 0); } } \
        __builtin_amdgcn_s_setprio(0); } while (0)
#define PG8_WAIT_V(n) asm volatile("s_waitcnt vmcnt(" #n ")" ::: "memory")
#define PG8_WAIT_L(n) asm volatile("s_waitcnt lgkmcnt(" #n ")" ::: "memory")
#define PG8_BAR __builtin_amdgcn_s_barrier()
#define PG8_SCHED __builtin_amdgcn_sched_barrier(0)
    Unit cur, nxt; int ui = 0;
    if (!S.next(0, cur)) return;
    f32x4 acc[2][2][4][2];
#pragma unroll
    for (int a = 0; a < 2; ++a)
#pragma unroll
        for (int b = 0; b < 2; ++b)
#pragma unroll
            for (int m = 0; m < 4; ++m)
#pragma unroll
                for (int n = 0; n < 2; ++n) acc[a][b][m][n] = (f32x4){0.f, 0.f, 0.f, 0.f};
    bf16x8 At[4][2], B0[2][2], B1[2][2];
    i32x8 At8[4], B08[2], B18[2];
    const int f8s = 0x7C7C7C7C;
    const char* cA = S.ptrA(cur); const char* cB = S.ptrB(cur);
    PG8_STAGE(PG8_SB(0, 0), cB, voffB); PG8_STAGE(PG8_SB(0, 1), cB + hstepB, voffB); PG8_STAGE(PG8_SA(0, 0), cA, voffA); PG8_STAGE(PG8_SA(0, 1), cA + hstepA, voffA);
    if (wr == 1) PG8_BAR;
    PG8_WAIT_V(2); PG8_BAR;
    PG8_STAGE(PG8_SB(1, 0), cB + kstep, voffB); PG8_STAGE(PG8_SA(1, 0), cA + kstep, voffA); PG8_STAGE(PG8_SB(1, 1), cB + hstepB + kstep, voffB);
    PG8_WAIT_V(6); PG8_BAR;
    for (;;) {
        const bool has_next = S.next(ui + 1, nxt);
        const char* nA = has_next ? S.ptrA(nxt) : cA; const char* nB = has_next ? S.ptrB(nxt) : cB;
        for (int t = 0; t < nt; t += 2) {
            const bool last = (t == nt - 2);
            const char* a1 = cA + (size_t)(t + 1) * kstep;
            const char* a2 = last ? nA : cA + (size_t)(t + 2) * kstep; const char* b2 = last ? nB : cB + (size_t)(t + 2) * kstep;
            const char* a3 = a2 + kstep; const char* b3 = b2 + kstep;
            PG8_LDB(B0, 0, 0); PG8_LDB(B1, 0, 1); PG8_SCHED; PG8_LDA(At, 0, 0); PG8_STAGE(PG8_SA(1, 1), a1 + hstepA, voffA);
            PG8_WAIT_V(8); PG8_WAIT_L(0); PG8_BAR; PG8_MMA(0, 0, At, B0); PG8_MMA(0, 1, At, B1); PG8_BAR; PG8_SCHED;
            PG8_LDA(At, 0, 1); PG8_STAGE(PG8_SB(0, 0), b2, voffB); PG8_STAGE(PG8_SB(0, 1), b2 + hstepB, voffB); PG8_STAGE(PG8_SA(0, 0), a2, voffA);
            PG8_WAIT_V(8); PG8_WAIT_L(0); PG8_BAR; PG8_MMA(1, 0, At, B0); PG8_MMA(1, 1, At, B1); PG8_BAR; PG8_SCHED;
            PG8_LDB(B0, 1, 0); PG8_LDB(B1, 1, 1); PG8_SCHED; PG8_LDA(At, 1, 0); PG8_STAGE(PG8_SA(0, 1), a2 + hstepA, voffA);
            PG8_WAIT_V(8); PG8_WAIT_L(0); PG8_BAR; PG8_MMA(0, 0, At, B0); PG8_MMA(0, 1, At, B1); PG8_BAR; PG8_SCHED;
            PG8_LDA(At, 1, 1); PG8_STAGE(PG8_SB(1, 0), b3, voffB); PG8_STAGE(PG8_SB(1, 1), b3 + hstepB, voffB); PG8_STAGE(PG8_SA(1, 0), a3, voffA);
            PG8_WAIT_V(8); PG8_WAIT_L(0); PG8_BAR; PG8_MMA(1, 0, At, B0); PG8_MMA(1, 1, At, B1); PG8_BAR; PG8_SCHED;
        }
        if (wr == 0) PG8_BAR;
        E(acc, cur, wr, wc, fr, fq);
        if (!has_next) break;
#pragma unroll
        for (int a = 0; a < 2; ++a)
#pragma unroll
            for (int b = 0; b < 2; ++b)
#pragma unroll
                for (int m = 0; m < 4; ++m)
#pragma unroll
                    for (int n = 0; n < 2; ++n) acc[a][b][m][n] = (f32x4){0.f, 0.f, 0.f, 0.f};
        cur = nxt; cA = nA; cB = nB; ++ui;
        if (wr == 1) PG8_BAR;
    }
    PG8_WAIT_V(0);
    PG8_BAR;
#undef PG8_SA
#undef PG8_SB
#undef PG8_STAGE
#undef PG8_LDA
#undef PG8_LDB
#undef PG8_MMA
#undef PG8_WAIT_V
#undef PG8_WAIT_L
#undef PG8_BAR
#undef PG8_SCHED
}
}

namespace att {
constexpr int SHM_V = 64 * 128 * 2;
constexpr int SHM_K = 64 * 192 * 2;
constexpr int OFF_K = 2 * SHM_V, OFF_WS = OFF_K + 2 * SHM_K, OFF_RPB = OFF_WS + 8 * 64 * 4, ATT_LDS = OFF_RPB + 2048;
constexpr float THR = 8.f;
__device__ __forceinline__ int crow(int r, int hi) { return (r & 3) + 8 * (r >> 2) + 4 * hi; }
__device__ __forceinline__ int v_st(int k, int c) { const int kk = (k & ~0xC) | ((k & 4) << 1) | ((k & 8) >> 1); return ((kk >> 3) * 4 + (c >> 5)) * 512 + ((kk & 7) * 32 + (c & 31)) * 2; }
__device__ __forceinline__ int v_rd_base(int lane) { return ((lane & 3) << 3) | (((lane >> 2) & 3) << 6) | (((lane >> 4) & 1) << 5) | (((lane >> 5) & 1) << 8); }
constexpr int v_rd_off(int d0, int ks, int half) { return d0 * 512 + ks * 4096 + half * 2048; }
template <int OFF> __device__ __forceinline__ s16x4 tr_read(int vb) {
    s16x4 r; asm volatile("ds_read_b64_tr_b16 %0, %1 offset:%2" : "=&v"(r) : "v"(vb), "i"(OFF) : "memory"); return r;
}
template <int D0> __device__ __forceinline__ void pv_one(f32x16& od, int vb, bf16x8 pa0, bf16x8 pa1, bf16x8 pa2, bf16x8 pa3) {
    const s16x4 l0 = tr_read<v_rd_off(D0, 0, 0)>(vb), h0 = tr_read<v_rd_off(D0, 0, 1)>(vb), l1 = tr_read<v_rd_off(D0, 1, 0)>(vb), h1 = tr_read<v_rd_off(D0, 1, 1)>(vb);
    const s16x4 l2 = tr_read<v_rd_off(D0, 2, 0)>(vb), h2 = tr_read<v_rd_off(D0, 2, 1)>(vb), l3 = tr_read<v_rd_off(D0, 3, 0)>(vb), h3 = tr_read<v_rd_off(D0, 3, 1)>(vb);
    asm volatile("s_waitcnt lgkmcnt(0)" ::: "memory"); __builtin_amdgcn_sched_barrier(0);
#define PK(L, H) (bf16x8){L[0], L[1], L[2], L[3], H[0], H[1], H[2], H[3]}
    od = __builtin_amdgcn_mfma_f32_32x32x16_bf16(pa0, PK(l0, h0), od, 0, 0, 0);
    od = __builtin_amdgcn_mfma_f32_32x32x16_bf16(pa1, PK(l1, h1), od, 0, 0, 0);
    od = __builtin_amdgcn_mfma_f32_32x32x16_bf16(pa2, PK(l2, h2), od, 0, 0, 0);
    od = __builtin_amdgcn_mfma_f32_32x32x16_bf16(pa3, PK(l3, h3), od, 0, 0, 0);
#undef PK
}

struct UnitP {
    const bf16_t* Q; int ldq;
    const bf16_t* K1; int ldk1;
    const bf16_t* K2; int ldk2;
    const bf16_t* V; int ldv;
    bf16_t* O; int ldo;
    int NT, nlat, row_lat0, row_ctx0;
    float C, thr_raw;
    int rope_q, qpos0;
    int qgrow0, krow0;
};

template <int DQK, bool NA>
__device__ __forceinline__ void attn_unit(const UnitP& P, char* lds) {
    constexpr int NQ = DQK / 16, KROWB = DQK * 2;
    const int tid = opaque_tid(), wid = __builtin_amdgcn_readfirstlane(tid >> 6), lane = tid & 63, r32 = lane & 31, hi = lane >> 5;
    char* V_lds = lds; char* K_lds = lds + OFF_K;
    float* wsf = (float*)(lds + OFF_WS) + wid * 64; float* li_l = wsf; float* al_l = wsf + 32;
    const float* rpbs = (const float*)(lds + OFF_RPB);
    float m_reg = -1e30f, l_reg = 0.f; f32x16 o[4];
#pragma unroll
    for (int d = 0; d < 4; ++d)
#pragma unroll
        for (int r = 0; r < 16; ++r) o[d][r] = 0.f;
    bf16x8 qr[NQ];
    { const bf16_t* Qw = P.Q + (size_t)(wid * 32 + r32) * P.ldq + hi * 8;
#pragma unroll
      for (int d0 = 0; d0 < NQ; ++d0) qr[d0] = *reinterpret_cast<const bf16x8*>(Qw + d0 * 16); }
    if constexpr (DQK == 192) {
        if (P.rope_q) {
            const int s = P.qpos0 + wid * 32 + r32; const float prow = (float)(s >> 6), pcol = (float)(s & 63);
#pragma unroll
            for (int e = 0; e < 8; ++e) {
                const float fr_ = __builtin_amdgcn_exp2f(-(float)(hi * 8 + e) * (13.287712379549449f / 16.f));
                const float ar = prow * fr_, ac = pcol * fr_;
                const float cr = __cosf(ar), sr = __sinf(ar), cc = __cosf(ac), sc = __sinf(ac);
                const float x1 = bf2f((unsigned short)qr[8][e]), x2 = bf2f((unsigned short)qr[9][e]), y1 = bf2f((unsigned short)qr[10][e]), y2 = bf2f((unsigned short)qr[11][e]);
                const unsigned w0 = cvtpk(x1 * cr - x2 * sr, x2 * cr + x1 * sr), w1 = cvtpk(y1 * cc - y2 * sc, y2 * cc + y1 * sc);
                qr[8][e] = (short)(w0 & 0xffffu); qr[9][e] = (short)(w0 >> 16); qr[10][e] = (short)(w1 & 0xffffu); qr[11][e] = (short)(w1 >> 16);
            }
        }
    }
    const int vb0 = (int)(uintptr_t)V_lds + v_rd_base(lane);
#define KSWZ(row, colB) ((row) * KROWB + ((colB) ^ (((row) & 7) << 4)))
#define TROW(t) ((t) < P.nlat ? P.row_lat0 + 64 * (t) : P.row_ctx0 + 64 * ((t) - P.nlat))
    LAS char* ldsl = (LAS char*)lds;
    constexpr int NKI = DQK / 64;
    int voffe[2]; const bf16_t* kbase[NKI]; int kld[NKI];
#pragma unroll
    for (int j = 0; j < 2; ++j) { const int X = (wid * 2 + j) * 1024 + lane * 16, st = X >> 9, kk = ((st >> 2) << 3) | ((X >> 6) & 7), c = ((st & 3) << 5) | ((X >> 1) & 31);
        const int k = (kk & ~0xC) | ((kk & 4) << 1) | ((kk & 8) >> 1); voffe[j] = k * P.ldv + c; }
#pragma unroll
    for (int j = 0; j < NKI; ++j) { const int X = (wid * NKI + j) * 1024 + lane * 16, row = X / KROWB, cb = X - row * KROWB, colB = cb ^ ((row & 7) << 4);
        if (DQK == 192 && colB >= 256) { kbase[j] = P.K2 + (size_t)row * P.ldk2 + ((colB - 256) >> 1); kld[j] = P.ldk2; }
        else { kbase[j] = P.K1 + (size_t)row * P.ldk1 + (colB >> 1); kld[j] = P.ldk1; } }
#define DMA(t, b) do { const size_t rb = (size_t)TROW(t); \
        _Pragma("unroll") for (int _j = 0; _j < 2; ++_j) __builtin_amdgcn_global_load_lds((const unsigned*)(P.V + rb * P.ldv + voffe[_j]), (LAS unsigned*)(ldsl + (b) * SHM_V + (wid * 2 + _j) * 1024), 16, 0, 0); \
        _Pragma("unroll") for (int _j = 0; _j < NKI; ++_j) __builtin_amdgcn_global_load_lds((const unsigned*)(kbase[_j] + rb * kld[_j]), (LAS unsigned*)(ldsl + OFF_K + (b) * SHM_K + (wid * NKI + _j) * 1024), 16, 0, 0); } while (0)
    const int qgrow = P.qgrow0 + (wid >> 1), qc = (wid & 1) * 32 + r32;
    const int r0w = min(max(qgrow - 4, 0), 24), c0 = min(max(qc - 8, 0), 48);
    DMA(0, 0); asm volatile("s_waitcnt vmcnt(0)" ::: "memory"); __syncthreads();
    for (int t = 0; t < P.NT; ++t) {
        if (t + 1 < P.NT) DMA(t + 1, (t + 1) & 1);
        bool act = true;
        if constexpr (NA) act = (t >= P.nlat) || ((unsigned)(P.krow0 + t - r0w) < 8u);
        if (act) {
            const char* Kb = K_lds + (t & 1) * SHM_K;
            f32x16 p0, p1;
#pragma unroll
            for (int r = 0; r < 16; ++r) { p0[r] = 0.f; p1[r] = 0.f; }
#pragma unroll
            for (int d0 = 0; d0 < NQ; ++d0) { const int cb = (d0 * 16 + hi * 8) * 2;
                const bf16x8 b0 = *reinterpret_cast<const bf16x8*>(Kb + KSWZ(r32, cb));
                const bf16x8 b1 = *reinterpret_cast<const bf16x8*>(Kb + KSWZ(32 + r32, cb));
                p0 = __builtin_amdgcn_mfma_f32_32x32x16_bf16(b0, qr[d0], p0, 0, 0, 0);
                p1 = __builtin_amdgcn_mfma_f32_32x32x16_bf16(b1, qr[d0], p1, 0, 0, 0); }
            if constexpr (NA) {
                if (t < P.nlat) {
                    const int dr = P.krow0 + t - qgrow + 7; const float* rp = rpbs + dr * 31;
                    int qcx = qc, c0x = c0, hix = hi; asm volatile("" : "+v"(qcx), "+v"(c0x), "+v"(hix));
#pragma unroll
                    for (int r = 0; r < 16; ++r) { const int kc0 = crow(r, hix), kc1 = 32 + kc0;
                        const float b0 = rp[min(max(kc0 - qcx + 15, 0), 30)], b1 = rp[min(max(kc1 - qcx + 15, 0), 30)];
                        p0[r] = ((unsigned)(kc0 - c0x) < 16u) ? p0[r] + b0 : -1e30f;
                        p1[r] = ((unsigned)(kc1 - c0x) < 16u) ? p1[r] + b1 : -1e30f;
                        if ((r & 3) == 3) asm volatile("" ::: "memory"); }
                }
            }
            float pmax = p0[0];
#pragma unroll
            for (int r = 1; r < 16; ++r) pmax = fmaxf(pmax, p0[r]);
#pragma unroll
            for (int r = 0; r < 16; ++r) pmax = fmaxf(pmax, p1[r]);
            { auto rr = __builtin_amdgcn_permlane32_swap(__float_as_uint(pmax), __float_as_uint(pmax), false, false);
              pmax = fmaxf(__uint_as_float(rr[0]), __uint_as_float(rr[1])); }
            float mn, alpha;
            if (__all(pmax - m_reg <= P.thr_raw)) { mn = m_reg; alpha = 1.f; }
            else { mn = fmaxf(m_reg, pmax); alpha = __builtin_amdgcn_exp2f((m_reg - mn) * P.C); m_reg = mn; }
            const float mnC = -mn * P.C;
            float ps = 0.f;
#pragma unroll
            for (int r = 0; r < 16; ++r) { p0[r] = __builtin_amdgcn_exp2f(fmaf(p0[r], P.C, mnC)); p1[r] = __builtin_amdgcn_exp2f(fmaf(p1[r], P.C, mnC)); ps += p0[r] + p1[r]; }
            { auto rr = __builtin_amdgcn_permlane32_swap(__float_as_uint(ps), __float_as_uint(ps), false, false);
              ps = __uint_as_float(rr[0]) + __uint_as_float(rr[1]); }
            l_reg = l_reg * alpha + ps;
            if (__any(alpha < 1.f)) { if (hi == 0) al_l[r32] = alpha; asm volatile("s_waitcnt lgkmcnt(0)" ::: "memory");
#pragma unroll
                for (int r = 0; r < 16; ++r) { const float a = al_l[crow(r, hi)];
#pragma unroll
                    for (int d = 0; d < 4; ++d) o[d][r] *= a; } }
            bf16x8 pa0, pa1, pa2, pa3;
#define PK4(Pv, BASE, OUT) do { unsigned a0 = cvtpk(Pv[BASE + 0], Pv[BASE + 1]), a1 = cvtpk(Pv[BASE + 2], Pv[BASE + 3]);   \
    unsigned b0 = cvtpk(Pv[BASE + 4], Pv[BASE + 5]), b1 = cvtpk(Pv[BASE + 6], Pv[BASE + 7]);                              \
    auto r0 = __builtin_amdgcn_permlane32_swap(a0, b0, false, false); auto r1 = __builtin_amdgcn_permlane32_swap(a1, b1, false, false); \
    u32x4 w = {r0[0], r1[0], r0[1], r1[1]}; OUT = *reinterpret_cast<bf16x8*>(&w); } while (0)
            PK4(p0, 0, pa0); PK4(p0, 8, pa1); PK4(p1, 0, pa2); PK4(p1, 8, pa3);
#undef PK4
            const int vb = vb0 + (t & 1) * SHM_V;
            pv_one<0>(o[0], vb, pa0, pa1, pa2, pa3); pv_one<1>(o[1], vb, pa0, pa1, pa2, pa3); pv_one<2>(o[2], vb, pa0, pa1, pa2, pa3); pv_one<3>(o[3], vb, pa0, pa1, pa2, pa3);
        }
        asm volatile("s_waitcnt vmcnt(0)" ::: "memory");
        __syncthreads();
    }
    if (hi == 0) li_l[r32] = l_reg;
    asm volatile("s_waitcnt lgkmcnt(0)" ::: "memory");
    bf16_t* Ow = P.O + (size_t)(wid * 32) * P.ldo;
#pragma unroll
    for (int r = 0; r < 16; ++r) { const int orow = crow(r, hi); const float rl = __builtin_amdgcn_rcpf(li_l[orow]);
#pragma unroll
        for (int d0 = 0; d0 < 4; ++d0) Ow[(size_t)orow * P.ldo + d0 * 32 + r32] = (bf16_t)(cvtpk(o[d0][r] * rl, 0.f) & 0xffffu); }
    __syncthreads();
#undef KSWZ
#undef TROW
#undef DMA
}
}

#define XB_TMO      128
#define XB_XCNT(j)  (256  + 64 * (j))
#define XB_XSUB(j)  (1280 + 64 * (j))
#define XB_XGEN(j)  (2304 + 64 * (j))
#define XB_TOP      3328
#define XB_TOPGEN   3392
#define XCD_BAR_WORDS 3456
#define XB_SPIN_CAP (1u << 22)
__device__ __forceinline__ unsigned xb_ld(unsigned* p)              { return __hip_atomic_load(p, __ATOMIC_RELAXED, __HIP_MEMORY_SCOPE_AGENT); }
__device__ __forceinline__ unsigned xb_add(unsigned* p, unsigned v) { return __hip_atomic_fetch_add(p, v, __ATOMIC_RELAXED, __HIP_MEMORY_SCOPE_AGENT); }
__device__ __forceinline__ unsigned xb_xcc_id() { return (unsigned)__builtin_amdgcn_readfirstlane((int)((unsigned)__builtin_amdgcn_s_getreg((3 << 11) | 20) & 0xFu)); }
#define XB_SPIN(cond, bar) do { unsigned _sp = 0; while (cond) { __builtin_amdgcn_s_sleep(1); \
    if ((++_sp & 255u) == 0u) { if (xb_ld(&(bar)[XB_TMO])) break; if (_sp > XB_SPIN_CAP) { atomicAdd(&(bar)[XB_TMO], 1u); break; } } } } while (0)
struct XcdBarrier { unsigned* bar; unsigned x; volatile LAS unsigned* st; };
__device__ __forceinline__ XcdBarrier xcd_barrier_post(unsigned* bar, volatile LAS unsigned* st) {
    XcdBarrier b; b.bar = bar; b.x = 0; b.st = st;
    if (threadIdx.x == 0) (void)xb_add(&bar[XB_XCNT(xb_xcc_id())], 1u);
    return b;
}
__device__ __forceinline__ void xcd_barrier_complete(unsigned* bar, unsigned x, unsigned& nloc, unsigned& nx) {
    const unsigned G = gridDim.x * gridDim.y * gridDim.z;
    unsigned sum, cnt, mine, sp = 0u;
    for (;;) {
        sum = 0u; cnt = 0u; mine = 0u;
#pragma unroll
        for (unsigned j = 0; j < 16; ++j) { const unsigned c = xb_ld(&bar[XB_XCNT(j)]); sum += c; cnt += (c > 0u) ? 1u : 0u; mine = (j == x) ? c : mine; }
        if (sum == G) break;
        __builtin_amdgcn_s_sleep(1);
        if ((++sp & 255u) == 0u) { if (xb_ld(&bar[XB_TMO])) break; if (sp > XB_SPIN_CAP) { atomicAdd(&bar[XB_TMO], 1u); break; } }
    }
    nloc = mine > 0u ? mine : 1u; nx = cnt > 0u ? cnt : 1u;
}
__device__ __forceinline__ void xcd_barrier(const XcdBarrier& b) {
    asm volatile("s_waitcnt vmcnt(0)" ::: "memory");
    __syncthreads();
    if (threadIdx.x == 0) {
        unsigned* bar = b.bar; const unsigned bx = xb_xcc_id();
        __builtin_amdgcn_s_waitcnt(0);
        unsigned nloc = b.st[0], nx = b.st[1];
        if (nloc == 0u) { xcd_barrier_complete(bar, bx, nloc, nx); b.st[0] = nloc; b.st[1] = nx; }
        const unsigned old = xb_add(&bar[XB_XSUB(bx)], 1u);
        const unsigned gen = old / nloc;
        if (old + 1u == (gen + 1u) * nloc) {
            __builtin_amdgcn_fence(__ATOMIC_RELEASE, "agent");
            asm volatile("s_waitcnt vmcnt(0)" ::: "memory");
            const unsigned og = xb_add(&bar[XB_TOP], 1u);
            const unsigned tg = og / nx;
            if (og + 1u == (tg + 1u) * nx) xb_add(&bar[XB_TOPGEN], 1u);
            else XB_SPIN(xb_ld(&bar[XB_TOPGEN]) == tg, bar);
            __builtin_amdgcn_fence(__ATOMIC_ACQUIRE, "agent");
            xb_add(&bar[XB_XGEN(bx)], 1u);
            asm volatile("s_waitcnt vmcnt(0)" ::: "memory");
        } else {
            XB_SPIN(xb_ld(&bar[XB_XGEN(bx)]) == gen, bar);
            __builtin_amdgcn_fence(__ATOMIC_ACQUIRE, "agent");
            asm volatile("s_waitcnt vmcnt(0)" ::: "memory");
        }
    }
    __syncthreads();
}

struct Args { const float* in[25]; float* out; unsigned char* ws; };
enum { I_X = 0, I_C, I_CTX, I_CCTX, I_WADA, I_BADA, I_GPRE1, I_GPOST1, I_GPRE2, I_GPOST2, I_WIN, I_RPB, I_GQN, I_GKN, I_MQN, I_MKVN, I_WUQ, I_WUKV, I_WBRA, I_WBRB, I_WBRC, I_WO, I_WFF1, I_WFF3, I_WFF2 };

struct TItem { const float* W; bf16_t* WT; int K, N, k0, n0, dbase; bool mode13, gate8; };
__device__ __forceinline__ TItem titem_get(const Args& a, int l, int it) {
    unsigned char* ws = a.ws; TItem d;
    constexpr int I_IN = 32 * 370, I_13 = 32 * 176, I_2 = 88 * 64, I_O = 32 * 64, I_BR = 16 * 64, I_UQ = 8 * 48;
    int r = it; d.mode13 = false; d.gate8 = false;
    if (r < I_IN) { const int kb = r / 370, nb = r % 370, n0 = nb * 32; d.W = a.in[I_WIN] + (size_t)l * DM * INW; d.K = DM; d.N = INW; d.WT = (bf16_t*)(ws + WS_WIN);
        d.k0 = kb * 64; d.n0 = n0; d.dbase = n0 < 4096 ? n0 : (n0 < 5696 ? n0 + 6144 : n0 - 1600);
        if (n0 >= 5696) { d.gate8 = true; d.dbase = n0 - 5696; d.WT = (bf16_t*)(ws + WS_WG8); }
        return d; }
    r -= I_IN;
    if (r < 2 * I_13) { const int which = r / I_13; r -= which * I_13; const int kb = r / 176, nb = r % 176; d.W = a.in[which ? I_WFF3 : I_WFF1] + (size_t)l * DM * DFF; d.K = DM; d.N = DFF; d.WT = (bf16_t*)(ws + WS_W13);
        d.k0 = kb * 64; d.n0 = nb * 32; d.dbase = 64 * nb + 16 * which; d.mode13 = true; return d; }
    r -= 2 * I_13;
    if (r < I_2) { const int kb = r / 64, nb = r % 64; d.W = a.in[I_WFF2] + (size_t)l * DFF * DM; d.K = DFF; d.N = DM; d.WT = (bf16_t*)(ws + WS_W2); d.k0 = kb * 64; d.n0 = nb * 32; d.dbase = nb * 32; return d; }
    r -= I_2;
    if (r < I_O) { const int kb = r / 64, nb = r % 64; d.W = a.in[I_WO] + (size_t)l * DM * DM; d.K = DM; d.N = DM; d.WT = (bf16_t*)(ws + WS_WO); d.k0 = kb * 64; d.n0 = nb * 32; d.dbase = nb * 32; return d; }
    r -= I_O;
    if (r < 3 * I_BR) { const int br = r / I_BR; r -= br * I_BR; const int kb = r / 64, nb = r % 64; d.W = a.in[I_WBRA + br] + (size_t)l * 1024 * DM; d.K = 1024; d.N = DM; d.WT = (bf16_t*)(ws + WS_WBR) + (size_t)br * 2048 * 1024;
        d.k0 = kb * 64; d.n0 = nb * 32; d.dbase = nb * 32; return d; }
    r -= 3 * I_BR;
    if (r < I_UQ) { const int kb = r / 48, nb = r % 48; d.W = a.in[I_WUQ] + (size_t)l * 512 * 1536; d.K = 512; d.N = 1536; d.WT = (bf16_t*)(ws + WS_WUQ); d.k0 = kb * 64; d.n0 = nb * 32; d.dbase = nb * 32; return d; }
    r -= I_UQ;
    { const int kb = r / 64, nb = r % 64; d.W = a.in[I_WUKV] + (size_t)l * 512 * 2048; d.K = 512; d.N = 2048; d.WT = (bf16_t*)(ws + WS_WUKV); d.k0 = kb * 64; d.n0 = nb * 32; d.dbase = nb * 32; return d; }
}
__device__ __forceinline__ void titem_load(const TItem& d, int lane, f32x4 (&v)[8]) {
    const int kq = lane >> 3, nq = (lane & 7) * 4;
    const float* Wp = d.W + (size_t)(d.k0 + kq) * d.N + d.n0 + nq;
#pragma unroll
    for (int i = 0; i < 8; ++i) v[i] = __builtin_nontemporal_load((const f32x4*)(Wp + (size_t)(8 * i) * d.N));
}
__device__ __forceinline__ void titem_store(const TItem& d, int lane, const f32x4 (&v)[8], LAS float* scr) {
    { const int kq = lane >> 3, nq = (lane & 7) * 4;
#pragma unroll
      for (int i = 0; i < 8; ++i) { LAS float* p = scr + (8 * i + kq) * 33 + nq; p[0] = v[i].x; p[1] = v[i].y; p[2] = v[i].z; p[3] = v[i].w; } }
    asm volatile("s_waitcnt lgkmcnt(0)" ::: "memory");
    const int c = lane & 7;
#pragma unroll
    for (int j = 0; j < 4; ++j) { const int n = (lane >> 3) + 8 * j; const LAS float* s = scr + (8 * c) * 33 + n;
        u32x4 o; o.x = cvtpk(s[0 * 33], s[1 * 33]); o.y = cvtpk(s[2 * 33], s[3 * 33]); o.z = cvtpk(s[4 * 33], s[5 * 33]); o.w = cvtpk(s[6 * 33], s[7 * 33]);
        const int drow = d.mode13 ? d.dbase + 32 * (n >> 4) + (n & 15) : d.dbase + n;
        if (d.gate8) { int w0 = 0, w1 = 0;
            w0 = __builtin_amdgcn_cvt_pk_fp8_f32(s[0 * 33] * 64.f, s[1 * 33] * 64.f, w0, false); w0 = __builtin_amdgcn_cvt_pk_fp8_f32(s[2 * 33] * 64.f, s[3 * 33] * 64.f, w0, true);
            w1 = __builtin_amdgcn_cvt_pk_fp8_f32(s[4 * 33] * 64.f, s[5 * 33] * 64.f, w1, false); w1 = __builtin_amdgcn_cvt_pk_fp8_f32(s[6 * 33] * 64.f, s[7 * 33] * 64.f, w1, true);
            *(u32x2*)((unsigned char*)d.WT + (size_t)drow * d.K + d.k0 + 8 * c) = (u32x2){(unsigned)w0, (unsigned)w1}; }
        else *(u32x4*)(d.WT + (size_t)drow * d.K + d.k0 + 8 * c) = o; }
    asm volatile("s_waitcnt lgkmcnt(0)" ::: "memory");
}
__device__ __forceinline__ void convert_weights(const Args& a, int l, int gw, int NGW, int lane, LAS float* scr) {
    lane = opaque_tid() & 63;
    constexpr int NITEMS = 32 * 370 + 2 * 32 * 176 + 88 * 64 + 32 * 64 + 3 * 16 * 64 + 8 * 48 + 8 * 64;
    if (gw >= NITEMS) return;
    TItem cur = titem_get(a, l, gw); f32x4 vc[8]; titem_load(cur, lane, vc);
    for (int it = gw; it < NITEMS; it += NGW) {
        const int nx = it + NGW; const bool has = nx < NITEMS;
        TItem nxt = cur; f32x4 vn[8];
        if (has) { nxt = titem_get(a, l, nx); titem_load(nxt, lane, vn); }
        titem_store(cur, lane, vc, scr);
        if (has) { cur = nxt;
#pragma unroll
            for (int i = 0; i < 8; ++i) vc[i] = vn[i]; }
    }
}

__device__ __forceinline__ void mod_phase(const Args& a, unsigned char* lds, int bid, int G, int tid) {
    if (bid >= 192) return;
    const int wid = tid >> 6, lane = tid & 63;
    float* sv = (float*)lds;
    float* red = (float*)(lds + 9 * 2048 * 4);
    for (int i = tid; i < 9 * 2048; i += 512) { const int j = i >> 11, d = i & 2047; const float v = (j < 8) ? a.in[I_C][j * 2048 + d] : a.in[I_CCTX][d]; sv[i] = v * sigmoidf_(v); }
    __syncthreads();
    for (int item = bid; item < 192; item += G) {
    const int l = item / 96, e0 = (item % 96) * 128;
    const float* W = a.in[I_WADA] + (size_t)l * DM * MODW + e0 + 2 * lane;
    float acc[9][2];
#pragma unroll
    for (int j = 0; j < 9; ++j) { acc[j][0] = 0.f; acc[j][1] = 0.f; }
    const int dbeg = wid * 256;
    for (int d = dbeg; d < dbeg + 256; d += 16) {
        float2 w[16];
#pragma unroll
        for (int q = 0; q < 16; ++q) w[q] = *(const float2*)(W + (size_t)(d + q) * MODW);
#pragma unroll
        for (int q = 0; q < 16; ++q) {
#pragma unroll
            for (int j = 0; j < 9; ++j) { const float s = sv[j * 2048 + d + q]; acc[j][0] = fmaf(s, w[q].x, acc[j][0]); acc[j][1] = fmaf(s, w[q].y, acc[j][1]); }
            if ((q & 1) == 1) asm volatile("" ::: "memory"); }
    }
#pragma unroll
    for (int j = 0; j < 9; ++j) { red[((wid * 9 + j) * 2 + 0) * 64 + lane] = acc[j][0]; red[((wid * 9 + j) * 2 + 1) * 64 + lane] = acc[j][1]; }
    __syncthreads();
    float* mod = (float*)(a.ws + WS_MOD);
    for (int i = tid; i < 9 * 128; i += 512) { const int j = i >> 7, t = i & 127, ln = t >> 1, q = t & 1; float s = 0.f;
#pragma unroll
        for (int w = 0; w < 8; ++w) s += red[((w * 9 + j) * 2 + q) * 64 + ln];
        mod[(size_t)(l * 9 + j) * MODW + e0 + t] = s + a.in[I_BADA][l * MODW + e0 + t]; }
    __syncthreads();
    }
}

template <bool HAS_T, bool HAS_H>
__device__ __forceinline__ void row_phase(int bid, int G, int nrows, const float* xl_src, const float* xc_src, float* xl_dst, float* xc_dst,
                                          const bf16_t* T, const float* Tp, const float* modL, int gt_off, const float* g_post,
                                          const float* g_pre, const float* modN, int sh_off, int sc_off, bf16_t* H, unsigned char* H8, unsigned char* lds) {
    const int tid = opaque_tid(), lane = tid & 63, wave = tid >> 6;
    f32x4* P4 = (f32x4*)lds;
    for (int part = 0; part < 2; ++part) {
    int rb, re;
    if (part == 0) { const int per = (NLAT + G - 1) / G; rb = bid * per; re = min(rb + per, NLAT); }
    else { if (nrows <= NLAT) break; const int per = (nrows - NLAT + G - 1) / G; rb = NLAT + bid * per; re = min(rb + per, nrows); }
    for (int sb = rb; sb < re;) {
        const int j = sb < NLAT ? (sb >> 11) : 8;
        const int jend = j < 8 ? ((j + 1) << 11) : nrows, se = min(re, jend);
        __syncthreads();
        if constexpr (HAS_T) { P4[tid] = ((const f32x4*)(modL + (size_t)j * MODW + gt_off))[tid]; P4[512 + tid] = ((const f32x4*)g_post)[tid]; }
        if constexpr (HAS_H) { P4[1024 + tid] = ((const f32x4*)g_pre)[tid]; P4[1536 + tid] = ((const f32x4*)(modN + (size_t)j * MODW + sc_off))[tid]; P4[2048 + tid] = ((const f32x4*)(modN + (size_t)j * MODW + sh_off))[tid]; }
        __syncthreads();
        for (int r0 = sb + wave * 2; r0 < se; r0 += 16) {
            const bool two = (r0 + 1 < se); const int r1 = two ? r0 + 1 : r0;
            const bool lat = r0 < NLAT;
            const f32x4* s0 = (const f32x4*)(lat ? xl_src + (size_t)r0 * DM : xc_src + (size_t)(r0 - NLAT) * DM) + lane;
            const f32x4* s1 = (const f32x4*)(lat ? xl_src + (size_t)r1 * DM : xc_src + (size_t)(r1 - NLAT) * DM) + lane;
            f32x4 va[8], vb[8];
#pragma unroll
            for (int q = 0; q < 8; ++q) { va[q] = __builtin_nontemporal_load(s0 + 64 * q); vb[q] = __builtin_nontemporal_load(s1 + 64 * q); }
            if constexpr (HAS_T) {
                const u32x2* t0 = (const u32x2*)(T + (size_t)r0 * DM) + lane; const u32x2* t1 = (const u32x2*)(T + (size_t)r1 * DM) + lane;
                f32x4 fa[8], fb[8];
                if (lat || Tp == nullptr) {
#pragma unroll
                    for (int q = 0; q < 8; ++q) { const u32x2 ta = __builtin_nontemporal_load(t0 + 64 * q), tb = __builtin_nontemporal_load(t1 + 64 * q);
                        fa[q] = (f32x4){bflo(ta.x), bfhi(ta.x), bflo(ta.y), bfhi(ta.y)}; fb[q] = (f32x4){bflo(tb.x), bfhi(tb.x), bflo(tb.y), bfhi(tb.y)}; }
                } else {
                    const f32x4* p0 = (const f32x4*)(Tp + (size_t)(r0 - NLAT) * DM) + lane; const f32x4* p1 = (const f32x4*)(Tp + (size_t)(r1 - NLAT) * DM) + lane;
                    constexpr size_t SL = (size_t)NCTX * DM / 4;
                    f32x4 ua[8];
#pragma unroll
                    for (int q = 0; q < 8; ++q) { fa[q] = p0[64 * q]; ua[q] = p0[SL + 64 * q]; }
                    asm volatile("" ::: "memory");
#pragma unroll
                    for (int q = 0; q < 8; ++q) { fa[q] = fa[q] + ua[q]; fb[q] = p1[64 * q]; ua[q] = p0[2 * SL + 64 * q]; }
                    asm volatile("" ::: "memory");
#pragma unroll
                    for (int q = 0; q < 8; ++q) { fa[q] = fa[q] + ua[q]; ua[q] = p0[3 * SL + 64 * q]; }
                    asm volatile("" ::: "memory");
#pragma unroll
                    for (int q = 0; q < 8; ++q) { fa[q] = fa[q] + ua[q]; ua[q] = p1[SL + 64 * q]; }
                    asm volatile("" ::: "memory");
#pragma unroll
                    for (int q = 0; q < 8; ++q) { fb[q] = fb[q] + ua[q]; ua[q] = p1[2 * SL + 64 * q]; }
                    asm volatile("" ::: "memory");
#pragma unroll
                    for (int q = 0; q < 8; ++q) { fb[q] = fb[q] + ua[q]; ua[q] = p1[3 * SL + 64 * q]; }
                    asm volatile("" ::: "memory");
#pragma unroll
                    for (int q = 0; q < 8; ++q) fb[q] = fb[q] + ua[q];
                }
                float sa = 0.f, sbb = 0.f;
#pragma unroll
                for (int q = 0; q < 8; ++q) { sa += (fa[q].x * fa[q].x + fa[q].y * fa[q].y) + (fa[q].z * fa[q].z + fa[q].w * fa[q].w); sbb += (fb[q].x * fb[q].x + fb[q].y * fb[q].y) + (fb[q].z * fb[q].z + fb[q].w * fb[q].w); }
                const float ra = rsqrtf(wave_sum(sa) * (1.f / DM) + EPS), rbb = rsqrtf(wave_sum(sbb) * (1.f / DM) + EPS);
                f32x4* d0 = (f32x4*)(lat ? xl_dst + (size_t)r0 * DM : xc_dst + (size_t)(r0 - NLAT) * DM) + lane;
                f32x4* d1 = (f32x4*)(lat ? xl_dst + (size_t)r1 * DM : xc_dst + (size_t)(r1 - NLAT) * DM) + lane;
#pragma unroll
                for (int q = 0; q < 8; ++q) { const f32x4 w = P4[lane + 64 * q] * P4[512 + lane + 64 * q];
                    va[q] = va[q] + w * (fa[q] * ra); vb[q] = vb[q] + w * (fb[q] * rbb);
                    __builtin_nontemporal_store(va[q], d0 + 64 * q); if (two) __builtin_nontemporal_store(vb[q], d1 + 64 * q); }
            }
            if constexpr (HAS_H) {
                float sa = 0.f, sbb = 0.f;
#pragma unroll
                for (int q = 0; q < 8; ++q) { sa += (va[q].x * va[q].x + va[q].y * va[q].y) + (va[q].z * va[q].z + va[q].w * va[q].w); sbb += (vb[q].x * vb[q].x + vb[q].y * vb[q].y) + (vb[q].z * vb[q].z + vb[q].w * vb[q].w); }
                const float ra = rsqrtf(wave_sum(sa) * (1.f / DM) + EPS), rbb = rsqrtf(wave_sum(sbb) * (1.f / DM) + EPS);
                u32x2* h0 = (u32x2*)(H + (size_t)r0 * DM) + lane; u32x2* h1 = (u32x2*)(H + (size_t)r1 * DM) + lane;
#pragma unroll
                for (int q = 0; q < 8; ++q) { const f32x4 g = P4[1024 + lane + 64 * q] * (P4[1536 + lane + 64 * q] + 1.f), sh = P4[2048 + lane + 64 * q];
                    const f32x4 ha = (va[q] * ra) * g + sh, hb = (vb[q] * rbb) * g + sh;
                    u32x2 wa; wa.x = cvtpk(ha.x, ha.y); wa.y = cvtpk(ha.z, ha.w); h0[64 * q] = wa;
                    if (two) { u32x2 wb; wb.x = cvtpk(hb.x, hb.y); wb.y = cvtpk(hb.z, hb.w); h1[64 * q] = wb; }
                    if (H8) { int ea = 0, eb = 0;
                        ea = __builtin_amdgcn_cvt_pk_fp8_f32(ha.x, ha.y, ea, false); ea = __builtin_amdgcn_cvt_pk_fp8_f32(ha.z, ha.w, ea, true);
                        eb = __builtin_amdgcn_cvt_pk_fp8_f32(hb.x, hb.y, eb, false); eb = __builtin_amdgcn_cvt_pk_fp8_f32(hb.z, hb.w, eb, true);
                        ((int*)(H8 + (size_t)r0 * DM))[lane + 64 * q] = ea; if (two) ((int*)(H8 + (size_t)r1 * DM))[lane + 64 * q] = eb; } }
            }
        }
        sb = se;
    }
    }
    __syncthreads();
}

__device__ __forceinline__ float half_sum(float v) {
#pragma unroll
    for (int o = 1; o < 32; o <<= 1) v += __shfl_xor(v, o);
    return v;
}
__device__ __forceinline__ void prep_phase(const Args& a, int l, int gw, int NGW, int lane_in) {
    const int lane = opaque_tid() & 63, half = lane >> 5, hl = lane & 31;
    bf16_t* Z = (bf16_t*)(a.ws + WS_Z);
    const float* gqn = a.in[I_GQN] + l * 128; const float* gkn = a.in[I_GKN] + l * 128;
    const float* mqn = a.in[I_MQN] + l * 512; const float* mkvn = a.in[I_MKVN] + l * 512;
    constexpr float L2T = 13.287712379549449f;
    float gq[4], gk[4], gf[4];
#pragma unroll
    for (int e = 0; e < 4; ++e) { gq[e] = gqn[4 * hl + e]; gk[e] = gkn[4 * hl + e]; gf[e] = __builtin_amdgcn_exp2f(-(float)(((4 * hl) & 31) + e) * (L2T / 32.f)); }
    const bool is_x1 = ((hl & 15) < 8);
    const float kf0 = __builtin_amdgcn_exp2f(-(float)((2 * hl) & 15) * (L2T / 16.f)), kf1 = __builtin_amdgcn_exp2f(-(float)(((2 * hl) & 15) + 1) * (L2T / 16.f));
    for (int rp = gw; rp < MTOT / 2; rp += NGW) {
        const int r = 2 * rp + half;
        bf16_t* zr = Z + (size_t)r * LDZ;
        const bool lat = r < NLAT; const int s = r & 2047; const float prow = (float)(s >> 6), pcol = (float)(s & 63);
        const float pos = (hl >> 4) ? pcol : prow;
        float gc[4], gs[4];
#pragma unroll
        for (int e = 0; e < 4; ++e) { gc[e] = lat ? __cosf(pos * gf[e]) : 1.f; gs[e] = lat ? __sinf(pos * gf[e]) : 0.f; if (is_x1) gs[e] = -gs[e]; }
        u32x2 wq[10]; u32x4 wa[2], wb[2];
#pragma unroll
        for (int hh = 0; hh < 10; ++hh) wq[hh] = ((const u32x2*)(zr + (hh < 8 ? ZC_BQ + hh * 128 : ZC_BK + (hh - 8) * 128)))[hl];
#pragma unroll
        for (int w2 = 0; w2 < 2; ++w2) { const u32x4* p = (const u32x4*)(zr + (w2 ? ZC_CKV : ZC_CQ)) + 2 * hl; wa[w2] = p[0]; wb[w2] = p[1]; }
        const unsigned wk = ((const unsigned*)(zr + ZC_CKR))[hl];
        asm volatile("" ::: "memory");
        float ssq[10];
#pragma unroll
        for (int hh = 0; hh < 10; ++hh) { const float x0 = bflo(wq[hh].x), x1 = bfhi(wq[hh].x), x2 = bflo(wq[hh].y), x3 = bfhi(wq[hh].y); ssq[hh] = (x0 * x0 + x1 * x1) + (x2 * x2 + x3 * x3); }
#pragma unroll
        for (int o = 1; o < 32; o <<= 1)
#pragma unroll
            for (int hh = 0; hh < 10; ++hh) ssq[hh] += __shfl_xor(ssq[hh], o);
#pragma unroll
        for (int hh = 0; hh < 10; ++hh) {
            const float x[4] = { bflo(wq[hh].x), bfhi(wq[hh].x), bflo(wq[hh].y), bfhi(wq[hh].y) };
            const float rstd = rsqrtf(ssq[hh] * (1.f / 128.f) + EPS);
            float y[4], o[4];
#pragma unroll
            for (int e = 0; e < 4; ++e) y[e] = x[e] * rstd * (hh < 8 ? gq[e] : gk[e]);
#pragma unroll
            for (int e = 0; e < 4; ++e) { const float q = __shfl_xor(y[e], 8); o[e] = y[e] * gc[e] + q * gs[e]; }
            u32x2 ow; ow.x = cvtpk(o[0], o[1]); ow.y = cvtpk(o[2], o[3]);
            ((u32x2*)(zr + (hh < 8 ? ZC_BQ + hh * 128 : ZC_BK + (hh - 8) * 128)))[hl] = ow;
        }
#pragma unroll
        for (int w2 = 0; w2 < 2; ++w2) {
            u32x4* p = (u32x4*)(zr + (w2 ? ZC_CKV : ZC_CQ)) + 2 * hl; const float* g = (w2 ? mkvn : mqn) + 16 * hl;
            const u32x4 va = wa[w2], vb = wb[w2];
            float x[16] = { bflo(va.x), bfhi(va.x), bflo(va.y), bfhi(va.y), bflo(va.z), bfhi(va.z), bflo(va.w), bfhi(va.w), bflo(vb.x), bfhi(vb.x), bflo(vb.y), bfhi(vb.y), bflo(vb.z), bfhi(vb.z), bflo(vb.w), bfhi(vb.w) };
            float ss = 0.f;
#pragma unroll
            for (int e = 0; e < 16; ++e) ss += x[e] * x[e];
            const float rstd = rsqrtf(half_sum(ss) * (1.f / 512.f) + EPS);
#pragma unroll
            for (int e = 0; e < 16; ++e) x[e] = x[e] * rstd * g[e];
            u32x4 oa, ob; oa.x = cvtpk(x[0], x[1]); oa.y = cvtpk(x[2], x[3]); oa.z = cvtpk(x[4], x[5]); oa.w = cvtpk(x[6], x[7]);
            ob.x = cvtpk(x[8], x[9]); ob.y = cvtpk(x[10], x[11]); ob.z = cvtpk(x[12], x[13]); ob.w = cvtpk(x[14], x[15]);
            p[0] = oa; p[1] = ob;
        }
        {
            float c0 = lat ? __cosf(pos * kf0) : 1.f, s0 = lat ? __sinf(pos * kf0) : 0.f, c1 = lat ? __cosf(pos * kf1) : 1.f, s1 = lat ? __sinf(pos * kf1) : 0.f;
            if (is_x1) { s0 = -s0; s1 = -s1; }
            const float y0 = bflo(wk), y1 = bfhi(wk);
            const float q0 = __shfl_xor(y0, 8), q1 = __shfl_xor(y1, 8);
            if (lat) ((unsigned*)(zr + ZC_CKR))[hl] = cvtpk(y0 * c0 + q0 * s0, y1 * c1 + q1 * s1);
        }
    }
}

__device__ __forceinline__ void attn_phase(const Args& a, int l, bool ctx_out, int vcu, int G, char* lds) {
    const bf16_t* Z = (const bf16_t*)(a.ws + WS_Z); const bf16_t* QC = (const bf16_t*)(a.ws + WS_H); const bf16_t* KVC = (const bf16_t*)(a.ws + WS_KVC);
    bf16_t* O = (bf16_t*)(a.ws + WS_O);
    const float C128 = 0.08838834764831845f * 1.4426950408889634f, C192 = 0.07216878364870323f * 1.4426950408889634f;
    const float T128 = att::THR / 0.08838834764831845f, T192 = att::THR / 0.07216878364870323f;
    for (int uidx = vcu; uidx < 512; uidx += G) {
        const int b = (uidx & 255) >> 5, j = uidx & 31, rd = uidx >> 8, qb = j & 7;
        const size_t qrow = (size_t)b * SEQ + qb * 256;
        {
            const int kvh = rd, head = kvh * 4 + (j >> 3);
            att::UnitP P; P.Q = Z + qrow * LDZ + ZC_BQ + head * 128; P.ldq = LDZ; P.K1 = Z + ZC_BK + kvh * 128; P.ldk1 = LDZ; P.K2 = nullptr; P.ldk2 = 0;
            P.V = Z + ZC_BV + kvh * 128; P.ldv = LDZ; P.O = O + qrow * LDO + 1024 + head * 128; P.ldo = LDO;
            P.NT = 36; P.nlat = 32; P.row_lat0 = b * SEQ; P.row_ctx0 = NLAT + b * CTXL; P.C = C128; P.thr_raw = T128; P.rope_q = 0; P.qpos0 = 0; P.qgrow0 = 0; P.krow0 = 0;
            att::attn_unit<128, false>(P, lds);
        }
        const int head = rd * 4 + (j >> 3);
        {
            att::UnitP P; P.Q = QC + qrow * LDQC + head * 192; P.ldq = LDQC; P.K1 = KVC + head * 256; P.ldk1 = LDKVC; P.K2 = Z + ZC_CKR; P.ldk2 = LDZ;
            P.V = KVC + head * 256 + 128; P.ldv = LDKVC; P.O = O + qrow * LDO + 2048 + head * 128; P.ldo = LDO;
            P.NT = 36; P.nlat = 32; P.row_lat0 = b * SEQ; P.row_ctx0 = NLAT + b * CTXL; P.C = C192; P.thr_raw = T192; P.rope_q = 1; P.qpos0 = qb * 256; P.qgrow0 = 0; P.krow0 = 0;
            att::attn_unit<192, false>(P, lds);
        }
        {
            const int g0 = 4 * qb, krow0 = min(max(g0 - 4, 0), 24), klast = min(max(g0 + 3 - 4, 0), 24) + 7, nr = klast - krow0 + 1;
            float* rpbs = (float*)(lds + att::OFF_RPB);
            const float* rpb = a.in[I_RPB] + ((size_t)l * 8 + head) * 465;
            for (int i = opaque_tid(); i < 465; i += 512) rpbs[i] = rpb[i] * 11.313708498984761f;
            att::UnitP P; P.Q = Z + qrow * LDZ + ZC_AQ + head * 128; P.ldq = LDZ; P.K1 = Z + ZC_AK + head * 128; P.ldk1 = LDZ; P.K2 = nullptr; P.ldk2 = 0;
            P.V = Z + ZC_AV + head * 128; P.ldv = LDZ; P.O = O + qrow * LDO + head * 128; P.ldo = LDO;
            P.NT = nr + 4; P.nlat = nr; P.row_lat0 = b * SEQ + krow0 * 64; P.row_ctx0 = NLAT + b * CTXL; P.C = C128; P.thr_raw = T128; P.rope_q = 0; P.qpos0 = 0; P.qgrow0 = g0; P.krow0 = krow0;
            att::attn_unit<128, true>(P, lds);
        }
    }
    if (ctx_out) {
        for (int u = vcu; u < 192; u += G) {
            const int mixer = u / 64, b = (u % 64) >> 3, head = u & 7;
            const size_t qrow = (size_t)NLAT + (size_t)b * CTXL;
            att::UnitP P; P.NT = 4; P.nlat = 0; P.row_lat0 = 0; P.row_ctx0 = NLAT + b * CTXL; P.rope_q = 0; P.qpos0 = 0; P.qgrow0 = 0; P.krow0 = 0; P.K2 = nullptr; P.ldk2 = 0; P.ldo = LDO;
            if (mixer == 0) { P.Q = Z + qrow * LDZ + ZC_AQ + head * 128; P.ldq = LDZ; P.K1 = Z + ZC_AK + head * 128; P.ldk1 = LDZ; P.V = Z + ZC_AV + head * 128; P.ldv = LDZ;
                P.O = O + qrow * LDO + head * 128; P.C = C128; P.thr_raw = T128; att::attn_unit<128, false>(P, lds); }
            else if (mixer == 1) { const int kvh = head >> 2; P.Q = Z + qrow * LDZ + ZC_BQ + head * 128; P.ldq = LDZ; P.K1 = Z + ZC_BK + kvh * 128; P.ldk1 = LDZ; P.V = Z + ZC_BV + kvh * 128; P.ldv = LDZ;
                P.O = O + qrow * LDO + 1024 + head * 128; P.C = C128; P.thr_raw = T128; att::attn_unit<128, false>(P, lds); }
            else { P.Q = QC + qrow * LDQC + head * 192; P.ldq = LDQC; P.K1 = KVC + head * 256; P.ldk1 = LDKVC; P.K2 = Z + ZC_CKR; P.ldk2 = LDZ; P.V = KVC + head * 256 + 128; P.ldv = LDKVC;
                P.O = O + qrow * LDO + 2048 + head * 128; P.C = C192; P.thr_raw = T192; att::attn_unit<192, false>(P, lds); }
        }
    }
}

__global__ void __launch_bounds__(512, 2) fwd_megakernel(Args a) {
    extern __shared__ __attribute__((aligned(16))) unsigned char lds[];
    cg::grid_group grid = cg::this_grid();
    const int tid = threadIdx.x, lane = tid & 63, wave = __builtin_amdgcn_readfirstlane(tid >> 6);
    const int G = gridDim.x, bid = blockIdx.x;
    const int vcu = (G % 8 == 0) ? (bid % 8) * (G / 8) + bid / 8 : bid;
    const int gw = vcu * 8 + wave, NGW = G * 8;
    unsigned char* ws = a.ws;
    LAS unsigned char* ldsl = (LAS unsigned char*)lds;
    LAS float* scr = (LAS float*)(ldsl + wave * 16384);
    float* mod = (float*)(ws + WS_MOD); float* CX = (float*)(ws + WS_CX);
    bf16_t* H = (bf16_t*)(ws + WS_H); bf16_t* Z = (bf16_t*)(ws + WS_Z); bf16_t* QC = (bf16_t*)(ws + WS_H); bf16_t* KVC = (bf16_t*)(ws + WS_KVC);
    bf16_t* Y = (bf16_t*)(ws + WS_KVC); bf16_t* O = (bf16_t*)(ws + WS_O); bf16_t* T = (bf16_t*)(ws + WS_T); bf16_t* U = (bf16_t*)(ws + WS_U); float* TP = (float*)(ws + WS_TP);

    unsigned* barw = (unsigned*)(ws + WS_BAR);
    volatile LAS unsigned* bst = (volatile LAS unsigned*)(ldsl + 131072 + 64);
    if (bid == 0) for (int i = tid; i < XCD_BAR_WORDS; i += 512) barw[i] = 0u;
    if (tid < 2) bst[tid] = 0u;
    __syncthreads();
    mod_phase(a, lds, bid, G, tid);
    convert_weights(a, 0, gw, NGW, lane, scr);
    grid.sync();
    const XcdBarrier xb = xcd_barrier_post(barw, bst);
#define GSYNC() xcd_barrier(xb)
    row_phase<false, true>(bid, G, MTOT, a.in[I_X], a.in[I_CTX], nullptr, nullptr, nullptr, nullptr, nullptr, 0, nullptr, a.in[I_GPRE1], mod, 0, 2048, H, ws + WS_H8, lds);
    GSYNC();
    for (int l = 0; l < 2; ++l) {
        const bool ctx_out = (l == 0);
        const int nMr = ctx_out ? MTOT / 256 : NLAT / 256;
        const float* modL = mod + (size_t)l * 9 * MODW;
        { pg8::TileSched S; S.nM = ctx_out ? MTOT / 256 : NLAT / 256; S.nN = 23; S.nwg = S.nM * S.nN; S.G = G; S.c = bid; S.nsub = 1; S.A = (const char*)H; S.B = (const char*)(ws + WS_WIN);
          S.aT = (size_t)256 * DM * 2; S.bT = (size_t)256 * DM * 2; S.aS = 0; S.bS = 0; S.nx = ctx_out ? 0 : 104;
          S.pn_split = 16; S.pn_skip = 24; S.pn_boff = 0;
          pg8::EpiZ E{Z}; pg8::gemm_phase(ldsl, DM, DM, DM, S, E); }
        { pg8::TileSched S; S.nM = ctx_out ? MTOT / 256 : NLAT / 256; S.nN = 24; S.nwg = S.nM * S.nN; S.G = G; S.c = bid; S.nsub = 1; S.A = (const char*)(ws + WS_H8); S.B = (const char*)(ws + WS_WG8);
          S.aT = (size_t)256 * DM; S.bT = (size_t)256 * DM; S.aS = 0; S.bS = 0; S.nx = 0; S.pn_split = 0; S.pn_skip = 16; S.pn_boff = 16;
          pg8::EpiZ8 E{Z}; pg8::gemm_phase<true>(ldsl, DM / 2, DM / 2, DM / 2, S, E); }
        GSYNC();
        prep_phase(a, l, gw, NGW, lane);
        GSYNC();
        { pg8::DualSched S; S.G = G; S.c = bid; S.n0 = (MTOT / 256) * 6; S.n1 = (MTOT / 256) * 8; S.nN0 = 6; S.nN1 = 8;
          S.A0 = (const char*)(Z + ZC_CQ); S.A1 = (const char*)(Z + ZC_CKV); S.B0 = (const char*)(ws + WS_WUQ); S.B1 = (const char*)(ws + WS_WUKV);
          S.aT = (size_t)256 * LDZ * 2; S.bT = (size_t)256 * 512 * 2;
          pg8::EpiQKV E{QC, KVC, LDQC, LDKVC}; pg8::gemm_phase(ldsl, LDZ, 512, 512, S, E); }
        GSYNC();
        attn_phase(a, l, ctx_out, vcu, G, (char*)lds);
        GSYNC();
        { pg8::TileSched S; S.nM = nMr; S.nN = 8; S.nwg = S.nM * S.nN; S.G = G; S.c = bid; S.nsub = 3; S.A = (const char*)O; S.B = (const char*)(ws + WS_WBR);
          S.aT = (size_t)256 * LDO * 2; S.bT = (size_t)256 * 1024 * 2; S.aS = (size_t)1024 * 2; S.bS = (size_t)2048 * 1024 * 2; S.nx = 0; S.pn_split = 1 << 30; S.pn_skip = 0; S.pn_boff = 0;
          pg8::EpiMerge E{Y, Z}; pg8::gemm_phase(ldsl, LDO, 1024, 1024, S, E); }
        GSYNC();
        { pg8::TileSched S; S.nM = NLAT / 256; S.nN = 8; S.nwg = S.nM * S.nN; S.G = G; S.c = bid; S.nsub = 1; S.A = (const char*)Y; S.B = (const char*)(ws + WS_WO);
          S.aT = (size_t)256 * DM * 2; S.bT = (size_t)256 * DM * 2; S.aS = 0; S.bS = 0; S.nx = 0; S.pn_split = 1 << 30; S.pn_skip = 0; S.pn_boff = 0;
          pg8::EpiQKV E{T, T, DM, DM}; pg8::gemm_phase(ldsl, DM, DM, DM, S, E); }
        if (ctx_out) { pg8::CtxSplitSched S; S.G = G; S.c = bid; S.A = (const char*)Y; S.B = (const char*)(ws + WS_WO); S.aT = (size_t)256 * DM * 2; S.bT = (size_t)256 * DM * 2; S.kqB = (size_t)(DM / 4) * 2;
          pg8::EpiSlab E{TP}; pg8::gemm_phase(ldsl, DM, DM, DM / 4, S, E); }
        GSYNC();
        row_phase<true, true>(bid, G, ctx_out ? MTOT : NLAT, l == 0 ? a.in[I_X] : a.out, a.in[I_CTX], a.out, CX, T, ctx_out ? TP : nullptr, modL, 4096, a.in[I_GPOST1] + l * DM,
                              a.in[I_GPRE2] + l * DM, modL, 6144, 8192, H, nullptr, lds);
        GSYNC();
        { pg8::TileSched S; S.nM = nMr; S.nN = 2 * DFF / 256; S.nwg = S.nM * S.nN; S.G = G; S.c = bid; S.nsub = 1; S.A = (const char*)H; S.B = (const char*)(ws + WS_W13);
          S.aT = (size_t)256 * DM * 2; S.bT = (size_t)256 * DM * 2; S.aS = 0; S.bS = 0; S.nx = 0; S.pn_split = 1 << 30; S.pn_skip = 0; S.pn_boff = 0;
          pg8::EpiSwiglu E{U}; pg8::gemm_phase(ldsl, DM, DM, DM, S, E); }
        GSYNC();
        { pg8::TileSched S; S.nM = NLAT / 256; S.nN = 8; S.nwg = S.nM * S.nN; S.G = G; S.c = bid; S.nsub = 1; S.A = (const char*)U; S.B = (const char*)(ws + WS_W2);
          S.aT = (size_t)256 * DFF * 2; S.bT = (size_t)256 * DFF * 2; S.aS = 0; S.bS = 0; S.nx = 0; S.pn_split = 1 << 30; S.pn_skip = 0; S.pn_boff = 0;
          pg8::EpiQKV E{T, T, DM, DM}; pg8::gemm_phase(ldsl, DFF, DFF, DFF, S, E); }
        if (ctx_out) { pg8::CtxSplitSched S; S.G = G; S.c = bid; S.A = (const char*)U; S.B = (const char*)(ws + WS_W2); S.aT = (size_t)256 * DFF * 2; S.bT = (size_t)256 * DFF * 2; S.kqB = (size_t)(DFF / 4) * 2;
          pg8::EpiSlab E{TP}; pg8::gemm_phase(ldsl, DFF, DFF, DFF / 4, S, E); }
        GSYNC();
        if (l == 0) {
            row_phase<true, true>(bid, G, MTOT, a.out, CX, a.out, CX, T, TP, modL, 10240, a.in[I_GPOST2], a.in[I_GPRE1] + DM, mod + (size_t)9 * MODW, 0, 2048, H, ws + WS_H8, lds);
            convert_weights(a, 1, gw, NGW, lane, scr);
            GSYNC();
        } else {
            row_phase<true, false>(bid, G, NLAT, a.out, nullptr, a.out, nullptr, T, nullptr, modL, 10240, a.in[I_GPOST2] + DM, nullptr, nullptr, 0, 0, nullptr, nullptr, lds);
        }
    }
}

extern "C" void kernel_launch(void* const* d_in, const int* in_sizes, int n_in, void* d_out, int out_size, void* d_ws, size_t ws_size, hipStream_t stream) {
    static int grid = 0;
    if (grid == 0) {
        if (n_in != 25 || out_size != NLAT * DM || ws_size < WS_END) { fprintf(stderr, "kernel_launch: unexpected shapes: n_in %d out %d ws %zu (need %zu)\n", n_in, out_size, ws_size, (size_t)WS_END); grid = -1; return; }
        int dev = 0, cus = 0, per_cu = 0;
        if (hipGetDevice(&dev) != hipSuccess || hipDeviceGetAttribute(&cus, hipDeviceAttributeMultiprocessorCount, dev) != hipSuccess) { grid = -1; return; }
        if (hipFuncSetAttribute((const void*)fwd_megakernel, hipFuncAttributeMaxDynamicSharedMemorySize, LDS_BYTES) != hipSuccess) { fprintf(stderr, "kernel_launch: hipFuncSetAttribute failed\n"); grid = -1; return; }
        if (hipOccupancyMaxActiveBlocksPerMultiprocessor(&per_cu, (const void*)fwd_megakernel, 512, LDS_BYTES) != hipSuccess || per_cu < 1) { fprintf(stderr, "kernel_launch: occupancy query says %d\n", per_cu); per_cu = 1; }
        (void)hipGetLastError();
        grid = cus * 1;
    }
    if (grid < 0) return;
    Args a{};
    for (int i = 0; i < 25; ++i) a.in[i] = (const float*)d_in[i];
    a.out = (float*)d_out; a.ws = (unsigned char*)d_ws;
    void* args[] = {&a};
    hipError_t e = hipLaunchCooperativeKernel((const void*)fwd_megakernel, dim3(grid), dim3(512), args, LDS_BYTES, stream);
    if (e != hipSuccess) fprintf(stderr, "kernel_launch: cooperative launch failed: %s (grid %d)\n", hipGetErrorString(e), grid);
}
```

```cpp
#include <hip/hip_runtime.h>
#include <hip/hip_cooperative_groups.h>
#include <cstdio>
#include <cstdint>
namespace cg = cooperative_groups;

constexpr int DM = 2048, NB = 8, SEQ = 2048, CTXL = 256, NLAT = NB * SEQ, NCTX = NB * CTXL, MTOT = NLAT + NCTX;
constexpr int INW = 11840, LDZ = 11840, NZP = 12032, DFF = 5632, LDO = 3072, LDQC = 1536, LDKVC = 2112;
constexpr int MODW = 6 * DM;
constexpr float EPS = 1e-6f;
constexpr int ZC_AQ = 0, ZC_AK = 1024, ZC_AV = 2048, ZC_BQ = 3072, ZC_GA = 4096, ZC_BK = 10240, ZC_BV = 10496, ZC_CQ = 10752, ZC_CKV = 11264, ZC_CKR = 11776;
constexpr size_t WS_MOD = 0;
constexpr size_t WS_BAR = 901120;
constexpr size_t WS_CX = 1u << 20;
constexpr size_t WS_WIN = WS_CX + (size_t)NCTX * DM * 4;
constexpr size_t WS_WUQ = WS_WIN + (size_t)NZP * DM * 2;
constexpr size_t WS_WUKV = WS_WUQ + (size_t)1536 * 512 * 2;
constexpr size_t WS_WBR = WS_WUKV + (size_t)2048 * 512 * 2;
constexpr size_t WS_WO = WS_WBR + (size_t)3 * 2048 * 1024 * 2;
constexpr size_t WS_W13 = WS_WO + (size_t)2048 * 2048 * 2;
constexpr size_t WS_W2 = WS_W13 + (size_t)2 * DFF * DM * 2;
constexpr size_t WS_H = WS_W2 + (size_t)DM * DFF * 2;
constexpr size_t WS_Z = WS_H + (size_t)MTOT * DM * 2;
constexpr size_t WS_T = WS_Z;
constexpr size_t WS_U = WS_Z + (size_t)MTOT * DM * 4;
constexpr size_t WS_TP = WS_U + (size_t)MTOT * DFF * 2;
constexpr size_t WS_KVC = WS_Z + (size_t)MTOT * LDZ * 2;
constexpr size_t WS_O = WS_KVC + (size_t)MTOT * LDKVC * 2;
constexpr size_t WS_H8 = WS_O + (size_t)MTOT * LDO * 2;
constexpr size_t WS_WG8 = WS_H8 + (size_t)MTOT * DM;
constexpr size_t WS_END = WS_WG8 + (size_t)6144 * DM;
static_assert(WS_END <= 921975872ull, "workspace budget (sum of the inputs)");
static_assert(WS_TP + (size_t)4 * NCTX * DM * 4 <= WS_KVC, "overlay");
constexpr int LDS_BYTES = 147456;

typedef unsigned short bf16_t;
typedef short bf16x8 __attribute__((ext_vector_type(8)));
typedef short s16x4 __attribute__((ext_vector_type(4)));
typedef float f32x4 __attribute__((ext_vector_type(4)));
typedef float f32x16 __attribute__((ext_vector_type(16)));
typedef unsigned u32x4 __attribute__((ext_vector_type(4)));
typedef unsigned u32x2 __attribute__((ext_vector_type(2)));
typedef int i32x8 __attribute__((ext_vector_type(8)));
typedef int i32x4 __attribute__((ext_vector_type(4)));
#define LAS __attribute__((address_space(3)))

__device__ __forceinline__ int opaque_tid() { int t = threadIdx.x; asm volatile("" : "+v"(t)); return t; }
__device__ __forceinline__ unsigned cvtpk(float lo, float hi) { unsigned r; asm volatile("v_cvt_pk_bf16_f32 %0, %1, %2" : "=v"(r) : "v"(lo), "v"(hi)); return r; }
__device__ __forceinline__ float bf2f(unsigned short s) { return __uint_as_float(((unsigned)s) << 16); }
__device__ __forceinline__ float bflo(unsigned w) { return __uint_as_float(w << 16); }
__device__ __forceinline__ float bfhi(unsigned w) { return __uint_as_float(w & 0xffff0000u); }
__device__ __forceinline__ float wave_sum(float v) {
#pragma unroll
    for (int o = 1; o < 64; o <<= 1) v += __shfl_xor(v, o);
    return v;
}
__device__ __forceinline__ float sigmoidf_(float x) { return __builtin_amdgcn_rcpf(1.f + __builtin_amdgcn_exp2f(-1.4426950408889634f * x)); }

namespace pg8 {
constexpr int BM = 256, BK = 64, HALF = 128, HTB = HALF * BK * 2, STAGE_BYTES = 8 * HTB, NXCD = 8, WGM = 8;
__device__ __forceinline__ int lds_byte(int r, int c) { const int st = (r >> 4) * 2 + (c >> 5), rr = r & 15, cc = c & 31, ob = rr * 64 + cc * 2; return st * 1024 + (ob ^ (((ob >> 9) & 1) << 5)); }
__device__ __forceinline__ void stage_rc(int b, int& R, int& C) { const int st = b / 1024, sb = b % 1024, swz = sb ^ (((sb >> 9) & 1) << 5); R = (st >> 1) * 16 + swz / 64; C = (st & 1) * 32 + (swz % 64) / 2; }
__device__ __forceinline__ int perm32(int rho) { const int n = rho >> 4, i = rho & 15; return 8 * (i >> 2) + 4 * n + (i & 3); }
struct Unit { int pm, pn, sub; };

struct TileSched {
    int nM, nN, nwg, G, c, nsub; const char* A; const char* B; size_t aT, bT, aS, bS;
    int pn_split, pn_skip, pn_boff;
    int nx;
    __device__ __forceinline__ bool next(int i, Unit& u) const {
        const int ti = i / nsub; u.sub = i - ti * nsub;
        const long L = (long)ti * G + c;
        if (L >= nwg) { const int k = (int)(L - nwg); if (k >= nx) return false; const int t = k / 13, idx = k - t * 13; u.pm = 64 + t;
            u.pn = idx < 8 ? 4 + idx : (idx < 10 ? 32 + idx : (idx < 12 ? 34 + idx : 46)); return true; }
        int wgid = (int)L; { const int q = nwg / NXCD, r = nwg % NXCD, xcd = wgid % NXCD, off = wgid / NXCD; wgid = (xcd < r ? xcd * (q + 1) : r * (q + 1) + (xcd - r) * q) + off; }
        const int nig = WGM * nN, gid = wgid / nig, fm = gid * WGM, gsz = (nM - fm) < WGM ? (nM - fm) : WGM;
        u.pm = fm + ((wgid % nig) % gsz); const int idx = (wgid % nig) / gsz; u.pn = idx < pn_split ? idx : idx + pn_skip; return true;
    }
    __device__ __forceinline__ const char* ptrA(const Unit& u) const { return A + (size_t)u.pm * aT + (size_t)u.sub * aS; }
    __device__ __forceinline__ const char* ptrB(const Unit& u) const { return B + (size_t)(u.pn - pn_boff) * bT + (size_t)u.sub * bS; }
};
struct DualSched {
    int G, c, n0, n1, nN0, nN1; const char *A0, *A1, *B0, *B1; size_t aT, bT;
    __device__ __forceinline__ bool next(int i, Unit& u) const {
        int L = i * G + c;
        if (L < n0) { u.sub = 0; u.pm = L / nN0; u.pn = L - u.pm * nN0; return true; }
        L -= n0; if (L >= n1) return false;
        u.sub = 1; u.pm = L / nN1; u.pn = L - u.pm * nN1; return true;
    }
    __device__ __forceinline__ const char* ptrA(const Unit& u) const { return (u.sub ? A1 : A0) + (size_t)u.pm * aT; }
    __device__ __forceinline__ const char* ptrB(const Unit& u) const { return (u.sub ? B1 : B0) + (size_t)u.pn * bT; }
};

struct EpiZ {
    static constexpr bool PERM = true;
    bf16_t* Z;
    __device__ __forceinline__ void operator()(const f32x4 (&acc)[2][2][4][2], const Unit& u, int wr, int wc, int fr, int fq) const {
        const int row0 = u.pm * BM + wr * 64 + fr, col0 = u.pn * BM + wc * 32 + 8 * fq;
#pragma unroll
        for (int ai = 0; ai < 2; ++ai)
#pragma unroll
            for (int m = 0; m < 4; ++m) { bf16_t* rowp = Z + (size_t)(row0 + ai * HALF + m * 16) * LDZ + col0;
#pragma unroll
                for (int bj = 0; bj < 2; ++bj) { const f32x4 v0 = acc[ai][bj][m][0], v1 = acc[ai][bj][m][1];
                    u32x4 w; w.x = cvtpk(v0[0], v0[1]); w.y = cvtpk(v0[2], v0[3]); w.z = cvtpk(v1[0], v1[1]); w.w = cvtpk(v1[2], v1[3]);
                    if (col0 + bj * HALF < LDZ) *(u32x4*)(rowp + bj * HALF) = w; } }
    }
};
struct EpiZ8 {
    static constexpr bool PERM = false, ALIGN = true;
    bf16_t* Z;
    __device__ __forceinline__ void operator()(const f32x4 (&acc)[2][2][4][2], const Unit& u, int wr, int wc, int fr, int fq) const {
        const int row0 = u.pm * BM + wr * 64 + fr, col0 = u.pn * BM + wc * 32 + 4 * fq;
#pragma unroll
        for (int ai = 0; ai < 2; ++ai)
#pragma unroll
            for (int m = 0; m < 4; ++m) { bf16_t* rowp = Z + (size_t)(row0 + ai * HALF + m * 16) * LDZ + col0;
#pragma unroll
                for (int bj = 0; bj < 2; ++bj)
#pragma unroll
                    for (int n = 0; n < 2; ++n) { const f32x4 v = acc[ai][bj][m][n]; u32x2 w; w.x = cvtpk(v[0], v[1]); w.y = cvtpk(v[2], v[3]); *(u32x2*)(rowp + bj * HALF + n * 16) = w; } }
    }
};
struct EpiQKV {
    static constexpr bool PERM = true;
    bf16_t* O0; bf16_t* O1; int ld0, ld1;
    __device__ __forceinline__ void operator()(const f32x4 (&acc)[2][2][4][2], const Unit& u, int wr, int wc, int fr, int fq) const {
        bf16_t* O = u.sub ? O1 : O0; const int ldc = u.sub ? ld1 : ld0;
        const int row0 = u.pm * BM + wr * 64 + fr, col0 = u.pn * BM + wc * 32 + 8 * fq;
#pragma unroll
        for (int ai = 0; ai < 2; ++ai)
#pragma unroll
            for (int m = 0; m < 4; ++m) { bf16_t* rowp = O + (size_t)(row0 + ai * HALF + m * 16) * ldc + col0;
#pragma unroll
                for (int bj = 0; bj < 2; ++bj) { const f32x4 v0 = acc[ai][bj][m][0], v1 = acc[ai][bj][m][1];
                    u32x4 w; w.x = cvtpk(v0[0], v0[1]); w.y = cvtpk(v0[2], v0[3]); w.z = cvtpk(v1[0], v1[1]); w.w = cvtpk(v1[2], v1[3]);
                    *(u32x4*)(rowp + bj * HALF) = w; } }
    }
};
struct EpiMerge {
    static constexpr bool PERM = true;
    bf16_t* Y; const bf16_t* Z;
    __device__ __forceinline__ void operator()(const f32x4 (&acc)[2][2][4][2], const Unit& u, int wr, int wc, int fr, int fq) const {
        const int row0 = u.pm * BM + wr * 64 + fr, col0 = u.pn * BM + wc * 32 + 8 * fq;
        const bool rmw = (u.sub > 0);
#pragma unroll
        for (int ai = 0; ai < 2; ++ai) {
            u32x4 g[4][2], pv[4][2];
#pragma unroll
            for (int m = 0; m < 4; ++m) { const size_t row = (size_t)(row0 + ai * HALF + m * 16);
#pragma unroll
                for (int bj = 0; bj < 2; ++bj) { g[m][bj] = *(const u32x4*)(Z + row * LDZ + ZC_GA + 2048 * u.sub + col0 + bj * HALF);
                    pv[m][bj] = rmw ? *(const u32x4*)(Y + row * DM + col0 + bj * HALF) : (u32x4){0u, 0u, 0u, 0u}; } }
            asm volatile("" ::: "memory");
#pragma unroll
            for (int m = 0; m < 4; ++m) { bf16_t* yp = Y + (size_t)(row0 + ai * HALF + m * 16) * DM + col0;
#pragma unroll
                for (int bj = 0; bj < 2; ++bj) { const f32x4 a0 = acc[ai][bj][m][0], a1 = acc[ai][bj][m][1]; const u32x4 gg = g[m][bj], p = pv[m][bj];
                    float v[8] = { a0[0] * sigmoidf_(bflo(gg.x)), a0[1] * sigmoidf_(bfhi(gg.x)), a0[2] * sigmoidf_(bflo(gg.y)), a0[3] * sigmoidf_(bfhi(gg.y)), a1[0] * sigmoidf_(bflo(gg.z)), a1[1] * sigmoidf_(bfhi(gg.z)), a1[2] * sigmoidf_(bflo(gg.w)), a1[3] * sigmoidf_(bfhi(gg.w)) };
                    v[0] += bflo(p.x); v[1] += bfhi(p.x); v[2] += bflo(p.y); v[3] += bfhi(p.y); v[4] += bflo(p.z); v[5] += bfhi(p.z); v[6] += bflo(p.w); v[7] += bfhi(p.w);
                    u32x4 w; w.x = cvtpk(v[0], v[1]); w.y = cvtpk(v[2], v[3]); w.z = cvtpk(v[4], v[5]); w.w = cvtpk(v[6], v[7]);
                    *(u32x4*)(yp + bj * HALF) = w; } }
        }
    }
};
struct EpiSwiglu {
    static constexpr bool PERM = false;
    bf16_t* U;
    __device__ __forceinline__ void operator()(const f32x4 (&acc)[2][2][4][2], const Unit& u, int wr, int wc, int fr, int fq) const {
        const int row0 = u.pm * BM + wr * 64 + fr, col0 = u.pn * 128 + wc * 16 + 4 * fq;
#pragma unroll
        for (int ai = 0; ai < 2; ++ai)
#pragma unroll
            for (int m = 0; m < 4; ++m) { bf16_t* rowp = U + (size_t)(row0 + ai * HALF + m * 16) * DFF + col0;
#pragma unroll
                for (int bj = 0; bj < 2; ++bj) { const f32x4 a = acc[ai][bj][m][0], g = acc[ai][bj][m][1]; float o[4];
#pragma unroll
                    for (int j = 0; j < 4; ++j) o[j] = a[j] * sigmoidf_(a[j]) * g[j];
                    u32x2 w; w.x = cvtpk(o[0], o[1]); w.y = cvtpk(o[2], o[3]);
                    *(u32x2*)(rowp + bj * 64) = w; } }
    }
};

struct CtxSplitSched {
    int G, c; const char* A; const char* B; size_t aT, bT, kqB;
    __device__ __forceinline__ bool next(int i, Unit& u) const { const int L = i * G + c; if (L >= 256) return false; u.sub = L & 3; const int t = L >> 2; u.pm = 64 + (t >> 3); u.pn = t & 7; return true; }
    __device__ __forceinline__ const char* ptrA(const Unit& u) const { return A + (size_t)u.pm * aT + (size_t)u.sub * kqB; }
    __device__ __forceinline__ const char* ptrB(const Unit& u) const { return B + (size_t)u.pn * bT + (size_t)u.sub * kqB; }
};
struct EpiSlab {
    static constexpr bool PERM = false;
    float* C;
    __device__ __forceinline__ void operator()(const f32x4 (&acc)[2][2][4][2], const Unit& u, int wr, int wc, int fr, int fq) const {
        const int row0 = (u.pm - 64) * BM + wr * 64 + fr, col0 = u.pn * BM + wc * 32 + 4 * fq;
        float* Cs = C + (size_t)u.sub * NCTX * DM;
#pragma unroll
        for (int ai = 0; ai < 2; ++ai)
#pragma unroll
            for (int m = 0; m < 4; ++m) { float* rowp = Cs + (size_t)(row0 + ai * HALF + m * 16) * DM + col0;
#pragma unroll
                for (int bj = 0; bj < 2; ++bj)
#pragma unroll
                    for (int n = 0; n < 2; ++n) *(f32x4*)(rowp + bj * HALF + n * 16) = acc[ai][bj][m][n]; }
    }
};

template <bool F8 = false, class Epi, class Sched>
__device__ __forceinline__ void gemm_phase(LAS unsigned char* lds, const int lda, const int ldb, const int K, const Sched& S, const Epi& E) {
    const int tid = opaque_tid(), wid = __builtin_amdgcn_readfirstlane(tid >> 6), lane = tid & 63, wr = wid >> 2, wc = wid & 3, fr = lane & 15, fq = lane >> 4;
    const int nt = K / BK;
    unsigned voffA[2], voffB[2];
#pragma unroll
    for (int i = 0; i < 2; ++i) { int R, C; stage_rc(tid * 16 + i * 8192, R, C); const int Rb = Epi::PERM ? ((R & ~31) + perm32(R & 31)) : R;
        voffA[i] = (unsigned)(R * lda + C) * 2u; voffB[i] = (unsigned)(Rb * ldb + C) * 2u; }
    const size_t kstep = (size_t)(BK * 2);
    const size_t hstepA = (size_t)HALF * lda * 2, hstepB = (size_t)HALF * ldb * 2;
    const unsigned ldsw = (unsigned)wid * 1024u;
    const int aoff = lds_byte(wr * 64 + fr, fq * 8), boff = lds_byte(wc * 32 + fr, fq * 8);
#define PG8_SA(b, h) (((b) * 2 + (h)) * HTB)
#define PG8_SB(b, h) ((4 + (b) * 2 + (h)) * HTB)
#define PG8_STAGE(bufoff, gbase, voff) do { _Pragma("unroll") for (int _i = 0; _i < 2; ++_i) \
        __builtin_amdgcn_global_load_lds((const unsigned*)((const char*)(gbase) + (voff)[_i]), (LAS unsigned*)(lds + (bufoff) + ldsw + _i * 8192), 16, 0, 0); } while (0)
#define PG8_LDA(dst, b, h) do { if constexpr (F8) { _Pragma("unroll") for (int m = 0; m < 4; ++m) { const i32x4 _l = *(const LAS i32x4*)(lds + PG8_SA(b, h) + aoff + m * 2048), _u = *(const LAS i32x4*)(lds + PG8_SA(b, h) + aoff + m * 2048 + 1024); \
          dst##8[m] = __builtin_shufflevector(_l, _u, 0, 1, 2, 3, 4, 5, 6, 7); } } \
        else { _Pragma("unroll") for (int m = 0; m < 4; ++m) _Pragma("unroll") for (int k = 0; k < 2; ++k) dst[m][k] = *(const LAS bf16x8*)(lds + PG8_SA(b, h) + aoff + m * 2048 + k * 1024); } } while (0)
#define PG8_LDB(dst, b, h) do { if constexpr (F8) { _Pragma("unroll") for (int n = 0; n < 2; ++n) { const i32x4 _l = *(const LAS i32x4*)(lds + PG8_SB(b, h) + boff + n * 2048), _u = *(const LAS i32x4*)(lds + PG8_SB(b, h) + boff + n * 2048 + 1024); \
          dst##8[n] = __builtin_shufflevector(_l, _u, 0, 1, 2, 3, 4, 5, 6, 7); } } \
        else { _Pragma("unroll") for (int n = 0; n < 2; ++n) _Pragma("unroll") for (int k = 0; k < 2; ++k) dst[n][k] = *(const LAS bf16x8*)(lds + PG8_SB(b, h) + boff + n * 2048 + k * 1024); } } while (0)
#define PG8_MMA(ai, bj, At, Bt) do { __builtin_amdgcn_s_setprio(1); _Pragma("unroll") for (int m = 0; m < 4; ++m) _Pragma("unroll") for (int n = 0; n < 2; ++n) { \
        if constexpr (F8)   \
            asm volatile("v_mfma_scale_f32_16x16x128_f8f6f4 %0, %1, %2, %0, %3, %4 op_sel_hi:[0,0,0]" : "+v"(acc[ai][bj][m][n]) : "v"(Bt##8[n]), "v"(At##8[m]), "v"(f8s), "v"(f8s)); \
        else { _Pragma("unroll") for (int k = 0; k < 2; ++k) acc[ai][bj][m][n] = __builtin_amdgcn_mfma_f32_16x16x32_bf16(Bt[n][k], At[m][k], acc[ai][bj][m][n], 0, 0, 0); } } \
        __builtin_amdgcn_s_setprio(0); } while (0)
#define PG8_WAIT_V(n) asm volatile("s_waitcnt vmcnt(" #n ")" ::: "memory")
#define PG8_WAIT_L(n) asm volatile("s_waitcnt lgkmcnt(" #n ")" ::: "memory")
#define PG8_BAR __builtin_amdgcn_s_barrier()
#define PG8_SCHED __builtin_amdgcn_sched_barrier(0)
    Unit cur, nxt; int ui = 0;
    if (!S.next(0, cur)) return;
    f32x4 acc[2][2][4][2];
#pragma unroll
    for (int a = 0; a < 2; ++a)
#pragma unroll
        for (int b = 0; b < 2; ++b)
#pragma unroll
            for (int m = 0; m < 4; ++m)
#pragma unroll
                for (int n = 0; n < 2; ++n) acc[a][b][m][n] = (f32x4){0.f, 0.f, 0.f, 0.f};
    bf16x8 At[4][2], B0[2][2], B1[2][2];
    i32x8 At8[4], B08[2], B18[2];
    const int f8s = 0x7C7C7C7C;
    const char* cA = S.ptrA(cur); const char* cB = S.ptrB(cur);
    PG8_STAGE(PG8_SB(0, 0), cB, voffB); PG8_STAGE(PG8_SB(0, 1), cB + hstepB, voffB); PG8_STAGE(PG8_SA(0, 0), cA, voffA); PG8_STAGE(PG8_SA(0, 1), cA + hstepA, voffA);
    if (wr == 1) PG8_BAR;
    PG8_WAIT_V(2); PG8_BAR;
    PG8_STAGE(PG8_SB(1, 0), cB + kstep, voffB); PG8_STAGE(PG8_SA(1, 0), cA + kstep, voffA); PG8_STAGE(PG8_SB(1, 1), cB + hstepB + kstep, voffB);
    PG8_WAIT_V(6); PG8_BAR;
    for (;;) {
        const bool has_next = S.next(ui + 1, nxt);
        const char* nA = has_next ? S.ptrA(nxt) : cA; const char* nB = has_next ? S.ptrB(nxt) : cB;
        for (int t = 0; t < nt; t += 2) {
            const bool last = (t == nt - 2);
            const char* a1 = cA + (size_t)(t + 1) * kstep;
            const char* a2 = last ? nA : cA + (size_t)(t + 2) * kstep; const char* b2 = last ? nB : cB + (size_t)(t + 2) * kstep;
            const char* a3 = a2 + kstep; const char* b3 = b2 + kstep;
            PG8_LDB(B0, 0, 0); PG8_LDB(B1, 0, 1); PG8_SCHED; PG8_LDA(At, 0, 0); PG8_STAGE(PG8_SA(1, 1), a1 + hstepA, voffA);
            PG8_WAIT_V(8); PG8_WAIT_L(0); PG8_BAR; PG8_MMA(0, 0, At, B0); PG8_MMA(0, 1, At, B1); PG8_BAR; PG8_SCHED;
            PG8_LDA(At, 0, 1); PG8_STAGE(PG8_SB(0, 0), b2, voffB); PG8_STAGE(PG8_SB(0, 1), b2 + hstepB, voffB); PG8_STAGE(PG8_SA(0, 0), a2, voffA);
            PG8_WAIT_V(8); PG8_WAIT_L(0); PG8_BAR; PG8_MMA(1, 0, At, B0); PG8_MMA(1, 1, At, B1); PG8_BAR; PG8_SCHED;
            PG8_LDB(B0, 1, 0); PG8_LDB(B1, 1, 1); PG8_SCHED; PG8_LDA(At, 1, 0); PG8_STAGE(PG8_SA(0, 1), a2 + hstepA, voffA);
            PG8_WAIT_V(8); PG8_WAIT_L(0); PG8_BAR; PG8_MMA(0, 0, At, B0); PG8_MMA(0, 1, At, B1); PG8_BAR; PG8_SCHED;
            PG8_LDA(At, 1, 1); PG8_STAGE(PG8_SB(1, 0), b3, voffB); PG8_STAGE(PG8_SB(1, 1), b3 + hstepB, voffB); PG8_STAGE(PG8_SA(1, 0), a3, voffA);
            PG8_WAIT_V(8); PG8_WAIT_L(0); PG8_BAR; PG8_MMA(1, 0, At, B0); PG8_MMA(1, 1, At, B1); PG8_BAR; PG8_SCHED;
        }
        if (wr == 0) PG8_BAR;
        E(acc, cur, wr, wc, fr, fq);
        if (!has_next) break;
#pragma unroll
        for (int a = 0; a < 2; ++a)
#pragma unroll
            for (int b = 0; b < 2; ++b)
#pragma unroll
                for (int m = 0; m < 4; ++m)
#pragma unroll
                    for (int n = 0; n < 2; ++n) acc[a][b][m][n] = (f32x4){0.f, 0.f, 0.f, 0.f};
        cur = nxt; cA = nA; cB = nB; ++ui;
        if (wr == 1) PG8_BAR;
    }
    PG8_WAIT_V(0);
    PG8_BAR;
#undef PG8_SA
#undef PG8_SB
#undef PG8_STAGE
#undef PG8_LDA
#undef PG8_LDB
#undef PG8_MMA
#undef PG8_WAIT_V
#undef PG8_WAIT_L
#undef PG8_BAR
#undef PG8_SCHED
}
}

namespace att {
constexpr int SHM_V = 64 * 128 * 2;
constexpr int SHM_K = 64 * 192 * 2;
constexpr int OFF_K = 2 * SHM_V, OFF_WS = OFF_K + 2 * SHM_K, OFF_RPB = OFF_WS + 8 * 64 * 4, ATT_LDS = OFF_RPB + 2048;
constexpr float THR = 8.f;
__device__ __forceinline__ int crow(int r, int hi) { return (r & 3) + 8 * (r >> 2) + 4 * hi; }
__device__ __forceinline__ int v_st(int k, int c) { const int kk = (k & ~0xC) | ((k & 4) << 1) | ((k & 8) >> 1); return ((kk >> 3) * 4 + (c >> 5)) * 512 + ((kk & 7) * 32 + (c & 31)) * 2; }
__device__ __forceinline__ int v_rd_base(int lane) { return ((lane & 3) << 3) | (((lane >> 2) & 3) << 6) | (((lane >> 4) & 1) << 5) | (((lane >> 5) & 1) << 8); }
constexpr int v_rd_off(int d0, int ks, int half) { return d0 * 512 + ks * 4096 + half * 2048; }
template <int OFF> __device__ __forceinline__ s16x4 tr_read(int vb) {
    s16x4 r; asm volatile("ds_read_b64_tr_b16 %0, %1 offset:%2" : "=&v"(r) : "v"(vb), "i"(OFF) : "memory"); return r;
}
template <int D0> __device__ __forceinline__ void pv_one(f32x16& od, int vb, bf16x8 pa0, bf16x8 pa1, bf16x8 pa2, bf16x8 pa3) {
    const s16x4 l0 = tr_read<v_rd_off(D0, 0, 0)>(vb), h0 = tr_read<v_rd_off(D0, 0, 1)>(vb), l1 = tr_read<v_rd_off(D0, 1, 0)>(vb), h1 = tr_read<v_rd_off(D0, 1, 1)>(vb);
    const s16x4 l2 = tr_read<v_rd_off(D0, 2, 0)>(vb), h2 = tr_read<v_rd_off(D0, 2, 1)>(vb), l3 = tr_read<v_rd_off(D0, 3, 0)>(vb), h3 = tr_read<v_rd_off(D0, 3, 1)>(vb);
    asm volatile("s_waitcnt lgkmcnt(0)" ::: "memory"); __builtin_amdgcn_sched_barrier(0);
#define PK(L, H) (bf16x8){L[0], L[1], L[2], L[3], H[0], H[1], H[2], H[3]}
    od = __builtin_amdgcn_mfma_f32_32x32x16_bf16(pa0, PK(l0, h0), od, 0, 0, 0);
    od = __builtin_amdgcn_mfma_f32_32x32x16_bf16(pa1, PK(l1, h1), od, 0, 0, 0);
    od = __builtin_amdgcn_mfma_f32_32x32x16_bf16(pa2, PK(l2, h2), od, 0, 0, 0);
    od = __builtin_amdgcn_mfma_f32_32x32x16_bf16(pa3, PK(l3, h3), od, 0, 0, 0);
#undef PK
}

struct UnitP {
    const bf16_t* Q; int ldq;
    const bf16_t* K1; int ldk1;
    const bf16_t* K2; int ldk2;
    const bf16_t* V; int ldv;
    bf16_t* O; int ldo;
    int NT, nlat, row_lat0, row_ctx0;
    float C, thr_raw;
    int rope_q, qpos0;
    int qgrow0, krow0;
};

template <int DQK, bool NA, bool MF = false>
__device__ __forceinline__ void attn_unit(const UnitP& P, char* lds) {
    constexpr int NQ = DQK / 16, KROWB = DQK * 2;
    const int tid = opaque_tid(), wid = __builtin_amdgcn_readfirstlane(tid >> 6), lane = tid & 63, r32 = lane & 31, hi = lane >> 5;
    char* V_lds = lds; char* K_lds = lds + OFF_K;
    float* wsf = (float*)(lds + OFF_WS) + wid * 64; float* li_l = wsf; float* al_l = wsf + 32;
    const float* rpbs = (const float*)(lds + OFF_RPB);
    float m_reg = -1e30f, l_reg = 0.f; f32x16 o[4];
#pragma unroll
    for (int d = 0; d < 4; ++d)
#pragma unroll
        for (int r = 0; r < 16; ++r) o[d][r] = 0.f;
    bf16x8 qr[NQ];
    { const bf16_t* Qw = P.Q + (size_t)(wid * 32 + r32) * P.ldq + hi * 8;
#pragma unroll
      for (int d0 = 0; d0 < NQ; ++d0) qr[d0] = *reinterpret_cast<const bf16x8*>(Qw + d0 * 16); }
    if constexpr (DQK == 192) {
        if (P.rope_q) {
            const int s = P.qpos0 + wid * 32 + r32; const float prow = (float)(s >> 6), pcol = (float)(s & 63);
#pragma unroll
            for (int e = 0; e < 8; ++e) {
                const float fr_ = __builtin_amdgcn_exp2f(-(float)(hi * 8 + e) * (13.287712379549449f / 16.f));
                const float ar = prow * fr_, ac = pcol * fr_;
                const float cr = __cosf(ar), sr = __sinf(ar), cc = __cosf(ac), sc = __sinf(ac);
                const float x1 = bf2f((unsigned short)qr[8][e]), x2 = bf2f((unsigned short)qr[9][e]), y1 = bf2f((unsigned short)qr[10][e]), y2 = bf2f((unsigned short)qr[11][e]);
                const unsigned w0 = cvtpk(x1 * cr - x2 * sr, x2 * cr + x1 * sr), w1 = cvtpk(y1 * cc - y2 * sc, y2 * cc + y1 * sc);
                qr[8][e] = (short)(w0 & 0xffffu); qr[9][e] = (short)(w0 >> 16); qr[10][e] = (short)(w1 & 0xffffu); qr[11][e] = (short)(w1 >> 16);
            }
        }
    }
    const int vb0 = (int)(uintptr_t)V_lds + v_rd_base(lane);
#define KSWZ(row, colB) ((row) * KROWB + ((colB) ^ (((row) & 7) << 4)))
#define TROW(t) ((t) < P.nlat ? P.row_lat0 + 64 * (t) : P.row_ctx0 + 64 * ((t) - P.nlat))
    LAS char* ldsl = (LAS char*)lds;
    constexpr int NKI = DQK / 64;
    int voffe[2]; const bf16_t* kbase[NKI]; int kld[NKI];
#pragma unroll
    for (int j = 0; j < 2; ++j) { const int X = (wid * 2 + j) * 1024 + lane * 16, st = X >> 9, kk = ((st >> 2) << 3) | ((X >> 6) & 7), c = ((st & 3) << 5) | ((X >> 1) & 31);
        const int k = (kk & ~0xC) | ((kk & 4) << 1) | ((kk & 8) >> 1); voffe[j] = k * P.ldv + c; }
#pragma unroll
    for (int j = 0; j < NKI; ++j) { const int X = (wid * NKI + j) * 1024 + lane * 16, row = X / KROWB, cb = X - row * KROWB, colB = cb ^ ((row & 7) << 4);
        if (DQK == 192 && colB >= 256) { kbase[j] = P.K2 + (size_t)row * P.ldk2 + ((colB - 256) >> 1); kld[j] = P.ldk2; }
        else { kbase[j] = P.K1 + (size_t)row * P.ldk1 + (colB >> 1); kld[j] = P.ldk1; } }
#define DMA(t, b) do { const size_t rb = (size_t)TROW(t); \
        _Pragma("unroll") for (int _j = 0; _j < 2; ++_j) __builtin_amdgcn_global_load_lds((const unsigned*)(P.V + rb * P.ldv + voffe[_j]), (LAS unsigned*)(ldsl + (b) * SHM_V + (wid * 2 + _j) * 1024), 16, 0, 0); \
        _Pragma("unroll") for (int _j = 0; _j < NKI; ++_j) __builtin_amdgcn_global_load_lds((const unsigned*)(kbase[_j] + rb * kld[_j]), (LAS unsigned*)(ldsl + OFF_K + (b) * SHM_K + (wid * NKI + _j) * 1024), 16, 0, 0); } while (0)
    const int qgrow = P.qgrow0 + (wid >> 1), qc = (wid & 1) * 32 + r32;
    const int r0w = min(max(qgrow - 4, 0), 24), c0 = min(max(qc - 8, 0), 48);
    DMA(0, 0); asm volatile("s_waitcnt vmcnt(0)" ::: "memory"); __syncthreads();
    for (int t = 0; t < P.NT; ++t) {
        if (t + 1 < P.NT) DMA(t + 1, (t + 1) & 1);
        bool act = true;
        if constexpr (NA) act = (t >= P.nlat) || ((unsigned)(P.krow0 + t - r0w) < 8u);
        if (act) {
            const char* Kb = K_lds + (t & 1) * SHM_K;
            f32x16 p0, p1;
#pragma unroll
            for (int r = 0; r < 16; ++r) { p0[r] = 0.f; p1[r] = 0.f; }
#pragma unroll
            for (int d0 = 0; d0 < NQ; ++d0) { const int cb = (d0 * 16 + hi * 8) * 2;
                const bf16x8 b0 = *reinterpret_cast<const bf16x8*>(Kb + KSWZ(r32, cb));
                const bf16x8 b1 = *reinterpret_cast<const bf16x8*>(Kb + KSWZ(32 + r32, cb));
                p0 = __builtin_amdgcn_mfma_f32_32x32x16_bf16(b0, qr[d0], p0, 0, 0, 0);
                p1 = __builtin_amdgcn_mfma_f32_32x32x16_bf16(b1, qr[d0], p1, 0, 0, 0); }
            if constexpr (NA) {
                if (t < P.nlat) {
                    const int dr = P.krow0 + t - qgrow + 7; const float* rp = rpbs + dr * 31;
                    int qcx = qc, c0x = c0, hix = hi; asm volatile("" : "+v"(qcx), "+v"(c0x), "+v"(hix));
#pragma unroll
                    for (int r = 0; r < 16; ++r) { const int kc0 = crow(r, hix), kc1 = 32 + kc0;
                        const float b0 = rp[min(max(kc0 - qcx + 15, 0), 30)], b1 = rp[min(max(kc1 - qcx + 15, 0), 30)];
                        p0[r] = ((unsigned)(kc0 - c0x) < 16u) ? p0[r] + b0 : -1e30f;
                        p1[r] = ((unsigned)(kc1 - c0x) < 16u) ? p1[r] + b1 : -1e30f;
                        if ((r & 3) == 3) asm volatile("" ::: "memory"); }
                }
            }
            float mn, alpha;
            if constexpr (MF) { mn = 0.f; alpha = 1.f; }
            else {
            float pmax = p0[0];
#pragma unroll
            for (int r = 1; r < 16; ++r) pmax = fmaxf(pmax, p0[r]);
#pragma unroll
            for (int r = 0; r < 16; ++r) pmax = fmaxf(pmax, p1[r]);
            { auto rr = __builtin_amdgcn_permlane32_swap(__float_as_uint(pmax), __float_as_uint(pmax), false, false);
              pmax = fmaxf(__uint_as_float(rr[0]), __uint_as_float(rr[1])); }
            if (__all(pmax - m_reg <= P.thr_raw)) { mn = m_reg; alpha = 1.f; }
            else { mn = fmaxf(m_reg, pmax); alpha = __builtin_amdgcn_exp2f((m_reg - mn) * P.C); m_reg = mn; }
            }
            const float mnC = -mn * P.C;
            float ps = 0.f;
#pragma unroll
            for (int r = 0; r < 16; ++r) { p0[r] = __builtin_amdgcn_exp2f(fmaf(p0[r], P.C, mnC)); p1[r] = __builtin_amdgcn_exp2f(fmaf(p1[r], P.C, mnC)); ps += p0[r] + p1[r]; }
            { auto rr = __builtin_amdgcn_permlane32_swap(__float_as_uint(ps), __float_as_uint(ps), false, false);
              ps = __uint_as_float(rr[0]) + __uint_as_float(rr[1]); }
            l_reg = l_reg * alpha + ps;
            if (!MF && __any(alpha < 1.f)) { if (hi == 0) al_l[r32] = alpha; asm volatile("s_waitcnt lgkmcnt(0)" ::: "memory");
#pragma unroll
                for (int r = 0; r < 16; ++r) { const float a = al_l[crow(r, hi)];
#pragma unroll
                    for (int d = 0; d < 4; ++d) o[d][r] *= a; } }
            bf16x8 pa0, pa1, pa2, pa3;
#define PK4(Pv, BASE, OUT) do { unsigned a0 = cvtpk(Pv[BASE + 0], Pv[BASE + 1]), a1 = cvtpk(Pv[BASE + 2], Pv[BASE + 3]);   \
    unsigned b0 = cvtpk(Pv[BASE + 4], Pv[BASE + 5]), b1 = cvtpk(Pv[BASE + 6], Pv[BASE + 7]);                              \
    auto r0 = __builtin_amdgcn_permlane32_swap(a0, b0, false, false); auto r1 = __builtin_amdgcn_permlane32_swap(a1, b1, false, false); \
    u32x4 w = {r0[0], r1[0], r0[1], r1[1]}; OUT = *reinterpret_cast<bf16x8*>(&w); } while (0)
            PK4(p0, 0, pa0); PK4(p0, 8, pa1); PK4(p1, 0, pa2); PK4(p1, 8, pa3);
#undef PK4
            const int vb = vb0 + (t & 1) * SHM_V;
            pv_one<0>(o[0], vb, pa0, pa1, pa2, pa3); pv_one<1>(o[1], vb, pa0, pa1, pa2, pa3); pv_one<2>(o[2], vb, pa0, pa1, pa2, pa3); pv_one<3>(o[3], vb, pa0, pa1, pa2, pa3);
        }
        asm volatile("s_waitcnt vmcnt(0)" ::: "memory");
        __syncthreads();
    }
    if (hi == 0) li_l[r32] = l_reg;
    asm volatile("s_waitcnt lgkmcnt(0)" ::: "memory");
    bf16_t* Ow = P.O + (size_t)(wid * 32) * P.ldo;
#pragma unroll
    for (int r = 0; r < 16; ++r) { const int orow = crow(r, hi); const float rl = __builtin_amdgcn_rcpf(li_l[orow]);
#pragma unroll
        for (int d0 = 0; d0 < 4; ++d0) Ow[(size_t)orow * P.ldo + d0 * 32 + r32] = (bf16_t)(cvtpk(o[d0][r] * rl, 0.f) & 0xffffu); }
    __syncthreads();
#undef KSWZ
#undef TROW
#undef DMA
}
}

#define XB_TMO      128
#define XB_XCNT(j)  (256  + 64 * (j))
#define XB_XSUB(j)  (1280 + 64 * (j))
#define XB_XGEN(j)  (2304 + 64 * (j))
#define XB_TOP      3328
#define XB_TOPGEN   3392
#define XCD_BAR_WORDS 3456
#define XB_SPIN_CAP (1u << 22)
__device__ __forceinline__ unsigned xb_ld(unsigned* p)              { return __hip_atomic_load(p, __ATOMIC_RELAXED, __HIP_MEMORY_SCOPE_AGENT); }
__device__ __forceinline__ unsigned xb_add(unsigned* p, unsigned v) { return __hip_atomic_fetch_add(p, v, __ATOMIC_RELAXED, __HIP_MEMORY_SCOPE_AGENT); }
__device__ __forceinline__ unsigned xb_xcc_id() { return (unsigned)__builtin_amdgcn_readfirstlane((int)((unsigned)__builtin_amdgcn_s_getreg((3 << 11) | 20) & 0xFu)); }
#define XB_SPIN(cond, bar) do { unsigned _sp = 0; while (cond) { __builtin_amdgcn_s_sleep(1); \
    if ((++_sp & 255u) == 0u) { if (xb_ld(&(bar)[XB_TMO])) break; if (_sp > XB_SPIN_CAP) { atomicAdd(&(bar)[XB_TMO], 1u); break; } } } } while (0)
struct XcdBarrier { unsigned* bar; unsigned x; volatile LAS unsigned* st; };
__device__ __forceinline__ XcdBarrier xcd_barrier_post(unsigned* bar, volatile LAS unsigned* st) {
    XcdBarrier b; b.bar = bar; b.x = 0; b.st = st;
    if (threadIdx.x == 0) (void)xb_add(&bar[XB_XCNT(xb_xcc_id())], 1u);
    return b;
}
__device__ __forceinline__ void xcd_barrier_complete(unsigned* bar, unsigned x, unsigned& nloc, unsigned& nx) {
    const unsigned G = gridDim.x * gridDim.y * gridDim.z;
    unsigned sum, cnt, mine, sp = 0u;
    for (;;) {
        sum = 0u; cnt = 0u; mine = 0u;
#pragma unroll
        for (unsigned j = 0; j < 16; ++j) { const unsigned c = xb_ld(&bar[XB_XCNT(j)]); sum += c; cnt += (c > 0u) ? 1u : 0u; mine = (j == x) ? c : mine; }
        if (sum == G) break;
        __builtin_amdgcn_s_sleep(1);
        if ((++sp & 255u) == 0u) { if (xb_ld(&bar[XB_TMO])) break; if (sp > XB_SPIN_CAP) { atomicAdd(&bar[XB_TMO], 1u); break; } }
    }
    nloc = mine > 0u ? mine : 1u; nx = cnt > 0u ? cnt : 1u;
}
__device__ __forceinline__ void xcd_barrier(const XcdBarrier& b) {
    asm volatile("s_waitcnt vmcnt(0)" ::: "memory");
    __syncthreads();
    if (threadIdx.x == 0) {
        unsigned* bar = b.bar; const unsigned bx = xb_xcc_id();
        __builtin_amdgcn_s_waitcnt(0);
        unsigned nloc = b.st[0], nx = b.st[1];
        if (nloc == 0u) { xcd_barrier_complete(bar, bx, nloc, nx); b.st[0] = nloc; b.st[1] = nx; }
        const unsigned old = xb_add(&bar[XB_XSUB(bx)], 1u);
        const unsigned gen = old / nloc;
        if (old + 1u == (gen + 1u) * nloc) {
            __builtin_amdgcn_fence(__ATOMIC_RELEASE, "agent");
            asm volatile("s_waitcnt vmcnt(0)" ::: "memory");
            const unsigned og = xb_add(&bar[XB_TOP], 1u);
            const unsigned tg = og / nx;
            if (og + 1u == (tg + 1u) * nx) xb_add(&bar[XB_TOPGEN], 1u);
            else XB_SPIN(xb_ld(&bar[XB_TOPGEN]) == tg, bar);
            __builtin_amdgcn_fence(__ATOMIC_ACQUIRE, "agent");
            xb_add(&bar[XB_XGEN(bx)], 1u);
            asm volatile("s_waitcnt vmcnt(0)" ::: "memory");
        } else {
            XB_SPIN(xb_ld(&bar[XB_XGEN(bx)]) == gen, bar);
            __builtin_amdgcn_fence(__ATOMIC_ACQUIRE, "agent");
            asm volatile("s_waitcnt vmcnt(0)" ::: "memory");
        }
    }
    __syncthreads();
}

struct Args { const float* in[25]; float* out; unsigned char* ws; };
enum { I_X = 0, I_C, I_CTX, I_CCTX, I_WADA, I_BADA, I_GPRE1, I_GPOST1, I_GPRE2, I_GPOST2, I_WIN, I_RPB, I_GQN, I_GKN, I_MQN, I_MKVN, I_WUQ, I_WUKV, I_WBRA, I_WBRB, I_WBRC, I_WO, I_WFF1, I_WFF3, I_WFF2 };

struct TItem { const float* W; bf16_t* WT; int K, N, k0, n0, dbase; bool mode13, gate8; };
__device__ __forceinline__ TItem titem_get(const Args& a, int l, int it) {
    unsigned char* ws = a.ws; TItem d;
    constexpr int I_IN = 32 * 370, I_13 = 32 * 176, I_2 = 88 * 64, I_O = 32 * 64, I_BR = 16 * 64, I_UQ = 8 * 48;
    int r = it; d.mode13 = false; d.gate8 = false;
    if (r < I_IN) { const int kb = r / 370, nb = r % 370, n0 = nb * 32; d.W = a.in[I_WIN] + (size_t)l * DM * INW; d.K = DM; d.N = INW; d.WT = (bf16_t*)(ws + WS_WIN);
        d.k0 = kb * 64; d.n0 = n0; d.dbase = n0 < 4096 ? n0 : (n0 < 5696 ? n0 + 6144 : n0 - 1600);
        if (n0 >= 5696) { d.gate8 = true; d.dbase = n0 - 5696; d.WT = (bf16_t*)(ws + WS_WG8); }
        return d; }
    r -= I_IN;
    if (r < 2 * I_13) { const int which = r / I_13; r -= which * I_13; const int kb = r / 176, nb = r % 176; d.W = a.in[which ? I_WFF3 : I_WFF1] + (size_t)l * DM * DFF; d.K = DM; d.N = DFF; d.WT = (bf16_t*)(ws + WS_W13);
        d.k0 = kb * 64; d.n0 = nb * 32; d.dbase = 64 * nb + 16 * which; d.mode13 = true; return d; }
    r -= 2 * I_13;
    if (r < I_2) { const int kb = r / 64, nb = r % 64; d.W = a.in[I_WFF2] + (size_t)l * DFF * DM; d.K = DFF; d.N = DM; d.WT = (bf16_t*)(ws + WS_W2); d.k0 = kb * 64; d.n0 = nb * 32; d.dbase = nb * 32; return d; }
    r -= I_2;
    if (r < I_O) { const int kb = r / 64, nb = r % 64; d.W = a.in[I_WO] + (size_t)l * DM * DM; d.K = DM; d.N = DM; d.WT = (bf16_t*)(ws + WS_WO); d.k0 = kb * 64; d.n0 = nb * 32; d.dbase = nb * 32; return d; }
    r -= I_O;
    if (r < 3 * I_BR) { const int br = r / I_BR; r -= br * I_BR; const int kb = r / 64, nb = r % 64; d.W = a.in[I_WBRA + br] + (size_t)l * 1024 * DM; d.K = 1024; d.N = DM; d.WT = (bf16_t*)(ws + WS_WBR) + (size_t)br * 2048 * 1024;
        d.k0 = kb * 64; d.n0 = nb * 32; d.dbase = nb * 32; return d; }
    r -= 3 * I_BR;
    if (r < I_UQ) { const int kb = r / 48, nb = r % 48; d.W = a.in[I_WUQ] + (size_t)l * 512 * 1536; d.K = 512; d.N = 1536; d.WT = (bf16_t*)(ws + WS_WUQ); d.k0 = kb * 64; d.n0 = nb * 32; d.dbase = nb * 32; return d; }
    r -= I_UQ;
    { const int kb = r / 64, nb = r % 64; d.W = a.in[I_WUKV] + (size_t)l * 512 * 2048; d.K = 512; d.N = 2048; d.WT = (bf16_t*)(ws + WS_WUKV); d.k0 = kb * 64; d.n0 = nb * 32; d.dbase = nb * 32; return d; }
}
__device__ __forceinline__ void titem_load(const TItem& d, int lane, f32x4 (&v)[8]) {
    const int kq = lane >> 3, nq = (lane & 7) * 4;
    const float* Wp = d.W + (size_t)(d.k0 + kq) * d.N + d.n0 + nq;
#pragma unroll
    for (int i = 0; i < 8; ++i) v[i] = __builtin_nontemporal_load((const f32x4*)(Wp + (size_t)(8 * i) * d.N));
}
__device__ __forceinline__ void titem_store(const TItem& d, int lane, const f32x4 (&v)[8], LAS float* scr) {
    { const int kq = lane >> 3, nq = (lane & 7) * 4;
#pragma unroll
      for (int i = 0; i < 8; ++i) { LAS float* p = scr + (8 * i + kq) * 33 + nq; p[0] = v[i].x; p[1] = v[i].y; p[2] = v[i].z; p[3] = v[i].w; } }
    asm volatile("s_waitcnt lgkmcnt(0)" ::: "memory");
    const int c = lane & 7;
#pragma unroll
    for (int j = 0; j < 4; ++j) { const int n = (lane >> 3) + 8 * j; const LAS float* s = scr + (8 * c) * 33 + n;
        u32x4 o; o.x = cvtpk(s[0 * 33], s[1 * 33]); o.y = cvtpk(s[2 * 33], s[3 * 33]); o.z = cvtpk(s[4 * 33], s[5 * 33]); o.w = cvtpk(s[6 * 33], s[7 * 33]);
        const int drow = d.mode13 ? d.dbase + 32 * (n >> 4) + (n & 15) : d.dbase + n;
        if (d.gate8) { int w0 = 0, w1 = 0;
            w0 = __builtin_amdgcn_cvt_pk_fp8_f32(s[0 * 33] * 64.f, s[1 * 33] * 64.f, w0, false); w0 = __builtin_amdgcn_cvt_pk_fp8_f32(s[2 * 33] * 64.f, s[3 * 33] * 64.f, w0, true);
            w1 = __builtin_amdgcn_cvt_pk_fp8_f32(s[4 * 33] * 64.f, s[5 * 33] * 64.f, w1, false); w1 = __builtin_amdgcn_cvt_pk_fp8_f32(s[6 * 33] * 64.f, s[7 * 33] * 64.f, w1, true);
            *(u32x2*)((unsigned char*)d.WT + (size_t)drow * d.K + d.k0 + 8 * c) = (u32x2){(unsigned)w0, (unsigned)w1}; }
        else *(u32x4*)(d.WT + (size_t)drow * d.K + d.k0 + 8 * c) = o; }
    asm volatile("s_waitcnt lgkmcnt(0)" ::: "memory");
}
__device__ __forceinline__ void convert_weights(const Args& a, int l, int gw, int NGW, int lane, LAS float* scr) {
    lane = opaque_tid() & 63;
    constexpr int NITEMS = 32 * 370 + 2 * 32 * 176 + 88 * 64 + 32 * 64 + 3 * 16 * 64 + 8 * 48 + 8 * 64;
    if (gw >= NITEMS) return;
    TItem cur = titem_get(a, l, gw); f32x4 vc[8]; titem_load(cur, lane, vc);
    for (int it = gw; it < NITEMS; it += NGW) {
        const int nx = it + NGW; const bool has = nx < NITEMS;
        TItem nxt = cur; f32x4 vn[8];
        if (has) { nxt = titem_get(a, l, nx); titem_load(nxt, lane, vn); }
        titem_store(cur, lane, vc, scr);
        if (has) { cur = nxt;
#pragma unroll
            for (int i = 0; i < 8; ++i) vc[i] = vn[i]; }
    }
}

__device__ __forceinline__ void mod_phase(const Args& a, unsigned char* lds, int bid, int G, int tid) {
    if (bid >= 192) return;
    const int wid = tid >> 6, lane = tid & 63;
    float* sv = (float*)lds;
    float* red = (float*)(lds + 9 * 2048 * 4);
    for (int i = tid; i < 9 * 2048; i += 512) { const int j = i >> 11, d = i & 2047; const float v = (j < 8) ? a.in[I_C][j * 2048 + d] : a.in[I_CCTX][d]; sv[i] = v * sigmoidf_(v); }
    __syncthreads();
    for (int item = bid; item < 192; item += G) {
    const int l = item / 96, e0 = (item % 96) * 128;
    const float* W = a.in[I_WADA] + (size_t)l * DM * MODW + e0 + 2 * lane;
    float acc[9][2];
#pragma unroll
    for (int j = 0; j < 9; ++j) { acc[j][0] = 0.f; acc[j][1] = 0.f; }
    const int dbeg = wid * 256;
    for (int d = dbeg; d < dbeg + 256; d += 16) {
        float2 w[16];
#pragma unroll
        for (int q = 0; q < 16; ++q) w[q] = *(const float2*)(W + (size_t)(d + q) * MODW);
#pragma unroll
        for (int q = 0; q < 16; ++q) {
#pragma unroll
            for (int j = 0; j < 9; ++j) { const float s = sv[j * 2048 + d + q]; acc[j][0] = fmaf(s, w[q].x, acc[j][0]); acc[j][1] = fmaf(s, w[q].y, acc[j][1]); }
            if ((q & 1) == 1) asm volatile("" ::: "memory"); }
    }
#pragma unroll
    for (int j = 0; j < 9; ++j) { red[((wid * 9 + j) * 2 + 0) * 64 + lane] = acc[j][0]; red[((wid * 9 + j) * 2 + 1) * 64 + lane] = acc[j][1]; }
    __syncthreads();
    float* mod = (float*)(a.ws + WS_MOD);
    for (int i = tid; i < 9 * 128; i += 512) { const int j = i >> 7, t = i & 127, ln = t >> 1, q = t & 1; float s = 0.f;
#pragma unroll
        for (int w = 0; w < 8; ++w) s += red[((w * 9 + j) * 2 + q) * 64 + ln];
        mod[(size_t)(l * 9 + j) * MODW + e0 + t] = s + a.in[I_BADA][l * MODW + e0 + t]; }
    __syncthreads();
    }
}

template <bool HAS_T, bool HAS_H>
__device__ __forceinline__ void row_phase(int bid, int G, int nrows, const float* xl_src, const float* xc_src, float* xl_dst, float* xc_dst,
                                          const bf16_t* T, const float* Tp, const float* modL, int gt_off, const float* g_post,
                                          const float* g_pre, const float* modN, int sh_off, int sc_off, bf16_t* H, unsigned char* H8, unsigned char* lds) {
    const int tid = opaque_tid(), lane = tid & 63, wave = tid >> 6;
    f32x4* P4 = (f32x4*)lds;
    for (int part = 0; part < 2; ++part) {
    int rb, re;
    if (part == 0) { const int per = (NLAT + G - 1) / G; rb = bid * per; re = min(rb + per, NLAT); }
    else { if (nrows <= NLAT) break; const int per = (nrows - NLAT + G - 1) / G; rb = NLAT + bid * per; re = min(rb + per, nrows); }
    for (int sb = rb; sb < re;) {
        const int j = sb < NLAT ? (sb >> 11) : 8;
        const int jend = j < 8 ? ((j + 1) << 11) : nrows, se = min(re, jend);
        __syncthreads();
        if constexpr (HAS_T) { P4[tid] = ((const f32x4*)(modL + (size_t)j * MODW + gt_off))[tid]; P4[512 + tid] = ((const f32x4*)g_post)[tid]; }
        if constexpr (HAS_H) { P4[1024 + tid] = ((const f32x4*)g_pre)[tid]; P4[1536 + tid] = ((const f32x4*)(modN + (size_t)j * MODW + sc_off))[tid]; P4[2048 + tid] = ((const f32x4*)(modN + (size_t)j * MODW + sh_off))[tid]; }
        __syncthreads();
        for (int r0 = sb + wave * 2; r0 < se; r0 += 16) {
            const bool two = (r0 + 1 < se); const int r1 = two ? r0 + 1 : r0;
            const bool lat = r0 < NLAT;
            const f32x4* s0 = (const f32x4*)(lat ? xl_src + (size_t)r0 * DM : xc_src + (size_t)(r0 - NLAT) * DM) + lane;
            const f32x4* s1 = (const f32x4*)(lat ? xl_src + (size_t)r1 * DM : xc_src + (size_t)(r1 - NLAT) * DM) + lane;
            f32x4 va[8], vb[8];
#pragma unroll
            for (int q = 0; q < 8; ++q) { va[q] = __builtin_nontemporal_load(s0 + 64 * q); vb[q] = __builtin_nontemporal_load(s1 + 64 * q); }
            if constexpr (HAS_T) {
                const u32x2* t0 = (const u32x2*)(T + (size_t)r0 * DM) + lane; const u32x2* t1 = (const u32x2*)(T + (size_t)r1 * DM) + lane;
                f32x4 fa[8], fb[8];
                if (lat || Tp == nullptr) {
#pragma unroll
                    for (int q = 0; q < 8; ++q) { const u32x2 ta = __builtin_nontemporal_load(t0 + 64 * q), tb = __builtin_nontemporal_load(t1 + 64 * q);
                        fa[q] = (f32x4){bflo(ta.x), bfhi(ta.x), bflo(ta.y), bfhi(ta.y)}; fb[q] = (f32x4){bflo(tb.x), bfhi(tb.x), bflo(tb.y), bfhi(tb.y)}; }
                } else {
                    const f32x4* p0 = (const f32x4*)(Tp + (size_t)(r0 - NLAT) * DM) + lane; const f32x4* p1 = (const f32x4*)(Tp + (size_t)(r1 - NLAT) * DM) + lane;
                    constexpr size_t SL = (size_t)NCTX * DM / 4;
                    f32x4 ua[8];
#pragma unroll
                    for (int q = 0; q < 8; ++q) { fa[q] = p0[64 * q]; ua[q] = p0[SL + 64 * q]; }
                    asm volatile("" ::: "memory");
#pragma unroll
                    for (int q = 0; q < 8; ++q) { fa[q] = fa[q] + ua[q]; fb[q] = p1[64 * q]; ua[q] = p0[2 * SL + 64 * q]; }
                    asm volatile("" ::: "memory");
#pragma unroll
                    for (int q = 0; q < 8; ++q) { fa[q] = fa[q] + ua[q]; ua[q] = p0[3 * SL + 64 * q]; }
                    asm volatile("" ::: "memory");
#pragma unroll
                    for (int q = 0; q < 8; ++q) { fa[q] = fa[q] + ua[q]; ua[q] = p1[SL + 64 * q]; }
                    asm volatile("" ::: "memory");
#pragma unroll
                    for (int q = 0; q < 8; ++q) { fb[q] = fb[q] + ua[q]; ua[q] = p1[2 * SL + 64 * q]; }
                    asm volatile("" ::: "memory");
#pragma unroll
                    for (int q = 0; q < 8; ++q) { fb[q] = fb[q] + ua[q]; ua[q] = p1[3 * SL + 64 * q]; }
                    asm volatile("" ::: "memory");
#pragma unroll
                    for (int q = 0; q < 8; ++q) fb[q] = fb[q] + ua[q];
                }
                float sa = 0.f, sbb = 0.f;
#pragma unroll
                for (int q = 0; q < 8; ++q) { sa += (fa[q].x * fa[q].x + fa[q].y * fa[q].y) + (fa[q].z * fa[q].z + fa[q].w * fa[q].w); sbb += (fb[q].x * fb[q].x + fb[q].y * fb[q].y) + (fb[q].z * fb[q].z + fb[q].w * fb[q].w); }
                const float ra = rsqrtf(wave_sum(sa) * (1.f / DM) + EPS), rbb = rsqrtf(wave_sum(sbb) * (1.f / DM) + EPS);
                f32x4* d0 = (f32x4*)(lat ? xl_dst + (size_t)r0 * DM : xc_dst + (size_t)(r0 - NLAT) * DM) + lane;
                f32x4* d1 = (f32x4*)(lat ? xl_dst + (size_t)r1 * DM : xc_dst + (size_t)(r1 - NLAT) * DM) + lane;
#pragma unroll
                for (int q = 0; q < 8; ++q) { const f32x4 w = P4[lane + 64 * q] * P4[512 + lane + 64 * q];
                    va[q] = va[q] + w * (fa[q] * ra); vb[q] = vb[q] + w * (fb[q] * rbb);
                    __builtin_nontemporal_store(va[q], d0 + 64 * q); if (two) __builtin_nontemporal_store(vb[q], d1 + 64 * q); }
            }
            if constexpr (HAS_H) {
                float sa = 0.f, sbb = 0.f;
#pragma unroll
                for (int q = 0; q < 8; ++q) { sa += (va[q].x * va[q].x + va[q].y * va[q].y) + (va[q].z * va[q].z + va[q].w * va[q].w); sbb += (vb[q].x * vb[q].x + vb[q].y * vb[q].y) + (vb[q].z * vb[q].z + vb[q].w * vb[q].w); }
                const float ra = rsqrtf(wave_sum(sa) * (1.f / DM) + EPS), rbb = rsqrtf(wave_sum(sbb) * (1.f / DM) + EPS);
                u32x2* h0 = (u32x2*)(H + (size_t)r0 * DM) + lane; u32x2* h1 = (u32x2*)(H + (size_t)r1 * DM) + lane;
#pragma unroll
                for (int q = 0; q < 8; ++q) { const f32x4 g = P4[1024 + lane + 64 * q] * (P4[1536 + lane + 64 * q] + 1.f), sh = P4[2048 + lane + 64 * q];
                    const f32x4 ha = (va[q] * ra) * g + sh, hb = (vb[q] * rbb) * g + sh;
                    u32x2 wa; wa.x = cvtpk(ha.x, ha.y); wa.y = cvtpk(ha.z, ha.w); h0[64 * q] = wa;
                    if (two) { u32x2 wb; wb.x = cvtpk(hb.x, hb.y); wb.y = cvtpk(hb.z, hb.w); h1[64 * q] = wb; }
                    if (H8) { int ea = 0, eb = 0;
                        ea = __builtin_amdgcn_cvt_pk_fp8_f32(ha.x, ha.y, ea, false); ea = __builtin_amdgcn_cvt_pk_fp8_f32(ha.z, ha.w, ea, true);
                        eb = __builtin_amdgcn_cvt_pk_fp8_f32(hb.x, hb.y, eb, false); eb = __builtin_amdgcn_cvt_pk_fp8_f32(hb.z, hb.w, eb, true);
                        ((int*)(H8 + (size_t)r0 * DM))[lane + 64 * q] = ea; if (two) ((int*)(H8 + (size_t)r1 * DM))[lane + 64 * q] = eb; } }
            }
        }
        sb = se;
    }
    }
    __syncthreads();
}

__device__ __forceinline__ float half_sum(float v) {
#pragma unroll
    for (int o = 1; o < 32; o <<= 1) v += __shfl_xor(v, o);
    return v;
}
__device__ __forceinline__ void prep_phase(const Args& a, int l, int gw, int NGW, int lane_in) {
    const int lane = opaque_tid() & 63, half = lane >> 5, hl = lane & 31;
    bf16_t* Z = (bf16_t*)(a.ws + WS_Z);
    const float* gqn = a.in[I_GQN] + l * 128; const float* gkn = a.in[I_GKN] + l * 128;
    const float* mqn = a.in[I_MQN] + l * 512; const float* mkvn = a.in[I_MKVN] + l * 512;
    constexpr float L2T = 13.287712379549449f;
    float gq[4], gk[4], gf[4];
#pragma unroll
    for (int e = 0; e < 4; ++e) { gq[e] = gqn[4 * hl + e]; gk[e] = gkn[4 * hl + e]; gf[e] = __builtin_amdgcn_exp2f(-(float)(((4 * hl) & 31) + e) * (L2T / 32.f)); }
    const bool is_x1 = ((hl & 15) < 8);
    const float kf0 = __builtin_amdgcn_exp2f(-(float)((2 * hl) & 15) * (L2T / 16.f)), kf1 = __builtin_amdgcn_exp2f(-(float)(((2 * hl) & 15) + 1) * (L2T / 16.f));
    for (int rp = gw; rp < MTOT / 2; rp += NGW) {
        const int r = 2 * rp + half;
        bf16_t* zr = Z + (size_t)r * LDZ;
        const bool lat = r < NLAT; const int s = r & 2047; const float prow = (float)(s >> 6), pcol = (float)(s & 63);
        const float pos = (hl >> 4) ? pcol : prow;
        float gc[4], gs[4];
#pragma unroll
        for (int e = 0; e < 4; ++e) { gc[e] = lat ? __cosf(pos * gf[e]) : 1.f; gs[e] = lat ? __sinf(pos * gf[e]) : 0.f; if (is_x1) gs[e] = -gs[e]; }
        u32x2 wq[10]; u32x4 wa[2], wb[2];
#pragma unroll
        for (int hh = 0; hh < 10; ++hh) wq[hh] = ((const u32x2*)(zr + (hh < 8 ? ZC_BQ + hh * 128 : ZC_BK + (hh - 8) * 128)))[hl];
#pragma unroll
        for (int w2 = 0; w2 < 2; ++w2) { const u32x4* p = (const u32x4*)(zr + (w2 ? ZC_CKV : ZC_CQ)) + 2 * hl; wa[w2] = p[0]; wb[w2] = p[1]; }
        const unsigned wk = ((const unsigned*)(zr + ZC_CKR))[hl];
        asm volatile("" ::: "memory");
        float ssq[10];
#pragma unroll
        for (int hh = 0; hh < 10; ++hh) { const float x0 = bflo(wq[hh].x), x1 = bfhi(wq[hh].x), x2 = bflo(wq[hh].y), x3 = bfhi(wq[hh].y); ssq[hh] = (x0 * x0 + x1 * x1) + (x2 * x2 + x3 * x3); }
#pragma unroll
        for (int o = 1; o < 32; o <<= 1)
#pragma unroll
            for (int hh = 0; hh < 10; ++hh) ssq[hh] += __shfl_xor(ssq[hh], o);
#pragma unroll
        for (int hh = 0; hh < 10; ++hh) {
            const float x[4] = { bflo(wq[hh].x), bfhi(wq[hh].x), bflo(wq[hh].y), bfhi(wq[hh].y) };
            const float rstd = rsqrtf(ssq[hh] * (1.f / 128.f) + EPS);
            float y[4], o[4];
#pragma unroll
            for (int e = 0; e < 4; ++e) y[e] = x[e] * rstd * (hh < 8 ? gq[e] : gk[e]);
#pragma unroll
            for (int e = 0; e < 4; ++e) { const float q = __shfl_xor(y[e], 8); o[e] = y[e] * gc[e] + q * gs[e]; }
            u32x2 ow; ow.x = cvtpk(o[0], o[1]); ow.y = cvtpk(o[2], o[3]);
            ((u32x2*)(zr + (hh < 8 ? ZC_BQ + hh * 128 : ZC_BK + (hh - 8) * 128)))[hl] = ow;
        }
#pragma unroll
        for (int w2 = 0; w2 < 2; ++w2) {
            u32x4* p = (u32x4*)(zr + (w2 ? ZC_CKV : ZC_CQ)) + 2 * hl; const float* g = (w2 ? mkvn : mqn) + 16 * hl;
            const u32x4 va = wa[w2], vb = wb[w2];
            float x[16] = { bflo(va.x), bfhi(va.x), bflo(va.y), bfhi(va.y), bflo(va.z), bfhi(va.z), bflo(va.w), bfhi(va.w), bflo(vb.x), bfhi(vb.x), bflo(vb.y), bfhi(vb.y), bflo(vb.z), bfhi(vb.z), bflo(vb.w), bfhi(vb.w) };
            float ss = 0.f;
#pragma unroll
            for (int e = 0; e < 16; ++e) ss += x[e] * x[e];
            const float rstd = rsqrtf(half_sum(ss) * (1.f / 512.f) + EPS);
#pragma unroll
            for (int e = 0; e < 16; ++e) x[e] = x[e] * rstd * g[e];
            u32x4 oa, ob; oa.x = cvtpk(x[0], x[1]); oa.y = cvtpk(x[2], x[3]); oa.z = cvtpk(x[4], x[5]); oa.w = cvtpk(x[6], x[7]);
            ob.x = cvtpk(x[8], x[9]); ob.y = cvtpk(x[10], x[11]); ob.z = cvtpk(x[12], x[13]); ob.w = cvtpk(x[14], x[15]);
            p[0] = oa; p[1] = ob;
        }
        {
            float c0 = lat ? __cosf(pos * kf0) : 1.f, s0 = lat ? __sinf(pos * kf0) : 0.f, c1 = lat ? __cosf(pos * kf1) : 1.f, s1 = lat ? __sinf(pos * kf1) : 0.f;
            if (is_x1) { s0 = -s0; s1 = -s1; }
            const float y0 = bflo(wk), y1 = bfhi(wk);
            const float q0 = __shfl_xor(y0, 8), q1 = __shfl_xor(y1, 8);
            if (lat) ((unsigned*)(zr + ZC_CKR))[hl] = cvtpk(y0 * c0 + q0 * s0, y1 * c1 + q1 * s1);
        }
    }
}

__device__ __forceinline__ void attn_phase(const Args& a, int l, bool ctx_out, int vcu, int G, char* lds) {
    const bf16_t* Z = (const bf16_t*)(a.ws + WS_Z); const bf16_t* QC = (const bf16_t*)(a.ws + WS_H); const bf16_t* KVC = (const bf16_t*)(a.ws + WS_KVC);
    bf16_t* O = (bf16_t*)(a.ws + WS_O);
    const float C128 = 0.08838834764831845f * 1.4426950408889634f, C192 = 0.07216878364870323f * 1.4426950408889634f;
    const float T128 = att::THR / 0.08838834764831845f, T192 = att::THR / 0.07216878364870323f;
    bool gqa_mf;
    { const int ln = opaque_tid() & 63; const float* gq = a.in[I_GQN] + l * 128; const float* gk = a.in[I_GKN] + l * 128;
      float mq = fmaxf(fabsf(gq[ln]), fabsf(gq[ln + 64])), mk = fmaxf(fabsf(gk[ln]), fabsf(gk[ln + 64]));
#pragma unroll
      for (int o = 1; o < 64; o <<= 1) { mq = fmaxf(mq, __shfl_xor(mq, o)); mk = fmaxf(mk, __shfl_xor(mk, o)); }
      gqa_mf = (11.313708498984761f * mq * mk < 60.f); }
    for (int uidx = vcu; uidx < 512; uidx += G) {
        const int b = (uidx & 255) >> 5, j = uidx & 31, rd = uidx >> 8, qb = j & 7;
        const size_t qrow = (size_t)b * SEQ + qb * 256;
        {
            const int kvh = rd, head = kvh * 4 + (j >> 3);
            att::UnitP P; P.Q = Z + qrow * LDZ + ZC_BQ + head * 128; P.ldq = LDZ; P.K1 = Z + ZC_BK + kvh * 128; P.ldk1 = LDZ; P.K2 = nullptr; P.ldk2 = 0;
            P.V = Z + ZC_BV + kvh * 128; P.ldv = LDZ; P.O = O + qrow * LDO + 1024 + head * 128; P.ldo = LDO;
            P.NT = 36; P.nlat = 32; P.row_lat0 = b * SEQ; P.row_ctx0 = NLAT + b * CTXL; P.C = C128; P.thr_raw = T128; P.rope_q = 0; P.qpos0 = 0; P.qgrow0 = 0; P.krow0 = 0;
            if (gqa_mf) att::attn_unit<128, false, true>(P, lds); else att::attn_unit<128, false>(P, lds);
        }
        const int head = rd * 4 + (j >> 3);
        {
            att::UnitP P; P.Q = QC + qrow * LDQC + head * 192; P.ldq = LDQC; P.K1 = KVC + head * 256; P.ldk1 = LDKVC; P.K2 = Z + ZC_CKR; P.ldk2 = LDZ;
            P.V = KVC + head * 256 + 128; P.ldv = LDKVC; P.O = O + qrow * LDO + 2048 + head * 128; P.ldo = LDO;
            P.NT = 36; P.nlat = 32; P.row_lat0 = b * SEQ; P.row_ctx0 = NLAT + b * CTXL; P.C = C192; P.thr_raw = T192; P.rope_q = 1; P.qpos0 = qb * 256; P.qgrow0 = 0; P.krow0 = 0;
            att::attn_unit<192, false>(P, lds);
        }
        {
            const int g0 = 4 * qb, krow0 = min(max(g0 - 4, 0), 24), klast = min(max(g0 + 3 - 4, 0), 24) + 7, nr = klast - krow0 + 1;
            float* rpbs = (float*)(lds + att::OFF_RPB);
            const float* rpb = a.in[I_RPB] + ((size_t)l * 8 + head) * 465;
            for (int i = opaque_tid(); i < 465; i += 512) rpbs[i] = rpb[i] * 11.313708498984761f;
            att::UnitP P; P.Q = Z + qrow * LDZ + ZC_AQ + head * 128; P.ldq = LDZ; P.K1 = Z + ZC_AK + head * 128; P.ldk1 = LDZ; P.K2 = nullptr; P.ldk2 = 0;
            P.V = Z + ZC_AV + head * 128; P.ldv = LDZ; P.O = O + qrow * LDO + head * 128; P.ldo = LDO;
            P.NT = nr + 4; P.nlat = nr; P.row_lat0 = b * SEQ + krow0 * 64; P.row_ctx0 = NLAT + b * CTXL; P.C = C128; P.thr_raw = T128; P.rope_q = 0; P.qpos0 = 0; P.qgrow0 = g0; P.krow0 = krow0;
            att::attn_unit<128, true>(P, lds);
        }
    }
    if (ctx_out) {
        for (int u = vcu; u < 192; u += G) {
            const int mixer = u / 64, b = (u % 64) >> 3, head = u & 7;
            const size_t qrow = (size_t)NLAT + (size_t)b * CTXL;
            att::UnitP P; P.NT = 4; P.nlat = 0; P.row_lat0 = 0; P.row_ctx0 = NLAT + b * CTXL; P.rope_q = 0; P.qpos0 = 0; P.qgrow0 = 0; P.krow0 = 0; P.K2 = nullptr; P.ldk2 = 0; P.ldo = LDO;
            if (mixer == 0) { P.Q = Z + qrow * LDZ + ZC_AQ + head * 128; P.ldq = LDZ; P.K1 = Z + ZC_AK + head * 128; P.ldk1 = LDZ; P.V = Z + ZC_AV + head * 128; P.ldv = LDZ;
                P.O = O + qrow * LDO + head * 128; P.C = C128; P.thr_raw = T128; att::attn_unit<128, false>(P, lds); }
            else if (mixer == 1) { const int kvh = head >> 2; P.Q = Z + qrow * LDZ + ZC_BQ + head * 128; P.ldq = LDZ; P.K1 = Z + ZC_BK + kvh * 128; P.ldk1 = LDZ; P.V = Z + ZC_BV + kvh * 128; P.ldv = LDZ;
                P.O = O + qrow * LDO + 1024 + head * 128; P.C = C128; P.thr_raw = T128; if (gqa_mf) att::attn_unit<128, false, true>(P, lds); else att::attn_unit<128, false>(P, lds); }
            else { P.Q = QC + qrow * LDQC + head * 192; P.ldq = LDQC; P.K1 = KVC + head * 256; P.ldk1 = LDKVC; P.K2 = Z + ZC_CKR; P.ldk2 = LDZ; P.V = KVC + head * 256 + 128; P.ldv = LDKVC;
                P.O = O + qrow * LDO + 2048 + head * 128; P.C = C192; P.thr_raw = T192; att::attn_unit<192, false>(P, lds); }
        }
    }
}

__global__ void __launch_bounds__(512, 2) fwd_megakernel(Args a) {
    extern __shared__ __attribute__((aligned(16))) unsigned char lds[];
    cg::grid_group grid = cg::this_grid();
    const int tid = threadIdx.x, lane = tid & 63, wave = __builtin_amdgcn_readfirstlane(tid >> 6);
    const int G = gridDim.x, bid = blockIdx.x;
    const int vcu = (G % 8 == 0) ? (bid % 8) * (G / 8) + bid / 8 : bid;
    const int gw = vcu * 8 + wave, NGW = G * 8;
    unsigned char* ws = a.ws;
    LAS unsigned char* ldsl = (LAS unsigned char*)lds;
    LAS float* scr = (LAS float*)(ldsl + wave * 16384);
    float* mod = (float*)(ws + WS_MOD); float* CX = (float*)(ws + WS_CX);
    bf16_t* H = (bf16_t*)(ws + WS_H); bf16_t* Z = (bf16_t*)(ws + WS_Z); bf16_t* QC = (bf16_t*)(ws + WS_H); bf16_t* KVC = (bf16_t*)(ws + WS_KVC);
    bf16_t* Y = (bf16_t*)(ws + WS_KVC); bf16_t* O = (bf16_t*)(ws + WS_O); bf16_t* T = (bf16_t*)(ws + WS_T); bf16_t* U = (bf16_t*)(ws + WS_U); float* TP = (float*)(ws + WS_TP);

    unsigned* barw = (unsigned*)(ws + WS_BAR);
    volatile LAS unsigned* bst = (volatile LAS unsigned*)(ldsl + 131072 + 64);
    if (bid == 0) for (int i = tid; i < XCD_BAR_WORDS; i += 512) barw[i] = 0u;
    if (tid < 2) bst[tid] = 0u;
    __syncthreads();
    mod_phase(a, lds, bid, G, tid);
    convert_weights(a, 0, gw, NGW, lane, scr);
    grid.sync();
    const XcdBarrier xb = xcd_barrier_post(barw, bst);
#define GSYNC() xcd_barrier(xb)
    row_phase<false, true>(bid, G, MTOT, a.in[I_X], a.in[I_CTX], nullptr, nullptr, nullptr, nullptr, nullptr, 0, nullptr, a.in[I_GPRE1], mod, 0, 2048, H, ws + WS_H8, lds);
    GSYNC();
    for (int l = 0; l < 2; ++l) {
        const bool ctx_out = (l == 0);
        const int nMr = ctx_out ? MTOT / 256 : NLAT / 256;
        const float* modL = mod + (size_t)l * 9 * MODW;
        { pg8::TileSched S; S.nM = ctx_out ? MTOT / 256 : NLAT / 256; S.nN = 23; S.nwg = S.nM * S.nN; S.G = G; S.c = bid; S.nsub = 1; S.A = (const char*)H; S.B = (const char*)(ws + WS_WIN);
          S.aT = (size_t)256 * DM * 2; S.bT = (size_t)256 * DM * 2; S.aS = 0; S.bS = 0; S.nx = ctx_out ? 0 : 104;
          S.pn_split = 16; S.pn_skip = 24; S.pn_boff = 0;
          pg8::EpiZ E{Z}; pg8::gemm_phase(ldsl, DM, DM, DM, S, E); }
        { pg8::TileSched S; S.nM = ctx_out ? MTOT / 256 : NLAT / 256; S.nN = 24; S.nwg = S.nM * S.nN; S.G = G; S.c = bid; S.nsub = 1; S.A = (const char*)(ws + WS_H8); S.B = (const char*)(ws + WS_WG8);
          S.aT = (size_t)256 * DM; S.bT = (size_t)256 * DM; S.aS = 0; S.bS = 0; S.nx = 0; S.pn_split = 0; S.pn_skip = 16; S.pn_boff = 16;
          pg8::EpiZ8 E{Z}; pg8::gemm_phase<true>(ldsl, DM / 2, DM / 2, DM / 2, S, E); }
        GSYNC();
        prep_phase(a, l, gw, NGW, lane);
        GSYNC();
        { pg8::DualSched S; S.G = G; S.c = bid; S.n0 = (MTOT / 256) * 6; S.n1 = (MTOT / 256) * 8; S.nN0 = 6; S.nN1 = 8;
          S.A0 = (const char*)(Z + ZC_CQ); S.A1 = (const char*)(Z + ZC_CKV); S.B0 = (const char*)(ws + WS_WUQ); S.B1 = (const char*)(ws + WS_WUKV);
          S.aT = (size_t)256 * LDZ * 2; S.bT = (size_t)256 * 512 * 2;
          pg8::EpiQKV E{QC, KVC, LDQC, LDKVC}; pg8::gemm_phase(ldsl, LDZ, 512, 512, S, E); }
        GSYNC();
        attn_phase(a, l, ctx_out, vcu, G, (char*)lds);
        GSYNC();
        { pg8::TileSched S; S.nM = nMr; S.nN = 8; S.nwg = S.nM * S.nN; S.G = G; S.c = bid; S.nsub = 3; S.A = (const char*)O; S.B = (const char*)(ws + WS_WBR);
          S.aT = (size_t)256 * LDO * 2; S.bT = (size_t)256 * 1024 * 2; S.aS = (size_t)1024 * 2; S.bS = (size_t)2048 * 1024 * 2; S.nx = 0; S.pn_split = 1 << 30; S.pn_skip = 0; S.pn_boff = 0;
          pg8::EpiMerge E{Y, Z}; pg8::gemm_phase(ldsl, LDO, 1024, 1024, S, E); }
        GSYNC();
        { pg8::TileSched S; S.nM = NLAT / 256; S.nN = 8; S.nwg = S.nM * S.nN; S.G = G; S.c = bid; S.nsub = 1; S.A = (const char*)Y; S.B = (const char*)(ws + WS_WO);
          S.aT = (size_t)256 * DM * 2; S.bT = (size_t)256 * DM * 2; S.aS = 0; S.bS = 0; S.nx = 0; S.pn_split = 1 << 30; S.pn_skip = 0; S.pn_boff = 0;
          pg8::EpiQKV E{T, T, DM, DM}; pg8::gemm_phase(ldsl, DM, DM, DM, S, E); }
        if (ctx_out) { pg8::CtxSplitSched S; S.G = G; S.c = bid; S.A = (const char*)Y; S.B = (const char*)(ws + WS_WO); S.aT = (size_t)256 * DM * 2; S.bT = (size_t)256 * DM * 2; S.kqB = (size_t)(DM / 4) * 2;
          pg8::EpiSlab E{TP}; pg8::gemm_phase(ldsl, DM, DM, DM / 4, S, E); }
        GSYNC();
        row_phase<true, true>(bid, G, ctx_out ? MTOT : NLAT, l == 0 ? a.in[I_X] : a.out, a.in[I_CTX], a.out, CX, T, ctx_out ? TP : nullptr, modL, 4096, a.in[I_GPOST1] + l * DM,
                              a.in[I_GPRE2] + l * DM, modL, 6144, 8192, H, nullptr, lds);
        GSYNC();
        { pg8::TileSched S; S.nM = nMr; S.nN = 2 * DFF / 256; S.nwg = S.nM * S.nN; S.G = G; S.c = bid; S.nsub = 1; S.A = (const char*)H; S.B = (const char*)(ws + WS_W13);
          S.aT = (size_t)256 * DM * 2; S.bT = (size_t)256 * DM * 2; S.aS = 0; S.bS = 0; S.nx = 0; S.pn_split = 1 << 30; S.pn_skip = 0; S.pn_boff = 0;
          pg8::EpiSwiglu E{U}; pg8::gemm_phase(ldsl, DM, DM, DM, S, E); }
        GSYNC();
        { pg8::TileSched S; S.nM = NLAT / 256; S.nN = 8; S.nwg = S.nM * S.nN; S.G = G; S.c = bid; S.nsub = 1; S.A = (const char*)U; S.B = (const char*)(ws + WS_W2);
          S.aT = (size_t)256 * DFF * 2; S.bT = (size_t)256 * DFF * 2; S.aS = 0; S.bS = 0; S.nx = 0; S.pn_split = 1 << 30; S.pn_skip = 0; S.pn_boff = 0;
          pg8::EpiQKV E{T, T, DM, DM}; pg8::gemm_phase(ldsl, DFF, DFF, DFF, S, E); }
        if (ctx_out) { pg8::CtxSplitSched S; S.G = G; S.c = bid; S.A = (const char*)U; S.B = (const char*)(ws + WS_W2); S.aT = (size_t)256 * DFF * 2; S.bT = (size_t)256 * DFF * 2; S.kqB = (size_t)(DFF / 4) * 2;
          pg8::EpiSlab E{TP}; pg8::gemm_phase(ldsl, DFF, DFF, DFF / 4, S, E); }
        GSYNC();
        if (l == 0) {
            row_phase<true, true>(bid, G, MTOT, a.out, CX, a.out, CX, T, TP, modL, 10240, a.in[I_GPOST2], a.in[I_GPRE1] + DM, mod + (size_t)9 * MODW, 0, 2048, H, ws + WS_H8, lds);
            convert_weights(a, 1, gw, NGW, lane, scr);
            GSYNC();
        } else {
            row_phase<true, false>(bid, G, NLAT, a.out, nullptr, a.out, nullptr, T, nullptr, modL, 10240, a.in[I_GPOST2] + DM, nullptr, nullptr, 0, 0, nullptr, nullptr, lds);
        }
    }
}

extern "C" void kernel_launch(void* const* d_in, const int* in_sizes, int n_in, void* d_out, int out_size, void* d_ws, size_t ws_size, hipStream_t stream) {
    static int grid = 0;
    if (grid == 0) {
        if (n_in != 25 || out_size != NLAT * DM || ws_size < WS_END) { fprintf(stderr, "kernel_launch: unexpected shapes: n_in %d out %d ws %zu (need %zu)\n", n_in, out_size, ws_size, (size_t)WS_END); grid = -1; return; }
        int dev = 0, cus = 0, per_cu = 0;
        if (hipGetDevice(&dev) != hipSuccess || hipDeviceGetAttribute(&cus, hipDeviceAttributeMultiprocessorCount, dev) != hipSuccess) { grid = -1; return; }
        if (hipFuncSetAttribute((const void*)fwd_megakernel, hipFuncAttributeMaxDynamicSharedMemorySize, LDS_BYTES) != hipSuccess) { fprintf(stderr, "kernel_launch: hipFuncSetAttribute failed\n"); grid = -1; return; }
        if (hipOccupancyMaxActiveBlocksPerMultiprocessor(&per_cu, (const void*)fwd_megakernel, 512, LDS_BYTES) != hipSuccess || per_cu < 1) { fprintf(stderr, "kernel_launch: occupancy query says %d\n", per_cu); per_cu = 1; }
        (void)hipGetLastError();
        grid = cus * 1;
    }
    if (grid < 0) return;
    Args a{};
    for (int i = 0; i < 25; ++i) a.in[i] = (const float*)d_in[i];
    a.out = (float*)d_out; a.ws = (unsigned char*)d_ws;
    void* args[] = {&a};
    hipError_t e = hipLaunchCooperativeKernel((const void*)fwd_megakernel, dim3(grid), dim3(512), args, LDS_BYTES, stream);
    if (e != hipSuccess) fprintf(stderr, "kernel_launch: cooperative launch failed: %s (grid %d)\n", hipGetErrorString(e), grid);
}
```

```cpp
#include <hip/hip_runtime.h>
#include <hip/hip_cooperative_groups.h>
#include <cstdio>
#include <cstdint>
namespace cg = cooperative_groups;

constexpr int DM = 2048, NB = 8, SEQ = 2048, CTXL = 256, NLAT = NB * SEQ, NCTX = NB * CTXL, MTOT = NLAT + NCTX;
constexpr int INW = 11840, LDZ = 11840, NZP = 12032, DFF = 5632, LDO = 3072, LDQC = 1536, LDKVC = 2112;
constexpr int MODW = 6 * DM;
constexpr float EPS = 1e-6f;
constexpr int ZC_AQ = 0, ZC_AK = 1024, ZC_AV = 2048, ZC_BQ = 3072, ZC_GA = 4096, ZC_BK = 10240, ZC_BV = 10496, ZC_CQ = 10752, ZC_CKV = 11264, ZC_CKR = 11776;
constexpr size_t WS_MOD = 0;
constexpr size_t WS_BAR = 901120;
constexpr size_t WS_CX = 1u << 20;
constexpr size_t WS_WIN = WS_CX + (size_t)NCTX * DM * 4;
constexpr size_t WS_WUQ = WS_WIN + (size_t)NZP * DM * 2;
constexpr size_t WS_WUKV = WS_WUQ + (size_t)1536 * 512 * 2;
constexpr size_t WS_WBR = WS_WUKV + (size_t)2048 * 512 * 2;
constexpr size_t WS_WO = WS_WBR + (size_t)3 * 2048 * 1024 * 2;
constexpr size_t WS_W13 = WS_WO + (size_t)2048 * 2048 * 2;
constexpr size_t WS_W2 = WS_W13 + (size_t)2 * DFF * DM * 2;
constexpr size_t WS_H = WS_W2 + (size_t)DM * DFF * 2;
constexpr size_t WS_Z = WS_H + (size_t)MTOT * DM * 2;
constexpr size_t WS_T = WS_Z;
constexpr size_t WS_U = WS_Z + (size_t)MTOT * DM * 4;
constexpr size_t WS_TP = WS_U + (size_t)MTOT * DFF * 2;
constexpr size_t WS_KVC = WS_Z + (size_t)MTOT * LDZ * 2;
constexpr size_t WS_O = WS_KVC + (size_t)MTOT * LDKVC * 2;
constexpr size_t WS_H8 = WS_O + (size_t)MTOT * LDO * 2;
constexpr size_t WS_WG8 = WS_H8 + (size_t)MTOT * DM;
constexpr size_t WS_END = WS_WG8 + (size_t)6144 * DM;
static_assert(WS_END <= 921975872ull, "workspace budget (sum of the inputs)");
static_assert(WS_TP + (size_t)4 * NCTX * DM * 4 <= WS_KVC, "overlay");
constexpr int LDS_BYTES = 147456;

typedef unsigned short bf16_t;
typedef short bf16x8 __attribute__((ext_vector_type(8)));
typedef short s16x4 __attribute__((ext_vector_type(4)));
typedef float f32x4 __attribute__((ext_vector_type(4)));
typedef float f32x16 __attribute__((ext_vector_type(16)));
typedef unsigned u32x4 __attribute__((ext_vector_type(4)));
typedef unsigned u32x2 __attribute__((ext_vector_type(2)));
typedef int i32x8 __attribute__((ext_vector_type(8)));
typedef int i32x4 __attribute__((ext_vector_type(4)));
#define LAS __attribute__((address_space(3)))

__device__ __forceinline__ int opaque_tid() { int t = threadIdx.x; asm volatile("" : "+v"(t)); return t; }
__device__ __forceinline__ unsigned cvtpk(float lo, float hi) { unsigned r; asm volatile("v_cvt_pk_bf16_f32 %0, %1, %2" : "=v"(r) : "v"(lo), "v"(hi)); return r; }
__device__ __forceinline__ float bf2f(unsigned short s) { return __uint_as_float(((unsigned)s) << 16); }
__device__ __forceinline__ float bflo(unsigned w) { return __uint_as_float(w << 16); }
__device__ __forceinline__ float bfhi(unsigned w) { return __uint_as_float(w & 0xffff0000u); }
__device__ __forceinline__ float wave_sum(float v) {
#pragma unroll
    for (int o = 1; o < 64; o <<= 1) v += __shfl_xor(v, o);
    return v;
}
__device__ __forceinline__ float sigmoidf_(float x) { return __builtin_amdgcn_rcpf(1.f + __builtin_amdgcn_exp2f(-1.4426950408889634f * x)); }

namespace pg8 {
constexpr int BM = 256, BK = 64, HALF = 128, HTB = HALF * BK * 2, STAGE_BYTES = 8 * HTB, NXCD = 8, WGM = 8;
__device__ __forceinline__ int lds_byte(int r, int c) { const int st = (r >> 4) * 2 + (c >> 5), rr = r & 15, cc = c & 31, ob = rr * 64 + cc * 2; return st * 1024 + (ob ^ (((ob >> 9) & 1) << 5)); }
__device__ __forceinline__ void stage_rc(int b, int& R, int& C) { const int st = b / 1024, sb = b % 1024, swz = sb ^ (((sb >> 9) & 1) << 5); R = (st >> 1) * 16 + swz / 64; C = (st & 1) * 32 + (swz % 64) / 2; }
__device__ __forceinline__ int perm32(int rho) { const int n = rho >> 4, i = rho & 15; return 8 * (i >> 2) + 4 * n + (i & 3); }
struct Unit { int pm, pn, sub; };

struct TileSched {
    int nM, nN, nwg, G, c, nsub; const char* A; const char* B; size_t aT, bT, aS, bS;
    int pn_split, pn_skip, pn_boff;
    int nx;
    __device__ __forceinline__ bool next(int i, Unit& u) const {
        const int ti = i / nsub; u.sub = i - ti * nsub;
        const long L = (long)ti * G + c;
        if (L >= nwg) { const int k = (int)(L - nwg); if (k >= nx) return false; const int t = k / 13, idx = k - t * 13; u.pm = 64 + t;
            u.pn = idx < 8 ? 4 + idx : (idx < 10 ? 32 + idx : (idx < 12 ? 34 + idx : 46)); return true; }
        int wgid = (int)L; { const int q = nwg / NXCD, r = nwg % NXCD, xcd = wgid % NXCD, off = wgid / NXCD; wgid = (xcd < r ? xcd * (q + 1) : r * (q + 1) + (xcd - r) * q) + off; }
        const int nig = WGM * nN, gid = wgid / nig, fm = gid * WGM, gsz = (nM - fm) < WGM ? (nM - fm) : WGM;
        u.pm = fm + ((wgid % nig) % gsz); const int idx = (wgid % nig) / gsz; u.pn = idx < pn_split ? idx : idx + pn_skip; return true;
    }
    __device__ __forceinline__ const char* ptrA(const Unit& u) const { return A + (size_t)u.pm * aT + (size_t)u.sub * aS; }
    __device__ __forceinline__ const char* ptrB(const Unit& u) const { return B + (size_t)(u.pn - pn_boff) * bT + (size_t)u.sub * bS; }
};
struct DualSched {
    int G, c, n0, n1, nN0, nN1; const char *A0, *A1, *B0, *B1; size_t aT, bT;
    __device__ __forceinline__ bool next(int i, Unit& u) const {
        int L = i * G + c;
        if (L < n0) { u.sub = 0; u.pm = L / nN0; u.pn = L - u.pm * nN0; return true; }
        L -= n0; if (L >= n1) return false;
        u.sub = 1; u.pm = L / nN1; u.pn = L - u.pm * nN1; return true;
    }
    __device__ __forceinline__ const char* ptrA(const Unit& u) const { return (u.sub ? A1 : A0) + (size_t)u.pm * aT; }
    __device__ __forceinline__ const char* ptrB(const Unit& u) const { return (u.sub ? B1 : B0) + (size_t)u.pn * bT; }
};

struct EpiZ {
    static constexpr bool PERM = true;
    bf16_t* Z;
    __device__ __forceinline__ void operator()(const f32x4 (&acc)[2][2][4][2], const Unit& u, int wr, int wc, int fr, int fq) const {
        const int row0 = u.pm * BM + wr * 64 + fr, col0 = u.pn * BM + wc * 32 + 8 * fq;
#pragma unroll
        for (int ai = 0; ai < 2; ++ai)
#pragma unroll
            for (int m = 0; m < 4; ++m) { bf16_t* rowp = Z + (size_t)(row0 + ai * HALF + m * 16) * LDZ + col0;
#pragma unroll
                for (int bj = 0; bj < 2; ++bj) { const f32x4 v0 = acc[ai][bj][m][0], v1 = acc[ai][bj][m][1];
                    u32x4 w; w.x = cvtpk(v0[0], v0[1]); w.y = cvtpk(v0[2], v0[3]); w.z = cvtpk(v1[0], v1[1]); w.w = cvtpk(v1[2], v1[3]);
                    if (col0 + bj * HALF < LDZ) *(u32x4*)(rowp + bj * HALF) = w; } }
    }
};
struct EpiZ8 {
    static constexpr bool PERM = false, ALIGN = true;
    bf16_t* Z;
    __device__ __forceinline__ void operator()(const f32x4 (&acc)[2][2][4][2], const Unit& u, int wr, int wc, int fr, int fq) const {
        const int row0 = u.pm * BM + wr * 64 + fr, col0 = u.pn * BM + wc * 32 + 4 * fq;
#pragma unroll
        for (int ai = 0; ai < 2; ++ai)
#pragma unroll
            for (int m = 0; m < 4; ++m) { bf16_t* rowp = Z + (size_t)(row0 + ai * HALF + m * 16) * LDZ + col0;
#pragma unroll
                for (int bj = 0; bj < 2; ++bj)
#pragma unroll
                    for (int n = 0; n < 2; ++n) { const f32x4 v = acc[ai][bj][m][n]; u32x2 w; w.x = cvtpk(v[0], v[1]); w.y = cvtpk(v[2], v[3]); *(u32x2*)(rowp + bj * HALF + n * 16) = w; } }
    }
};
struct EpiQKV {
    static constexpr bool PERM = true;
    bf16_t* O0; bf16_t* O1; int ld0, ld1;
    __device__ __forceinline__ void operator()(const f32x4 (&acc)[2][2][4][2], const Unit& u, int wr, int wc, int fr, int fq) const {
        bf16_t* O = u.sub ? O1 : O0; const int ldc = u.sub ? ld1 : ld0;
        const int row0 = u.pm * BM + wr * 64 + fr, col0 = u.pn * BM + wc * 32 + 8 * fq;
#pragma unroll
        for (int ai = 0; ai < 2; ++ai)
#pragma unroll
            for (int m = 0; m < 4; ++m) { bf16_t* rowp = O + (size_t)(row0 + ai * HALF + m * 16) * ldc + col0;
#pragma unroll
                for (int bj = 0; bj < 2; ++bj) { const f32x4 v0 = acc[ai][bj][m][0], v1 = acc[ai][bj][m][1];
                    u32x4 w; w.x = cvtpk(v0[0], v0[1]); w.y = cvtpk(v0[2], v0[3]); w.z = cvtpk(v1[0], v1[1]); w.w = cvtpk(v1[2], v1[3]);
                    *(u32x4*)(rowp + bj * HALF) = w; } }
    }
};
struct EpiMerge {
    static constexpr bool PERM = true;
    bf16_t* Y; const bf16_t* Z;
    __device__ __forceinline__ void operator()(const f32x4 (&acc)[2][2][4][2], const Unit& u, int wr, int wc, int fr, int fq) const {
        const int row0 = u.pm * BM + wr * 64 + fr, col0 = u.pn * BM + wc * 32 + 8 * fq;
        const bool rmw = (u.sub > 0);
#pragma unroll
        for (int ai = 0; ai < 2; ++ai) {
            u32x4 g[4][2], pv[4][2];
#pragma unroll
            for (int m = 0; m < 4; ++m) { const size_t row = (size_t)(row0 + ai * HALF + m * 16);
#pragma unroll
                for (int bj = 0; bj < 2; ++bj) { g[m][bj] = *(const u32x4*)(Z + row * LDZ + ZC_GA + 2048 * u.sub + col0 + bj * HALF);
                    pv[m][bj] = rmw ? *(const u32x4*)(Y + row * DM + col0 + bj * HALF) : (u32x4){0u, 0u, 0u, 0u}; } }
            asm volatile("" ::: "memory");
#pragma unroll
            for (int m = 0; m < 4; ++m) { bf16_t* yp = Y + (size_t)(row0 + ai * HALF + m * 16) * DM + col0;
#pragma unroll
                for (int bj = 0; bj < 2; ++bj) { const f32x4 a0 = acc[ai][bj][m][0], a1 = acc[ai][bj][m][1]; const u32x4 gg = g[m][bj], p = pv[m][bj];
                    float v[8] = { a0[0] * sigmoidf_(bflo(gg.x)), a0[1] * sigmoidf_(bfhi(gg.x)), a0[2] * sigmoidf_(bflo(gg.y)), a0[3] * sigmoidf_(bfhi(gg.y)), a1[0] * sigmoidf_(bflo(gg.z)), a1[1] * sigmoidf_(bfhi(gg.z)), a1[2] * sigmoidf_(bflo(gg.w)), a1[3] * sigmoidf_(bfhi(gg.w)) };
                    v[0] += bflo(p.x); v[1] += bfhi(p.x); v[2] += bflo(p.y); v[3] += bfhi(p.y); v[4] += bflo(p.z); v[5] += bfhi(p.z); v[6] += bflo(p.w); v[7] += bfhi(p.w);
                    u32x4 w; w.x = cvtpk(v[0], v[1]); w.y = cvtpk(v[2], v[3]); w.z = cvtpk(v[4], v[5]); w.w = cvtpk(v[6], v[7]);
                    *(u32x4*)(yp + bj * HALF) = w; } }
        }
    }
};
struct EpiSwiglu {
    static constexpr bool PERM = false;
    bf16_t* U;
    __device__ __forceinline__ void operator()(const f32x4 (&acc)[2][2][4][2], const Unit& u, int wr, int wc, int fr, int fq) const {
        const int row0 = u.pm * BM + wr * 64 + fr, col0 = u.pn * 128 + wc * 16 + 4 * fq;
#pragma unroll
        for (int ai = 0; ai < 2; ++ai)
#pragma unroll
            for (int m = 0; m < 4; ++m) { bf16_t* rowp = U + (size_t)(row0 + ai * HALF + m * 16) * DFF + col0;
#pragma unroll
                for (int bj = 0; bj < 2; ++bj) { const f32x4 a = acc[ai][bj][m][0], g = acc[ai][bj][m][1]; float o[4];
#pragma unroll
                    for (int j = 0; j < 4; ++j) o[j] = a[j] * sigmoidf_(a[j]) * g[j];
                    u32x2 w; w.x = cvtpk(o[0], o[1]); w.y = cvtpk(o[2], o[3]);
                    *(u32x2*)(rowp + bj * 64) = w; } }
    }
};

struct CtxSplitSched {
    int G, c; const char* A; const char* B; size_t aT, bT, kqB;
    __device__ __forceinline__ bool next(int i, Unit& u) const { const int L = i * G + c; if (L >= 256) return false; u.sub = L & 3; const int t = L >> 2; u.pm = 64 + (t >> 3); u.pn = t & 7; return true; }
    __device__ __forceinline__ const char* ptrA(const Unit& u) const { return A + (size_t)u.pm * aT + (size_t)u.sub * kqB; }
    __device__ __forceinline__ const char* ptrB(const Unit& u) const { return B + (size_t)u.pn * bT + (size_t)u.sub * kqB; }
};
struct EpiSlab {
    static constexpr bool PERM = false;
    float* C;
    __device__ __forceinline__ void operator()(const f32x4 (&acc)[2][2][4][2], const Unit& u, int wr, int wc, int fr, int fq) const {
        const int row0 = (u.pm - 64) * BM + wr * 64 + fr, col0 = u.pn * BM + wc * 32 + 4 * fq;
        float* Cs = C + (size_t)u.sub * NCTX * DM;
#pragma unroll
        for (int ai = 0; ai < 2; ++ai)
#pragma unroll
            for (int m = 0; m < 4; ++m) { float* rowp = Cs + (size_t)(row0 + ai * HALF + m * 16) * DM + col0;
#pragma unroll
                for (int bj = 0; bj < 2; ++bj)
#pragma unroll
                    for (int n = 0; n < 2; ++n) *(f32x4*)(rowp + bj * HALF + n * 16) = acc[ai][bj][m][n]; }
    }
};

template <bool F8 = false, class Epi, class Sched>
__device__ __forceinline__ void gemm_phase(LAS unsigned char* lds, const int lda, const int ldb, const int K, const Sched& S, const Epi& E) {
    const int tid = opaque_tid(), wid = __builtin_amdgcn_readfirstlane(tid >> 6), lane = tid & 63, wr = wid >> 2, wc = wid & 3, fr = lane & 15, fq = lane >> 4;
    const int nt = K / BK;
    unsigned voffA[2], voffB[2];
#pragma unroll
    for (int i = 0; i < 2; ++i) { int R, C; stage_rc(tid * 16 + i * 8192, R, C); const int Rb = Epi::PERM ? ((R & ~31) + perm32(R & 31)) : R;
        voffA[i] = (unsigned)(R * lda + C) * 2u; voffB[i] = (unsigned)(Rb * ldb + C) * 2u; }
    const size_t kstep = (size_t)(BK * 2);
    const size_t hstepA = (size_t)HALF * lda * 2, hstepB = (size_t)HALF * ldb * 2;
    const unsigned ldsw = (unsigned)wid * 1024u;
    const int aoff = lds_byte(wr * 64 + fr, fq * 8), boff = lds_byte(wc * 32 + fr, fq * 8);
#define PG8_SA(b, h) (((b) * 2 + (h)) * HTB)
#define PG8_SB(b, h) ((4 + (b) * 2 + (h)) * HTB)
#define PG8_STAGE(bufoff, gbase, voff) do { _Pragma("unroll") for (int _i = 0; _i < 2; ++_i) \
        __builtin_amdgcn_global_load_lds((const unsigned*)((const char*)(gbase) + (voff)[_i]), (LAS unsigned*)(lds + (bufoff) + ldsw + _i * 8192), 16, 0, 0); } while (0)
#define PG8_LDA(dst, b, h) do { if constexpr (F8) { _Pragma("unroll") for (int m = 0; m < 4; ++m) { const i32x4 _l = *(const LAS i32x4*)(lds + PG8_SA(b, h) + aoff + m * 2048), _u = *(const LAS i32x4*)(lds + PG8_SA(b, h) + aoff + m * 2048 + 1024); \
          dst##8[m] = __builtin_shufflevector(_l, _u, 0, 1, 2, 3, 4, 5, 6, 7); } } \
        else { _Pragma("unroll") for (int m = 0; m < 4; ++m) _Pragma("unroll") for (int k = 0; k < 2; ++k) dst[m][k] = *(const LAS bf16x8*)(lds + PG8_SA(b, h) + aoff + m * 2048 + k * 1024); } } while (0)
#define PG8_LDB(dst, b, h) do { if constexpr (F8) { _Pragma("unroll") for (int n = 0; n < 2; ++n) { const i32x4 _l = *(const LAS i32x4*)(lds + PG8_SB(b, h) + boff + n * 2048), _u = *(const LAS i32x4*)(lds + PG8_SB(b, h) + boff + n * 2048 + 1024); \
          dst##8[n] = __builtin_shufflevector(_l, _u, 0, 1, 2, 3, 4, 5, 6, 7); } } \
        else { _Pragma("unroll") for (int n = 0; n < 2; ++n) _Pragma("unroll") for (int k = 0; k < 2; ++k) dst[n][k] = *(const LAS bf16x8*)(lds + PG8_SB(b, h) + boff + n * 2048 + k * 1024); } } while (0)
#define PG8_MMA(ai, bj, At, Bt) do { __builtin_amdgcn_s_setprio(1); _Pragma("unroll") for (int m = 0; m < 4; ++m) _Pragma("unroll") for (int n = 0; n < 2; ++n) { \
        if constexpr (F8)   \
            asm volatile("v_mfma_scale_f32_16x16x128_f8f6f4 %0, %1, %2, %0, %3, %4 op_sel_hi:[0,0,0]" : "+v"(acc[ai][bj][m][n]) : "v"(Bt##8[n]), "v"(At##8[m]), "v"(f8s), "v"(f8s)); \
        else { _Pragma("unroll") for (int k = 0; k < 2; ++k) acc[ai][bj][m][n] = __builtin_amdgcn_mfma_f32_16x16x32_bf16(Bt[n][k], At[m][k], acc[ai][bj][m][n], 0, 0, 0); } } \
        __builtin_amdgcn_s_setprio(0); } while (0)
#define PG8_WAIT_V(n) asm volatile("s_waitcnt vmcnt(" #n ")" ::: "memory")
#define PG8_WAIT_L(n) asm volatile("s_waitcnt lgkmcnt(" #n ")" ::: "memory")
#define PG8_BAR __builtin_amdgcn_s_barrier()
#define PG8_SCHED __builtin_amdgcn_sched_barrier(0)
    Unit cur, nxt; int ui = 0;
    if (!S.next(0, cur)) return;
    f32x4 acc[2][2][4][2];
#pragma unroll
    for (int a = 0; a < 2; ++a)
#pragma unroll
        for (int b = 0; b < 2; ++b)
#pragma unroll
            for (int m = 0; m < 4; ++m)
#pragma unroll
                for (int n = 0; n < 2; ++n) acc[a][b][m][n] = (f32x4){0.f, 0.f, 0.f, 0.f};
    bf16x8 At[4][2], B0[2][2], B1[2][2];
    i32x8 At8[4], B08[2], B18[2];
    const int f8s = 0x7C7C7C7C;
    const char* cA = S.ptrA(cur); const char* cB = S.ptrB(cur);
    PG8_STAGE(PG8_SB(0, 0), cB, voffB); PG8_STAGE(PG8_SB(0, 1), cB + hstepB, voffB); PG8_STAGE(PG8_SA(0, 0), cA, voffA); PG8_STAGE(PG8_SA(0, 1), cA + hstepA, voffA);
    if (wr == 1) PG8_BAR;
    PG8_WAIT_V(2); PG8_BAR;
    PG8_STAGE(PG8_SB(1, 0), cB + kstep, voffB); PG8_STAGE(PG8_SA(1, 0), cA + kstep, voffA); PG8_STAGE(PG8_SB(1, 1), cB + hstepB + kstep, voffB);
    PG8_WAIT_V(6); PG8_BAR;
    for (;;) {
        const bool has_next = S.next(ui + 1, nxt);
        const char* nA = has_next ? S.ptrA(nxt) : cA; const char* nB = has_next ? S.ptrB(nxt) : cB;
        for (int t = 0; t < nt; t += 2) {
            const bool last = (t == nt - 2);
            const char* a1 = cA + (size_t)(t + 1) * kstep;
            const char* a2 = last ? nA : cA + (size_t)(t + 2) * kstep; const char* b2 = last ? nB : cB + (size_t)(t + 2) * kstep;
            const char* a3 = a2 + kstep; const char* b3 = b2 + kstep;
            PG8_LDB(B0, 0, 0); PG8_LDB(B1, 0, 1); PG8_SCHED; PG8_LDA(At, 0, 0); PG8_STAGE(PG8_SA(1, 1), a1 + hstepA, voffA);
            PG8_WAIT_V(8); PG8_WAIT_L(0); PG8_BAR; PG8_MMA(0, 0, At, B0); PG8_MMA(0, 1, At, B1); PG8_BAR; PG8_SCHED;
            PG8_LDA(At, 0, 1); PG8_STAGE(PG8_SB(0, 0), b2, voffB); PG8_STAGE(PG8_SB(0, 1), b2 + hstepB, voffB); PG8_STAGE(PG8_SA(0, 0), a2, voffA);
            PG8_WAIT_V(8); PG8_WAIT_L(0); PG8_BAR; PG8_MMA(1, 0, At, B0); PG8_MMA(1, 1, At, B1); PG8_BAR; PG8_SCHED;
            PG8_LDB(B0, 1, 0); PG8_LDB(B1, 1, 1); PG8_SCHED; PG8_LDA(At, 1, 0); PG8_STAGE(PG8_SA(0, 1), a2 + hstepA, voffA);
            PG8_WAIT_V(8); PG8_WAIT_L(0); PG8_BAR; PG8_MMA(0, 0, At, B0); PG8_MMA(0, 1, At, B1); PG8_BAR; PG8_SCHED;
            PG8_LDA(At, 1, 1); PG8_STAGE(PG8_SB(1, 0), b3, voffB); PG8_STAGE(PG8_SB(1, 1), b3 + hstepB, voffB); PG8_STAGE(PG8_SA(1, 0), a3, voffA);
            PG8_WAIT_V(8); PG8_WAIT_L(0); PG8_BAR; PG8_MMA(1, 0, At, B0); PG8_MMA(1, 1, At, B1); PG8_BAR; PG8_SCHED;
        }
        if (wr == 0) PG8_BAR;
        E(acc, cur, wr, wc, fr, fq);
        if (!has_next) break;
#pragma unroll
        for (int a = 0; a < 2; ++a)
#pragma unroll
            for (int b = 0; b < 2; ++b)
#pragma unroll
                for (int m = 0; m < 4; ++m)
#pragma unroll
                    for (int n = 0; n < 2; ++n) acc[a][b][m][n] = (f32x4){0.f, 0.f, 0.f, 0.f};
        cur = nxt; cA = nA; cB = nB; ++ui;
        if (wr == 1) PG8_BAR;
    }
    PG8_WAIT_V(0);
    PG8_BAR;
#undef PG8_SA
#undef PG8_SB
#undef PG8_STAGE
#undef PG8_LDA
#undef PG8_LDB
#undef PG8_MMA
#undef PG8_WAIT_V
#undef PG8_WAIT_L
#undef PG8_BAR
#undef PG8_SCHED
}
}

namespace att {
constexpr int SHM_V = 64 * 128 * 2;
constexpr int SHM_K = 64 * 192 * 2;
constexpr int OFF_K = 2 * SHM_V, OFF_WS = OFF_K + 2 * SHM_K, OFF_RPB = OFF_WS + 8 * 64 * 4, ATT_LDS = OFF_RPB + 2048;
constexpr float THR = 8.f;
__device__ __forceinline__ int crow(int r, int hi) { return (r & 3) + 8 * (r >> 2) + 4 * hi; }
__device__ __forceinline__ int v_st(int k, int c) { const int kk = (k & ~0xC) | ((k & 4) << 1) | ((k & 8) >> 1); return ((kk >> 3) * 4 + (c >> 5)) * 512 + ((kk & 7) * 32 + (c & 31)) * 2; }
__device__ __forceinline__ int v_rd_base(int lane) { return ((lane & 3) << 3) | (((lane >> 2) & 3) << 6) | (((lane >> 4) & 1) << 5) | (((lane >> 5) & 1) << 8); }
constexpr int v_rd_off(int d0, int ks, int half) { return d0 * 512 + ks * 4096 + half * 2048; }
template <int OFF> __device__ __forceinline__ s16x4 tr_read(int vb) {
    s16x4 r; asm volatile("ds_read_b64_tr_b16 %0, %1 offset:%2" : "=&v"(r) : "v"(vb), "i"(OFF) : "memory"); return r;
}
template <int D0> __device__ __forceinline__ void pv_one(f32x16& od, int vb, bf16x8 pa0, bf16x8 pa1, bf16x8 pa2, bf16x8 pa3) {
    const s16x4 l0 = tr_read<v_rd_off(D0, 0, 0)>(vb), h0 = tr_read<v_rd_off(D0, 0, 1)>(vb), l1 = tr_read<v_rd_off(D0, 1, 0)>(vb), h1 = tr_read<v_rd_off(D0, 1, 1)>(vb);
    const s16x4 l2 = tr_read<v_rd_off(D0, 2, 0)>(vb), h2 = tr_read<v_rd_off(D0, 2, 1)>(vb), l3 = tr_read<v_rd_off(D0, 3, 0)>(vb), h3 = tr_read<v_rd_off(D0, 3, 1)>(vb);
    asm volatile("s_waitcnt lgkmcnt(0)" ::: "memory"); __builtin_amdgcn_sched_barrier(0);
#define PK(L, H) (bf16x8){L[0], L[1], L[2], L[3], H[0], H[1], H[2], H[3]}
    od = __builtin_amdgcn_mfma_f32_32x32x16_bf16(pa0, PK(l0, h0), od, 0, 0, 0);
    od = __builtin_amdgcn_mfma_f32_32x32x16_bf16(pa1, PK(l1, h1), od, 0, 0, 0);
    od = __builtin_amdgcn_mfma_f32_32x32x16_bf16(pa2, PK(l2, h2), od, 0, 0, 0);
    od = __builtin_amdgcn_mfma_f32_32x32x16_bf16(pa3, PK(l3, h3), od, 0, 0, 0);
#undef PK
}

struct UnitP {
    const bf16_t* Q; int ldq;
    const bf16_t* K1; int ldk1;
    const bf16_t* K2; int ldk2;
    const bf16_t* V; int ldv;
    bf16_t* O; int ldo;
    int NT, nlat, row_lat0, row_ctx0;
    float C, thr_raw;
    int rope_q, qpos0;
    int qgrow0, krow0;
};

template <int DQK, bool NA>
__device__ __forceinline__ void attn_unit(const UnitP& P, char* lds) {
    constexpr int NQ = DQK / 16, KROWB = DQK * 2;
    const int tid = opaque_tid(), wid = __builtin_amdgcn_readfirstlane(tid >> 6), lane = tid & 63, r32 = lane & 31, hi = lane >> 5;
    char* V_lds = lds; char* K_lds = lds + OFF_K;
    float* wsf = (float*)(lds + OFF_WS) + wid * 64; float* li_l = wsf; float* al_l = wsf + 32;
    const float* rpbs = (const float*)(lds + OFF_RPB);
    float m_reg = -1e30f, l_reg = 0.f; f32x16 o[4];
#pragma unroll
    for (int d = 0; d < 4; ++d)
#pragma unroll
        for (int r = 0; r < 16; ++r) o[d][r] = 0.f;
    bf16x8 qr[NQ];
    { const bf16_t* Qw = P.Q + (size_t)(wid * 32 + r32) * P.ldq + hi * 8;
#pragma unroll
      for (int d0 = 0; d0 < NQ; ++d0) qr[d0] = *reinterpret_cast<const bf16x8*>(Qw + d0 * 16); }
    if constexpr (DQK == 192) {
        if (P.rope_q) {
            const int s = P.qpos0 + wid * 32 + r32; const float prow = (float)(s >> 6), pcol = (float)(s & 63);
#pragma unroll
            for (int e = 0; e < 8; ++e) {
                const float fr_ = __builtin_amdgcn_exp2f(-(float)(hi * 8 + e) * (13.287712379549449f / 16.f));
                const float ar = prow * fr_, ac = pcol * fr_;
                const float cr = __cosf(ar), sr = __sinf(ar), cc = __cosf(ac), sc = __sinf(ac);
                const float x1 = bf2f((unsigned short)qr[8][e]), x2 = bf2f((unsigned short)qr[9][e]), y1 = bf2f((unsigned short)qr[10][e]), y2 = bf2f((unsigned short)qr[11][e]);
                const unsigned w0 = cvtpk(x1 * cr - x2 * sr, x2 * cr + x1 * sr), w1 = cvtpk(y1 * cc - y2 * sc, y2 * cc + y1 * sc);
                qr[8][e] = (short)(w0 & 0xffffu); qr[9][e] = (short)(w0 >> 16); qr[10][e] = (short)(w1 & 0xffffu); qr[11][e] = (short)(w1 >> 16);
            }
        }
    }
    const int vb0 = (int)(uintptr_t)V_lds + v_rd_base(lane);
#define KSWZ(row, colB) ((row) * KROWB + ((colB) ^ (((row) & 7) << 4)))
#define TROW(t) ((t) < P.nlat ? P.row_lat0 + 64 * (t) : P.row_ctx0 + 64 * ((t) - P.nlat))
    LAS char* ldsl = (LAS char*)lds;
    constexpr int NKI = DQK / 64;
    int voffe[2]; const bf16_t* kbase[NKI]; int kld[NKI];
#pragma unroll
    for (int j = 0; j < 2; ++j) { const int X = (wid * 2 + j) * 1024 + lane * 16, st = X >> 9, kk = ((st >> 2) << 3) | ((X >> 6) & 7), c = ((st & 3) << 5) | ((X >> 1) & 31);
        const int k = (kk & ~0xC) | ((kk & 4) << 1) | ((kk & 8) >> 1); voffe[j] = k * P.ldv + c; }
#pragma unroll
    for (int j = 0; j < NKI; ++j) { const int X = (wid * NKI + j) * 1024 + lane * 16, row = X / KROWB, cb = X - row * KROWB, colB = cb ^ ((row & 7) << 4);
        if (DQK == 192 && colB >= 256) { kbase[j] = P.K2 + (size_t)row * P.ldk2 + ((colB - 256) >> 1); kld[j] = P.ldk2; }
        else { kbase[j] = P.K1 + (size_t)row * P.ldk1 + (colB >> 1); kld[j] = P.ldk1; } }
#define DMA(t, b) do { const size_t rb = (size_t)TROW(t); \
        _Pragma("unroll") for (int _j = 0; _j < 2; ++_j) __builtin_amdgcn_global_load_lds((const unsigned*)(P.V + rb * P.ldv + voffe[_j]), (LAS unsigned*)(ldsl + (b) * SHM_V + (wid * 2 + _j) * 1024), 16, 0, 0); \
        _Pragma("unroll") for (int _j = 0; _j < NKI; ++_j) __builtin_amdgcn_global_load_lds((const unsigned*)(kbase[_j] + rb * kld[_j]), (LAS unsigned*)(ldsl + OFF_K + (b) * SHM_K + (wid * NKI + _j) * 1024), 16, 0, 0); } while (0)
    const int qgrow = P.qgrow0 + (wid >> 1), qc = (wid & 1) * 32 + r32;
    const int r0w = min(max(qgrow - 4, 0), 24), c0 = min(max(qc - 8, 0), 48);
    DMA(0, 0); asm volatile("s_waitcnt vmcnt(0)" ::: "memory"); __syncthreads();
    for (int t = 0; t < P.NT; ++t) {
        if (t + 1 < P.NT) DMA(t + 1, (t + 1) & 1);
        bool act = true;
        if constexpr (NA) act = (t >= P.nlat) || ((unsigned)(P.krow0 + t - r0w) < 8u);
        if (act) {
            const char* Kb = K_lds + (t & 1) * SHM_K;
            f32x16 p0, p1;
#pragma unroll
            for (int r = 0; r < 16; ++r) { p0[r] = 0.f; p1[r] = 0.f; }
#pragma unroll
            for (int d0 = 0; d0 < NQ; ++d0) { const int cb = (d0 * 16 + hi * 8) * 2;
                const bf16x8 b0 = *reinterpret_cast<const bf16x8*>(Kb + KSWZ(r32, cb));
                const bf16x8 b1 = *reinterpret_cast<const bf16x8*>(Kb + KSWZ(32 + r32, cb));
                p0 = __builtin_amdgcn_mfma_f32_32x32x16_bf16(b0, qr[d0], p0, 0, 0, 0);
                p1 = __builtin_amdgcn_mfma_f32_32x32x16_bf16(b1, qr[d0], p1, 0, 0, 0); }
            if constexpr (NA) {
                if (t < P.nlat) {
                    const int dr = P.krow0 + t - qgrow + 7; const float* rp = rpbs + dr * 31;
                    int qcx = qc, c0x = c0, hix = hi; asm volatile("" : "+v"(qcx), "+v"(c0x), "+v"(hix));
#pragma unroll
                    for (int r = 0; r < 16; ++r) { const int kc0 = crow(r, hix), kc1 = 32 + kc0;
                        const float b0 = rp[min(max(kc0 - qcx + 15, 0), 30)], b1 = rp[min(max(kc1 - qcx + 15, 0), 30)];
                        p0[r] = ((unsigned)(kc0 - c0x) < 16u) ? p0[r] + b0 : -1e30f;
                        p1[r] = ((unsigned)(kc1 - c0x) < 16u) ? p1[r] + b1 : -1e30f;
                        if ((r & 3) == 3) asm volatile("" ::: "memory"); }
                }
            }
            float pmax = p0[0];
#pragma unroll
            for (int r = 1; r < 16; ++r) pmax = fmaxf(pmax, p0[r]);
#pragma unroll
            for (int r = 0; r < 16; ++r) pmax = fmaxf(pmax, p1[r]);
            { auto rr = __builtin_amdgcn_permlane32_swap(__float_as_uint(pmax), __float_as_uint(pmax), false, false);
              pmax = fmaxf(__uint_as_float(rr[0]), __uint_as_float(rr[1])); }
            float mn, alpha;
            if (__all(pmax - m_reg <= P.thr_raw)) { mn = m_reg; alpha = 1.f; }
            else { mn = fmaxf(m_reg, pmax); alpha = __builtin_amdgcn_exp2f((m_reg - mn) * P.C); m_reg = mn; }
            const float mnC = -mn * P.C;
            float ps = 0.f;
#pragma unroll
            for (int r = 0; r < 16; ++r) { p0[r] = __builtin_amdgcn_exp2f(fmaf(p0[r], P.C, mnC)); p1[r] = __builtin_amdgcn_exp2f(fmaf(p1[r], P.C, mnC)); ps += p0[r] + p1[r]; }
            { auto rr = __builtin_amdgcn_permlane32_swap(__float_as_uint(ps), __float_as_uint(ps), false, false);
              ps = __uint_as_float(rr[0]) + __uint_as_float(rr[1]); }
            l_reg = l_reg * alpha + ps;
            if (__any(alpha < 1.f)) { if (hi == 0) al_l[r32] = alpha; asm volatile("s_waitcnt lgkmcnt(0)" ::: "memory");
#pragma unroll
                for (int r = 0; r < 16; ++r) { const float a = al_l[crow(r, hi)];
#pragma unroll
                    for (int d = 0; d < 4; ++d) o[d][r] *= a; } }
            bf16x8 pa0, pa1, pa2, pa3;
#define PK4(Pv, BASE, OUT) do { unsigned a0 = cvtpk(Pv[BASE + 0], Pv[BASE + 1]), a1 = cvtpk(Pv[BASE + 2], Pv[BASE + 3]);   \
    unsigned b0 = cvtpk(Pv[BASE + 4], Pv[BASE + 5]), b1 = cvtpk(Pv[BASE + 6], Pv[BASE + 7]);                              \
    auto r0 = __builtin_amdgcn_permlane32_swap(a0, b0, false, false); auto r1 = __builtin_amdgcn_permlane32_swap(a1, b1, false, false); \
    u32x4 w = {r0[0], r1[0], r0[1], r1[1]}; OUT = *reinterpret_cast<bf16x8*>(&w); } while (0)
            PK4(p0, 0, pa0); PK4(p0, 8, pa1); PK4(p1, 0, pa2); PK4(p1, 8, pa3);
#undef PK4
            const int vb = vb0 + (t & 1) * SHM_V;
            pv_one<0>(o[0], vb, pa0, pa1, pa2, pa3); pv_one<1>(o[1], vb, pa0, pa1, pa2, pa3); pv_one<2>(o[2], vb, pa0, pa1, pa2, pa3); pv_one<3>(o[3], vb, pa0, pa1, pa2, pa3);
        }
        asm volatile("s_waitcnt vmcnt(0)" ::: "memory");
        __syncthreads();
    }
    if (hi == 0) li_l[r32] = l_reg;
    asm volatile("s_waitcnt lgkmcnt(0)" ::: "memory");
    bf16_t* Ow = P.O + (size_t)(wid * 32) * P.ldo;
#pragma unroll
    for (int r = 0; r < 16; ++r) { const int orow = crow(r, hi); const float rl = __builtin_amdgcn_rcpf(li_l[orow]);
#pragma unroll
        for (int d0 = 0; d0 < 4; ++d0) Ow[(size_t)orow * P.ldo + d0 * 32 + r32] = (bf16_t)(cvtpk(o[d0][r] * rl, 0.f) & 0xffffu); }
    __syncthreads();
#undef KSWZ
#undef TROW
#undef DMA
}
}

#define XB_TMO      128
#define XB_XCNT(j)  (256  + 64 * (j))
#define XB_XSUB(j)  (1280 + 64 * (j))
#define XB_XGEN(j)  (2304 + 64 * (j))
#define XB_TOP      3328
#define XB_TOPGEN   3392
#define XCD_BAR_WORDS 3456
#define XB_SPIN_CAP (1u << 22)
__device__ __forceinline__ unsigned xb_ld(unsigned* p)              { return __hip_atomic_load(p, __ATOMIC_RELAXED, __HIP_MEMORY_SCOPE_AGENT); }
__device__ __forceinline__ unsigned xb_add(unsigned* p, unsigned v) { return __hip_atomic_fetch_add(p, v, __ATOMIC_RELAXED, __HIP_MEMORY_SCOPE_AGENT); }
__device__ __forceinline__ unsigned xb_xcc_id() { return (unsigned)__builtin_amdgcn_readfirstlane((int)((unsigned)__builtin_amdgcn_s_getreg((3 << 11) | 20) & 0xFu)); }
#define XB_SPIN(cond, bar) do { unsigned _sp = 0; while (cond) { __builtin_amdgcn_s_sleep(1); \
    if ((++_sp & 255u) == 0u) { if (xb_ld(&(bar)[XB_TMO])) break; if (_sp > XB_SPIN_CAP) { atomicAdd(&(bar)[XB_TMO], 1u); break; } } } } while (0)
struct XcdBarrier { unsigned* bar; unsigned x; volatile LAS unsigned* st; };
__device__ __forceinline__ XcdBarrier xcd_barrier_post(unsigned* bar, volatile LAS unsigned* st) {
    XcdBarrier b; b.bar = bar; b.x = 0; b.st = st;
    if (threadIdx.x == 0) (void)xb_add(&bar[XB_XCNT(xb_xcc_id())], 1u);
    return b;
}
__device__ __forceinline__ void xcd_barrier_complete(unsigned* bar, unsigned x, unsigned& nloc, unsigned& nx) {
    const unsigned G = gridDim.x * gridDim.y * gridDim.z;
    unsigned sum, cnt, mine, sp = 0u;
    for (;;) {
        sum = 0u; cnt = 0u; mine = 0u;
#pragma unroll
        for (unsigned j = 0; j < 16; ++j) { const unsigned c = xb_ld(&bar[XB_XCNT(j)]); sum += c; cnt += (c > 0u) ? 1u : 0u; mine = (j == x) ? c : mine; }
        if (sum == G) break;
        __builtin_amdgcn_s_sleep(1);
        if ((++sp & 255u) == 0u) { if (xb_ld(&bar[XB_TMO])) break; if (sp > XB_SPIN_CAP) { atomicAdd(&bar[XB_TMO], 1u); break; } }
    }
    nloc = mine > 0u ? mine : 1u; nx = cnt > 0u ? cnt : 1u;
}
__device__ __forceinline__ void xcd_barrier(const XcdBarrier& b) {
    asm volatile("s_waitcnt vmcnt(0)" ::: "memory");
    __syncthreads();
    if (threadIdx.x == 0) {
        unsigned* bar = b.bar; const unsigned bx = xb_xcc_id();
        __builtin_amdgcn_s_waitcnt(0);
        unsigned nloc = b.st[0], nx = b.st[1];
        if (nloc == 0u) { xcd_barrier_complete(bar, bx, nloc, nx); b.st[0] = nloc; b.st[1] = nx; }
        const unsigned old = xb_add(&bar[XB_XSUB(bx)], 1u);
        const unsigned gen = old / nloc;
        if (old + 1u == (gen + 1u) * nloc) {
            __builtin_amdgcn_fence(__ATOMIC_RELEASE, "agent");
            asm volatile("s_waitcnt vmcnt(0)" ::: "memory");
            const unsigned og = xb_add(&bar[XB_TOP], 1u);
            const unsigned tg = og / nx;
            if (og + 1u == (tg + 1u) * nx) xb_add(&bar[XB_TOPGEN], 1u);
            else XB_SPIN(xb_ld(&bar[XB_TOPGEN]) == tg, bar);
            __builtin_amdgcn_fence(__ATOMIC_ACQUIRE, "agent");
            xb_add(&bar[XB_XGEN(bx)], 1u);
            asm volatile("s_waitcnt vmcnt(0)" ::: "memory");
        } else {
            XB_SPIN(xb_ld(&bar[XB_XGEN(bx)]) == gen, bar);
            __builtin_amdgcn_fence(__ATOMIC_ACQUIRE, "agent");
            asm volatile("s_waitcnt vmcnt(0)" ::: "memory");
        }
    }
    __syncthreads();
}

struct Args { const float* in[25]; float* out; unsigned char* ws; };
enum { I_X = 0, I_C, I_CTX, I_CCTX, I_WADA, I_BADA, I_GPRE1, I_GPOST1, I_GPRE2, I_GPOST2, I_WIN, I_RPB, I_GQN, I_GKN, I_MQN, I_MKVN, I_WUQ, I_WUKV, I_WBRA, I_WBRB, I_WBRC, I_WO, I_WFF1, I_WFF3, I_WFF2 };

struct TItem { const float* W; bf16_t* WT; int K, N, k0, n0, dbase; bool mode13, gate8; };
__device__ __forceinline__ TItem titem_get(const Args& a, int l, int it) {
    unsigned char* ws = a.ws; TItem d;
    constexpr int I_IN = 32 * 370, I_13 = 32 * 176, I_2 = 88 * 64, I_O = 32 * 64, I_BR = 16 * 64, I_UQ = 8 * 48;
    int r = it; d.mode13 = false; d.gate8 = false;
    if (r < I_IN) { const int kb = r / 370, nb = r % 370, n0 = nb * 32; d.W = a.in[I_WIN] + (size_t)l * DM * INW; d.K = DM; d.N = INW; d.WT = (bf16_t*)(ws + WS_WIN);
        d.k0 = kb * 64; d.n0 = n0; d.dbase = n0 < 4096 ? n0 : (n0 < 5696 ? n0 + 6144 : n0 - 1600);
        if (n0 >= 5696) { d.gate8 = true; d.dbase = n0 - 5696; d.WT = (bf16_t*)(ws + WS_WG8); }
        return d; }
    r -= I_IN;
    if (r < 2 * I_13) { const int which = r / I_13; r -= which * I_13; const int kb = r / 176, nb = r % 176; d.W = a.in[which ? I_WFF3 : I_WFF1] + (size_t)l * DM * DFF; d.K = DM; d.N = DFF; d.WT = (bf16_t*)(ws + WS_W13);
        d.k0 = kb * 64; d.n0 = nb * 32; d.dbase = 64 * nb + 16 * which; d.mode13 = true; return d; }
    r -= 2 * I_13;
    if (r < I_2) { const int kb = r / 64, nb = r % 64; d.W = a.in[I_WFF2] + (size_t)l * DFF * DM; d.K = DFF; d.N = DM; d.WT = (bf16_t*)(ws + WS_W2); d.k0 = kb * 64; d.n0 = nb * 32; d.dbase = nb * 32; return d; }
    r -= I_2;
    if (r < I_O) { const int kb = r / 64, nb = r % 64; d.W = a.in[I_WO] + (size_t)l * DM * DM; d.K = DM; d.N = DM; d.WT = (bf16_t*)(ws + WS_WO); d.k0 = kb * 64; d.n0 = nb * 32; d.dbase = nb * 32; return d; }
    r -= I_O;
    if (r < 3 * I_BR) { const int br = r / I_BR; r -= br * I_BR; const int kb = r / 64, nb = r % 64; d.W = a.in[I_WBRA + br] + (size_t)l * 1024 * DM; d.K = 1024; d.N = DM; d.WT = (bf16_t*)(ws + WS_WBR) + (size_t)br * 2048 * 1024;
        d.k0 = kb * 64; d.n0 = nb * 32; d.dbase = nb * 32; return d; }
    r -= 3 * I_BR;
    if (r < I_UQ) { const int kb = r / 48, nb = r % 48; d.W = a.in[I_WUQ] + (size_t)l * 512 * 1536; d.K = 512; d.N = 1536; d.WT = (bf16_t*)(ws + WS_WUQ); d.k0 = kb * 64; d.n0 = nb * 32; d.dbase = nb * 32; return d; }
    r -= I_UQ;
    { const int kb = r / 64, nb = r % 64; d.W = a.in[I_WUKV] + (size_t)l * 512 * 2048; d.K = 512; d.N = 2048; d.WT = (bf16_t*)(ws + WS_WUKV); d.k0 = kb * 64; d.n0 = nb * 32; d.dbase = nb * 32; return d; }
}
__device__ __forceinline__ void titem_load(const TItem& d, int lane, f32x4 (&v)[8]) {
    const int kq = lane >> 3, nq = (lane & 7) * 4;
    const float* Wp = d.W + (size_t)(d.k0 + kq) * d.N + d.n0 + nq;
#pragma unroll
    for (int i = 0; i < 8; ++i) v[i] = __builtin_nontemporal_load((const f32x4*)(Wp + (size_t)(8 * i) * d.N));
}
__device__ __forceinline__ void titem_store(const TItem& d, int lane, const f32x4 (&v)[8], LAS float* scr) {
    { const int kq = lane >> 3, nq = (lane & 7) * 4;
#pragma unroll
      for (int i = 0; i < 8; ++i) { LAS float* p = scr + (8 * i + kq) * 33 + nq; p[0] = v[i].x; p[1] = v[i].y; p[2] = v[i].z; p[3] = v[i].w; } }
    asm volatile("s_waitcnt lgkmcnt(0)" ::: "memory");
    const int c = lane & 7;
#pragma unroll
    for (int j = 0; j < 4; ++j) { const int n = (lane >> 3) + 8 * j; const LAS float* s = scr + (8 * c) * 33 + n;
        u32x4 o; o.x = cvtpk(s[0 * 33], s[1 * 33]); o.y = cvtpk(s[2 * 33], s[3 * 33]); o.z = cvtpk(s[4 * 33], s[5 * 33]); o.w = cvtpk(s[6 * 33], s[7 * 33]);
        const int drow = d.mode13 ? d.dbase + 32 * (n >> 4) + (n & 15) : d.dbase + n;
        if (d.gate8) { int w0 = 0, w1 = 0;
            w0 = __builtin_amdgcn_cvt_pk_fp8_f32(s[0 * 33] * 64.f, s[1 * 33] * 64.f, w0, false); w0 = __builtin_amdgcn_cvt_pk_fp8_f32(s[2 * 33] * 64.f, s[3 * 33] * 64.f, w0, true);
            w1 = __builtin_amdgcn_cvt_pk_fp8_f32(s[4 * 33] * 64.f, s[5 * 33] * 64.f, w1, false); w1 = __builtin_amdgcn_cvt_pk_fp8_f32(s[6 * 33] * 64.f, s[7 * 33] * 64.f, w1, true);
            *(u32x2*)((unsigned char*)d.WT + (size_t)drow * d.K + d.k0 + 8 * c) = (u32x2){(unsigned)w0, (unsigned)w1}; }
        else *(u32x4*)(d.WT + (size_t)drow * d.K + d.k0 + 8 * c) = o; }
    asm volatile("s_waitcnt lgkmcnt(0)" ::: "memory");
}
__device__ __forceinline__ void convert_weights(const Args& a, int l, int gw, int NGW, int lane, LAS float* scr) {
    lane = opaque_tid() & 63;
    constexpr int NITEMS = 32 * 370 + 2 * 32 * 176 + 88 * 64 + 32 * 64 + 3 * 16 * 64 + 8 * 48 + 8 * 64;
    if (gw >= NITEMS) return;
    TItem cur = titem_get(a, l, gw); f32x4 vc[8]; titem_load(cur, lane, vc);
    for (int it = gw; it < NITEMS; it += NGW) {
        const int nx = it + NGW; const bool has = nx < NITEMS;
        TItem nxt = cur; f32x4 vn[8];
        if (has) { nxt = titem_get(a, l, nx); titem_load(nxt, lane, vn); }
        titem_store(cur, lane, vc, scr);
        if (has) { cur = nxt;
#pragma unroll
            for (int i = 0; i < 8; ++i) vc[i] = vn[i]; }
    }
}

__device__ __forceinline__ void mod_phase(const Args& a, unsigned char* lds, int bid, int G, int tid) {
    if (bid >= 192) return;
    const int wid = tid >> 6, lane = tid & 63;
    float* sv = (float*)lds;
    float* red = (float*)(lds + 9 * 2048 * 4);
    for (int i = tid; i < 9 * 2048; i += 512) { const int j = i >> 11, d = i & 2047; const float v = (j < 8) ? a.in[I_C][j * 2048 + d] : a.in[I_CCTX][d]; sv[i] = v * sigmoidf_(v); }
    __syncthreads();
    for (int item = bid; item < 192; item += G) {
    const int l = item / 96, e0 = (item % 96) * 128;
    const float* W = a.in[I_WADA] + (size_t)l * DM * MODW + e0 + 2 * lane;
    float acc[9][2];
#pragma unroll
    for (int j = 0; j < 9; ++j) { acc[j][0] = 0.f; acc[j][1] = 0.f; }
    const int dbeg = wid * 256;
    for (int d = dbeg; d < dbeg + 256; d += 16) {
        float2 w[16];
#pragma unroll
        for (int q = 0; q < 16; ++q) w[q] = *(const float2*)(W + (size_t)(d + q) * MODW);
#pragma unroll
        for (int q = 0; q < 16; ++q) {
#pragma unroll
            for (int j = 0; j < 9; ++j) { const float s = sv[j * 2048 + d + q]; acc[j][0] = fmaf(s, w[q].x, acc[j][0]); acc[j][1] = fmaf(s, w[q].y, acc[j][1]); }
            if ((q & 1) == 1) asm volatile("" ::: "memory"); }
    }
#pragma unroll
    for (int j = 0; j < 9; ++j) { red[((wid * 9 + j) * 2 + 0) * 64 + lane] = acc[j][0]; red[((wid * 9 + j) * 2 + 1) * 64 + lane] = acc[j][1]; }
    __syncthreads();
    float* mod = (float*)(a.ws + WS_MOD);
    for (int i = tid; i < 9 * 128; i += 512) { const int j = i >> 7, t = i & 127, ln = t >> 1, q = t & 1; float s = 0.f;
#pragma unroll
        for (int w = 0; w < 8; ++w) s += red[((w * 9 + j) * 2 + q) * 64 + ln];
        mod[(size_t)(l * 9 + j) * MODW + e0 + t] = s + a.in[I_BADA][l * MODW + e0 + t]; }
    __syncthreads();
    }
}

template <bool HAS_T, bool HAS_H, bool SRC_BF = false, bool DST_BF = false>
__device__ __forceinline__ void row_phase(int bid, int G, int nrows, const void* xl_src, const float* xc_src, void* xl_dst, float* xc_dst,
                                          const bf16_t* T, const float* Tp, const float* modL, int gt_off, const float* g_post,
                                          const float* g_pre, const float* modN, int sh_off, int sc_off, bf16_t* H, unsigned char* H8, unsigned char* lds) {
    const int tid = opaque_tid(), lane = tid & 63, wave = tid >> 6;
    f32x4* P4 = (f32x4*)lds;
    for (int part = 0; part < 2; ++part) {
    int rb, re;
    if (part == 0) { const int per = (NLAT + G - 1) / G; rb = bid * per; re = min(rb + per, NLAT); }
    else { if (nrows <= NLAT) break; const int per = (nrows - NLAT + G - 1) / G; rb = NLAT + bid * per; re = min(rb + per, nrows); }
    for (int sb = rb; sb < re;) {
        const int j = sb < NLAT ? (sb >> 11) : 8;
        const int jend = j < 8 ? ((j + 1) << 11) : nrows, se = min(re, jend);
        __syncthreads();
        if constexpr (HAS_T) { P4[tid] = ((const f32x4*)(modL + (size_t)j * MODW + gt_off))[tid]; P4[512 + tid] = ((const f32x4*)g_post)[tid]; }
        if constexpr (HAS_H) { P4[1024 + tid] = ((const f32x4*)g_pre)[tid]; P4[1536 + tid] = ((const f32x4*)(modN + (size_t)j * MODW + sc_off))[tid]; P4[2048 + tid] = ((const f32x4*)(modN + (size_t)j * MODW + sh_off))[tid]; }
        __syncthreads();
        for (int r0 = sb + wave * 2; r0 < se; r0 += 16) {
            const bool two = (r0 + 1 < se); const int r1 = two ? r0 + 1 : r0;
            const bool lat = r0 < NLAT;
            f32x4 va[8], vb[8];
            if (SRC_BF && lat) {
                const u32x2* b0 = (const u32x2*)((const bf16_t*)xl_src + (size_t)r0 * DM) + lane; const u32x2* b1 = (const u32x2*)((const bf16_t*)xl_src + (size_t)r1 * DM) + lane;
#pragma unroll
                for (int q = 0; q < 8; ++q) { const u32x2 ta = __builtin_nontemporal_load(b0 + 64 * q), tb = __builtin_nontemporal_load(b1 + 64 * q);
                    va[q] = (f32x4){bflo(ta.x), bfhi(ta.x), bflo(ta.y), bfhi(ta.y)}; vb[q] = (f32x4){bflo(tb.x), bfhi(tb.x), bflo(tb.y), bfhi(tb.y)}; }
            } else {
                const f32x4* s0 = (const f32x4*)(lat ? (const float*)xl_src + (size_t)r0 * DM : xc_src + (size_t)(r0 - NLAT) * DM) + lane;
                const f32x4* s1 = (const f32x4*)(lat ? (const float*)xl_src + (size_t)r1 * DM : xc_src + (size_t)(r1 - NLAT) * DM) + lane;
#pragma unroll
                for (int q = 0; q < 8; ++q) { va[q] = __builtin_nontemporal_load(s0 + 64 * q); vb[q] = __builtin_nontemporal_load(s1 + 64 * q); }
            }
            if constexpr (HAS_T) {
                const u32x2* t0 = (const u32x2*)(T + (size_t)r0 * DM) + lane; const u32x2* t1 = (const u32x2*)(T + (size_t)r1 * DM) + lane;
                f32x4 fa[8], fb[8];
                if (lat || Tp == nullptr) {
#pragma unroll
                    for (int q = 0; q < 8; ++q) { const u32x2 ta = __builtin_nontemporal_load(t0 + 64 * q), tb = __builtin_nontemporal_load(t1 + 64 * q);
                        fa[q] = (f32x4){bflo(ta.x), bfhi(ta.x), bflo(ta.y), bfhi(ta.y)}; fb[q] = (f32x4){bflo(tb.x), bfhi(tb.x), bflo(tb.y), bfhi(tb.y)}; }
                } else {
                    const f32x4* p0 = (const f32x4*)(Tp + (size_t)(r0 - NLAT) * DM) + lane; const f32x4* p1 = (const f32x4*)(Tp + (size_t)(r1 - NLAT) * DM) + lane;
                    constexpr size_t SL = (size_t)NCTX * DM / 4;
                    f32x4 ua[8];
#pragma unroll
                    for (int q = 0; q < 8; ++q) { fa[q] = p0[64 * q]; ua[q] = p0[SL + 64 * q]; }
                    asm volatile("" ::: "memory");
#pragma unroll
                    for (int q = 0; q < 8; ++q) { fa[q] = fa[q] + ua[q]; fb[q] = p1[64 * q]; ua[q] = p0[2 * SL + 64 * q]; }
                    asm volatile("" ::: "memory");
#pragma unroll
                    for (int q = 0; q < 8; ++q) { fa[q] = fa[q] + ua[q]; ua[q] = p0[3 * SL + 64 * q]; }
                    asm volatile("" ::: "memory");
#pragma unroll
                    for (int q = 0; q < 8; ++q) { fa[q] = fa[q] + ua[q]; ua[q] = p1[SL + 64 * q]; }
                    asm volatile("" ::: "memory");
#pragma unroll
                    for (int q = 0; q < 8; ++q) { fb[q] = fb[q] + ua[q]; ua[q] = p1[2 * SL + 64 * q]; }
                    asm volatile("" ::: "memory");
#pragma unroll
                    for (int q = 0; q < 8; ++q) { fb[q] = fb[q] + ua[q]; ua[q] = p1[3 * SL + 64 * q]; }
                    asm volatile("" ::: "memory");
#pragma unroll
                    for (int q = 0; q < 8; ++q) fb[q] = fb[q] + ua[q];
                }
                float sa = 0.f, sbb = 0.f;
#pragma unroll
                for (int q = 0; q < 8; ++q) { sa += (fa[q].x * fa[q].x + fa[q].y * fa[q].y) + (fa[q].z * fa[q].z + fa[q].w * fa[q].w); sbb += (fb[q].x * fb[q].x + fb[q].y * fb[q].y) + (fb[q].z * fb[q].z + fb[q].w * fb[q].w); }
                const float ra = rsqrtf(wave_sum(sa) * (1.f / DM) + EPS), rbb = rsqrtf(wave_sum(sbb) * (1.f / DM) + EPS);
#pragma unroll
                for (int q = 0; q < 8; ++q) { const f32x4 w = P4[lane + 64 * q] * P4[512 + lane + 64 * q];
                    va[q] = va[q] + w * (fa[q] * ra); vb[q] = vb[q] + w * (fb[q] * rbb); }
                if (DST_BF && lat) {
                    u32x2* e0 = (u32x2*)((bf16_t*)xl_dst + (size_t)r0 * DM) + lane; u32x2* e1 = (u32x2*)((bf16_t*)xl_dst + (size_t)r1 * DM) + lane;
#pragma unroll
                    for (int q = 0; q < 8; ++q) { u32x2 wa; wa.x = cvtpk(va[q].x, va[q].y); wa.y = cvtpk(va[q].z, va[q].w); __builtin_nontemporal_store(wa, e0 + 64 * q);
                        if (two) { u32x2 wb; wb.x = cvtpk(vb[q].x, vb[q].y); wb.y = cvtpk(vb[q].z, vb[q].w); __builtin_nontemporal_store(wb, e1 + 64 * q); } }
                } else {
                    f32x4* d0 = (f32x4*)(lat ? (float*)xl_dst + (size_t)r0 * DM : xc_dst + (size_t)(r0 - NLAT) * DM) + lane;
                    f32x4* d1 = (f32x4*)(lat ? (float*)xl_dst + (size_t)r1 * DM : xc_dst + (size_t)(r1 - NLAT) * DM) + lane;
#pragma unroll
                    for (int q = 0; q < 8; ++q) { __builtin_nontemporal_store(va[q], d0 + 64 * q); if (two) __builtin_nontemporal_store(vb[q], d1 + 64 * q); }
                }
            }
            if constexpr (HAS_H) {
                float sa = 0.f, sbb = 0.f;
#pragma unroll
                for (int q = 0; q < 8; ++q) { sa += (va[q].x * va[q].x + va[q].y * va[q].y) + (va[q].z * va[q].z + va[q].w * va[q].w); sbb += (vb[q].x * vb[q].x + vb[q].y * vb[q].y) + (vb[q].z * vb[q].z + vb[q].w * vb[q].w); }
                const float ra = rsqrtf(wave_sum(sa) * (1.f / DM) + EPS), rbb = rsqrtf(wave_sum(sbb) * (1.f / DM) + EPS);
                u32x2* h0 = (u32x2*)(H + (size_t)r0 * DM) + lane; u32x2* h1 = (u32x2*)(H + (size_t)r1 * DM) + lane;
#pragma unroll
                for (int q = 0; q < 8; ++q) { const f32x4 g = P4[1024 + lane + 64 * q] * (P4[1536 + lane + 64 * q] + 1.f), sh = P4[2048 + lane + 64 * q];
                    const f32x4 ha = (va[q] * ra) * g + sh, hb = (vb[q] * rbb) * g + sh;
                    u32x2 wa; wa.x = cvtpk(ha.x, ha.y); wa.y = cvtpk(ha.z, ha.w); h0[64 * q] = wa;
                    if (two) { u32x2 wb; wb.x = cvtpk(hb.x, hb.y); wb.y = cvtpk(hb.z, hb.w); h1[64 * q] = wb; }
                    if (H8) { int ea = 0, eb = 0;
                        ea = __builtin_amdgcn_cvt_pk_fp8_f32(ha.x, ha.y, ea, false); ea = __builtin_amdgcn_cvt_pk_fp8_f32(ha.z, ha.w, ea, true);
                        eb = __builtin_amdgcn_cvt_pk_fp8_f32(hb.x, hb.y, eb, false); eb = __builtin_amdgcn_cvt_pk_fp8_f32(hb.z, hb.w, eb, true);
                        ((int*)(H8 + (size_t)r0 * DM))[lane + 64 * q] = ea; if (two) ((int*)(H8 + (size_t)r1 * DM))[lane + 64 * q] = eb; } }
            }
        }
        sb = se;
    }
    }
    __syncthreads();
}

__device__ __forceinline__ float half_sum(float v) {
#pragma unroll
    for (int o = 1; o < 32; o <<= 1) v += __shfl_xor(v, o);
    return v;
}
__device__ __forceinline__ void prep_phase(const Args& a, int l, int gw, int NGW, int lane_in) {
    const int lane = opaque_tid() & 63, half = lane >> 5, hl = lane & 31;
    bf16_t* Z = (bf16_t*)(a.ws + WS_Z);
    const float* gqn = a.in[I_GQN] + l * 128; const float* gkn = a.in[I_GKN] + l * 128;
    const float* mqn = a.in[I_MQN] + l * 512; const float* mkvn = a.in[I_MKVN] + l * 512;
    constexpr float L2T = 13.287712379549449f;
    float gq[4], gk[4], gf[4];
#pragma unroll
    for (int e = 0; e < 4; ++e) { gq[e] = gqn[4 * hl + e]; gk[e] = gkn[4 * hl + e]; gf[e] = __builtin_amdgcn_exp2f(-(float)(((4 * hl) & 31) + e) * (L2T / 32.f)); }
    const bool is_x1 = ((hl & 15) < 8);
    const float kf0 = __builtin_amdgcn_exp2f(-(float)((2 * hl) & 15) * (L2T / 16.f)), kf1 = __builtin_amdgcn_exp2f(-(float)(((2 * hl) & 15) + 1) * (L2T / 16.f));
    for (int rp = gw; rp < MTOT / 2; rp += NGW) {
        const int r = 2 * rp + half;
        bf16_t* zr = Z + (size_t)r * LDZ;
        const bool lat = r < NLAT; const int s = r & 2047; const float prow = (float)(s >> 6), pcol = (float)(s & 63);
        const float pos = (hl >> 4) ? pcol : prow;
        float gc[4], gs[4];
#pragma unroll
        for (int e = 0; e < 4; ++e) { gc[e] = lat ? __cosf(pos * gf[e]) : 1.f; gs[e] = lat ? __sinf(pos * gf[e]) : 0.f; if (is_x1) gs[e] = -gs[e]; }
        u32x2 wq[10]; u32x4 wa[2], wb[2];
#pragma unroll
        for (int hh = 0; hh < 10; ++hh) wq[hh] = ((const u32x2*)(zr + (hh < 8 ? ZC_BQ + hh * 128 : ZC_BK + (hh - 8) * 128)))[hl];
#pragma unroll
        for (int w2 = 0; w2 < 2; ++w2) { const u32x4* p = (const u32x4*)(zr + (w2 ? ZC_CKV : ZC_CQ)) + 2 * hl; wa[w2] = p[0]; wb[w2] = p[1]; }
        const unsigned wk = ((const unsigned*)(zr + ZC_CKR))[hl];
        asm volatile("" ::: "memory");
        float ssq[10];
#pragma unroll
        for (int hh = 0; hh < 10; ++hh) { const float x0 = bflo(wq[hh].x), x1 = bfhi(wq[hh].x), x2 = bflo(wq[hh].y), x3 = bfhi(wq[hh].y); ssq[hh] = (x0 * x0 + x1 * x1) + (x2 * x2 + x3 * x3); }
#pragma unroll
        for (int o = 1; o < 32; o <<= 1)
#pragma unroll
            for (int hh = 0; hh < 10; ++hh) ssq[hh] += __shfl_xor(ssq[hh], o);
#pragma unroll
        for (int hh = 0; hh < 10; ++hh) {
            const float x[4] = { bflo(wq[hh].x), bfhi(wq[hh].x), bflo(wq[hh].y), bfhi(wq[hh].y) };
            const float rstd = rsqrtf(ssq[hh] * (1.f / 128.f) + EPS);
            float y[4], o[4];
#pragma unroll
            for (int e = 0; e < 4; ++e) y[e] = x[e] * rstd * (hh < 8 ? gq[e] : gk[e]);
#pragma unroll
            for (int e = 0; e < 4; ++e) { const float q = __shfl_xor(y[e], 8); o[e] = y[e] * gc[e] + q * gs[e]; }
            u32x2 ow; ow.x = cvtpk(o[0], o[1]); ow.y = cvtpk(o[2], o[3]);
            ((u32x2*)(zr + (hh < 8 ? ZC_BQ + hh * 128 : ZC_BK + (hh - 8) * 128)))[hl] = ow;
        }
#pragma unroll
        for (int w2 = 0; w2 < 2; ++w2) {
            u32x4* p = (u32x4*)(zr + (w2 ? ZC_CKV : ZC_CQ)) + 2 * hl; const float* g = (w2 ? mkvn : mqn) + 16 * hl;
            const u32x4 va = wa[w2], vb = wb[w2];
            float x[16] = { bflo(va.x), bfhi(va.x), bflo(va.y), bfhi(va.y), bflo(va.z), bfhi(va.z), bflo(va.w), bfhi(va.w), bflo(vb.x), bfhi(vb.x), bflo(vb.y), bfhi(vb.y), bflo(vb.z), bfhi(vb.z), bflo(vb.w), bfhi(vb.w) };
            float ss = 0.f;
#pragma unroll
            for (int e = 0; e < 16; ++e) ss += x[e] * x[e];
            const float rstd = rsqrtf(half_sum(ss) * (1.f / 512.f) + EPS);
#pragma unroll
            for (int e = 0; e < 16; ++e) x[e] = x[e] * rstd * g[e];
            u32x4 oa, ob; oa.x = cvtpk(x[0], x[1]); oa.y = cvtpk(x[2], x[3]); oa.z = cvtpk(x[4], x[5]); oa.w = cvtpk(x[6], x[7]);
            ob.x = cvtpk(x[8], x[9]); ob.y = cvtpk(x[10], x[11]); ob.z = cvtpk(x[12], x[13]); ob.w = cvtpk(x[14], x[15]);
            p[0] = oa; p[1] = ob;
        }
        {
            float c0 = lat ? __cosf(pos * kf0) : 1.f, s0 = lat ? __sinf(pos * kf0) : 0.f, c1 = lat ? __cosf(pos * kf1) : 1.f, s1 = lat ? __sinf(pos * kf1) : 0.f;
            if (is_x1) { s0 = -s0; s1 = -s1; }
            const float y0 = bflo(wk), y1 = bfhi(wk);
            const float q0 = __shfl_xor(y0, 8), q1 = __shfl_xor(y1, 8);
            if (lat) ((unsigned*)(zr + ZC_CKR))[hl] = cvtpk(y0 * c0 + q0 * s0, y1 * c1 + q1 * s1);
        }
    }
}

__device__ __forceinline__ void attn_phase(const Args& a, int l, bool ctx_out, int vcu, int G, char* lds) {
    const bf16_t* Z = (const bf16_t*)(a.ws + WS_Z); const bf16_t* QC = (const bf16_t*)(a.ws + WS_H); const bf16_t* KVC = (const bf16_t*)(a.ws + WS_KVC);
    bf16_t* O = (bf16_t*)(a.ws + WS_O);
    const float C128 = 0.08838834764831845f * 1.4426950408889634f, C192 = 0.07216878364870323f * 1.4426950408889634f;
    const float T128 = att::THR / 0.08838834764831845f, T192 = att::THR / 0.07216878364870323f;
    for (int uidx = vcu; uidx < 512; uidx += G) {
        const int b = (uidx & 255) >> 5, j = uidx & 31, rd = uidx >> 8, qb = j & 7;
        const size_t qrow = (size_t)b * SEQ + qb * 256;
        {
            const int kvh = rd, head = kvh * 4 + (j >> 3);
            att::UnitP P; P.Q = Z + qrow * LDZ + ZC_BQ + head * 128; P.ldq = LDZ; P.K1 = Z + ZC_BK + kvh * 128; P.ldk1 = LDZ; P.K2 = nullptr; P.ldk2 = 0;
            P.V = Z + ZC_BV + kvh * 128; P.ldv = LDZ; P.O = O + qrow * LDO + 1024 + head * 128; P.ldo = LDO;
            P.NT = 36; P.nlat = 32; P.row_lat0 = b * SEQ; P.row_ctx0 = NLAT + b * CTXL; P.C = C128; P.thr_raw = T128; P.rope_q = 0; P.qpos0 = 0; P.qgrow0 = 0; P.krow0 = 0;
            att::attn_unit<128, false>(P, lds);
        }
        const int head = rd * 4 + (j >> 3);
        {
            att::UnitP P; P.Q = QC + qrow * LDQC + head * 192; P.ldq = LDQC; P.K1 = KVC + head * 256; P.ldk1 = LDKVC; P.K2 = Z + ZC_CKR; P.ldk2 = LDZ;
            P.V = KVC + head * 256 + 128; P.ldv = LDKVC; P.O = O + qrow * LDO + 2048 + head * 128; P.ldo = LDO;
            P.NT = 36; P.nlat = 32; P.row_lat0 = b * SEQ; P.row_ctx0 = NLAT + b * CTXL; P.C = C192; P.thr_raw = T192; P.rope_q = 1; P.qpos0 = qb * 256; P.qgrow0 = 0; P.krow0 = 0;
            att::attn_unit<192, false>(P, lds);
        }
        {
            const int g0 = 4 * qb, krow0 = min(max(g0 - 4, 0), 24), klast = min(max(g0 + 3 - 4, 0), 24) + 7, nr = klast - krow0 + 1;
            float* rpbs = (float*)(lds + att::OFF_RPB);
            const float* rpb = a.in[I_RPB] + ((size_t)l * 8 + head) * 465;
            for (int i = opaque_tid(); i < 465; i += 512) rpbs[i] = rpb[i] * 11.313708498984761f;
            att::UnitP P; P.Q = Z + qrow * LDZ + ZC_AQ + head * 128; P.ldq = LDZ; P.K1 = Z + ZC_AK + head * 128; P.ldk1 = LDZ; P.K2 = nullptr; P.ldk2 = 0;
            P.V = Z + ZC_AV + head * 128; P.ldv = LDZ; P.O = O + qrow * LDO + head * 128; P.ldo = LDO;
            P.NT = nr + 4; P.nlat = nr; P.row_lat0 = b * SEQ + krow0 * 64; P.row_ctx0 = NLAT + b * CTXL; P.C = C128; P.thr_raw = T128; P.rope_q = 0; P.qpos0 = 0; P.qgrow0 = g0; P.krow0 = krow0;
            att::attn_unit<128, true>(P, lds);
        }
    }
    if (ctx_out) {
        for (int u = vcu; u < 192; u += G) {
            const int mixer = u / 64, b = (u % 64) >> 3, head = u & 7;
            const size_t qrow = (size_t)NLAT + (size_t)b * CTXL;
            att::UnitP P; P.NT = 4; P.nlat = 0; P.row_lat0 = 0; P.row_ctx0 = NLAT + b * CTXL; P.rope_q = 0; P.qpos0 = 0; P.qgrow0 = 0; P.krow0 = 0; P.K2 = nullptr; P.ldk2 = 0; P.ldo = LDO;
            if (mixer == 0) { P.Q = Z + qrow * LDZ + ZC_AQ + head * 128; P.ldq = LDZ; P.K1 = Z + ZC_AK + head * 128; P.ldk1 = LDZ; P.V = Z + ZC_AV + head * 128; P.ldv = LDZ;
                P.O = O + qrow * LDO + head * 128; P.C = C128; P.thr_raw = T128; att::attn_unit<128, false>(P, lds); }
            else if (mixer == 1) { const int kvh = head >> 2; P.Q = Z + qrow * LDZ + ZC_BQ + head * 128; P.ldq = LDZ; P.K1 = Z + ZC_BK + kvh * 128; P.ldk1 = LDZ; P.V = Z + ZC_BV + kvh * 128; P.ldv = LDZ;
                P.O = O + qrow * LDO + 1024 + head * 128; P.C = C128; P.thr_raw = T128; att::attn_unit<128, false>(P, lds); }
            else { P.Q = QC + qrow * LDQC + head * 192; P.ldq = LDQC; P.K1 = KVC + head * 256; P.ldk1 = LDKVC; P.K2 = Z + ZC_CKR; P.ldk2 = LDZ; P.V = KVC + head * 256 + 128; P.ldv = LDKVC;
                P.O = O + qrow * LDO + 2048 + head * 128; P.C = C192; P.thr_raw = T192; att::attn_unit<192, false>(P, lds); }
        }
    }
}

__global__ void __launch_bounds__(512, 2) fwd_megakernel(Args a) {
    extern __shared__ __attribute__((aligned(16))) unsigned char lds[];
    cg::grid_group grid = cg::this_grid();
    const int tid = threadIdx.x, lane = tid & 63, wave = __builtin_amdgcn_readfirstlane(tid >> 6);
    const int G = gridDim.x, bid = blockIdx.x;
    const int vcu = (G % 8 == 0) ? (bid % 8) * (G / 8) + bid / 8 : bid;
    const int gw = vcu * 8 + wave, NGW = G * 8;
    unsigned char* ws = a.ws;
    LAS unsigned char* ldsl = (LAS unsigned char*)lds;
    LAS float* scr = (LAS float*)(ldsl + wave * 16384);
    float* mod = (float*)(ws + WS_MOD); float* CX = (float*)(ws + WS_CX);
    bf16_t* H = (bf16_t*)(ws + WS_H); bf16_t* Z = (bf16_t*)(ws + WS_Z); bf16_t* QC = (bf16_t*)(ws + WS_H); bf16_t* KVC = (bf16_t*)(ws + WS_KVC);
    bf16_t* Y = (bf16_t*)(ws + WS_KVC); bf16_t* O = (bf16_t*)(ws + WS_O); bf16_t* T = (bf16_t*)(ws + WS_T); bf16_t* U = (bf16_t*)(ws + WS_U); float* TP = (float*)(ws + WS_TP);

    unsigned* barw = (unsigned*)(ws + WS_BAR);
    volatile LAS unsigned* bst = (volatile LAS unsigned*)(ldsl + 131072 + 64);
    if (bid == 0) for (int i = tid; i < XCD_BAR_WORDS; i += 512) barw[i] = 0u;
    if (tid < 2) bst[tid] = 0u;
    __syncthreads();
    mod_phase(a, lds, bid, G, tid);
    convert_weights(a, 0, gw, NGW, lane, scr);
    grid.sync();
    const XcdBarrier xb = xcd_barrier_post(barw, bst);
#define GSYNC() xcd_barrier(xb)
    row_phase<false, true>(bid, G, MTOT, a.in[I_X], a.in[I_CTX], nullptr, nullptr, nullptr, nullptr, nullptr, 0, nullptr, a.in[I_GPRE1], mod, 0, 2048, H, ws + WS_H8, lds);
    GSYNC();
    for (int l = 0; l < 2; ++l) {
        const bool ctx_out = (l == 0);
        const int nMr = ctx_out ? MTOT / 256 : NLAT / 256;
        const float* modL = mod + (size_t)l * 9 * MODW;
        { pg8::TileSched S; S.nM = ctx_out ? MTOT / 256 : NLAT / 256; S.nN = 23; S.nwg = S.nM * S.nN; S.G = G; S.c = bid; S.nsub = 1; S.A = (const char*)H; S.B = (const char*)(ws + WS_WIN);
          S.aT = (size_t)256 * DM * 2; S.bT = (size_t)256 * DM * 2; S.aS = 0; S.bS = 0; S.nx = ctx_out ? 0 : 104;
          S.pn_split = 16; S.pn_skip = 24; S.pn_boff = 0;
          pg8::EpiZ E{Z}; pg8::gemm_phase(ldsl, DM, DM, DM, S, E); }
        { pg8::TileSched S; S.nM = ctx_out ? MTOT / 256 : NLAT / 256; S.nN = 24; S.nwg = S.nM * S.nN; S.G = G; S.c = bid; S.nsub = 1; S.A = (const char*)(ws + WS_H8); S.B = (const char*)(ws + WS_WG8);
          S.aT = (size_t)256 * DM; S.bT = (size_t)256 * DM; S.aS = 0; S.bS = 0; S.nx = 0; S.pn_split = 0; S.pn_skip = 16; S.pn_boff = 16;
          pg8::EpiZ8 E{Z}; pg8::gemm_phase<true>(ldsl, DM / 2, DM / 2, DM / 2, S, E); }
        GSYNC();
        prep_phase(a, l, gw, NGW, lane);
        GSYNC();
        { pg8::DualSched S; S.G = G; S.c = bid; S.n0 = (MTOT / 256) * 6; S.n1 = (MTOT / 256) * 8; S.nN0 = 6; S.nN1 = 8;
          S.A0 = (const char*)(Z + ZC_CQ); S.A1 = (const char*)(Z + ZC_CKV); S.B0 = (const char*)(ws + WS_WUQ); S.B1 = (const char*)(ws + WS_WUKV);
          S.aT = (size_t)256 * LDZ * 2; S.bT = (size_t)256 * 512 * 2;
          pg8::EpiQKV E{QC, KVC, LDQC, LDKVC}; pg8::gemm_phase(ldsl, LDZ, 512, 512, S, E); }
        GSYNC();
        attn_phase(a, l, ctx_out, vcu, G, (char*)lds);
        GSYNC();
        { pg8::TileSched S; S.nM = nMr; S.nN = 8; S.nwg = S.nM * S.nN; S.G = G; S.c = bid; S.nsub = 3; S.A = (const char*)O; S.B = (const char*)(ws + WS_WBR);
          S.aT = (size_t)256 * LDO * 2; S.bT = (size_t)256 * 1024 * 2; S.aS = (size_t)1024 * 2; S.bS = (size_t)2048 * 1024 * 2; S.nx = 0; S.pn_split = 1 << 30; S.pn_skip = 0; S.pn_boff = 0;
          pg8::EpiMerge E{Y, Z}; pg8::gemm_phase(ldsl, LDO, 1024, 1024, S, E); }
        GSYNC();
        { pg8::TileSched S; S.nM = NLAT / 256; S.nN = 8; S.nwg = S.nM * S.nN; S.G = G; S.c = bid; S.nsub = 1; S.A = (const char*)Y; S.B = (const char*)(ws + WS_WO);
          S.aT = (size_t)256 * DM * 2; S.bT = (size_t)256 * DM * 2; S.aS = 0; S.bS = 0; S.nx = 0; S.pn_split = 1 << 30; S.pn_skip = 0; S.pn_boff = 0;
          pg8::EpiQKV E{T, T, DM, DM}; pg8::gemm_phase(ldsl, DM, DM, DM, S, E); }
        if (ctx_out) { pg8::CtxSplitSched S; S.G = G; S.c = bid; S.A = (const char*)Y; S.B = (const char*)(ws + WS_WO); S.aT = (size_t)256 * DM * 2; S.bT = (size_t)256 * DM * 2; S.kqB = (size_t)(DM / 4) * 2;
          pg8::EpiSlab E{TP}; pg8::gemm_phase(ldsl, DM, DM, DM / 4, S, E); }
        GSYNC();
        if (l == 0) row_phase<true, true, false, true>(bid, G, MTOT, a.in[I_X], a.in[I_CTX], O, CX, T, ctx_out ? TP : nullptr, modL, 4096, a.in[I_GPOST1] + l * DM,
                              a.in[I_GPRE2] + l * DM, modL, 6144, 8192, H, nullptr, lds);
        else        row_phase<true, true, true, true>(bid, G, NLAT, a.out, a.in[I_CTX], O, CX, T, ctx_out ? TP : nullptr, modL, 4096, a.in[I_GPOST1] + l * DM,
                              a.in[I_GPRE2] + l * DM, modL, 6144, 8192, H, nullptr, lds);
        GSYNC();
        { pg8::TileSched S; S.nM = nMr; S.nN = 2 * DFF / 256; S.nwg = S.nM * S.nN; S.G = G; S.c = bid; S.nsub = 1; S.A = (const char*)H; S.B = (const char*)(ws + WS_W13);
          S.aT = (size_t)256 * DM * 2; S.bT = (size_t)256 * DM * 2; S.aS = 0; S.bS = 0; S.nx = 0; S.pn_split = 1 << 30; S.pn_skip = 0; S.pn_boff = 0;
          pg8::EpiSwiglu E{U}; pg8::gemm_phase(ldsl, DM, DM, DM, S, E); }
        GSYNC();
        { pg8::TileSched S; S.nM = NLAT / 256; S.nN = 8; S.nwg = S.nM * S.nN; S.G = G; S.c = bid; S.nsub = 1; S.A = (const char*)U; S.B = (const char*)(ws + WS_W2);
          S.aT = (size_t)256 * DFF * 2; S.bT = (size_t)256 * DFF * 2; S.aS = 0; S.bS = 0; S.nx = 0; S.pn_split = 1 << 30; S.pn_skip = 0; S.pn_boff = 0;
          pg8::EpiQKV E{T, T, DM, DM}; pg8::gemm_phase(ldsl, DFF, DFF, DFF, S, E); }
        if (ctx_out) { pg8::CtxSplitSched S; S.G = G; S.c = bid; S.A = (const char*)U; S.B = (const char*)(ws + WS_W2); S.aT = (size_t)256 * DFF * 2; S.bT = (size_t)256 * DFF * 2; S.kqB = (size_t)(DFF / 4) * 2;
          pg8::EpiSlab E{TP}; pg8::gemm_phase(ldsl, DFF, DFF, DFF / 4, S, E); }
        GSYNC();
        if (l == 0) {
            row_phase<true, true, true, true>(bid, G, MTOT, O, CX, a.out, CX, T, TP, modL, 10240, a.in[I_GPOST2], a.in[I_GPRE1] + DM, mod + (size_t)9 * MODW, 0, 2048, H, ws + WS_H8, lds);
            convert_weights(a, 1, gw, NGW, lane, scr);
            GSYNC();
        } else {
            row_phase<true, false, true, false>(bid, G, NLAT, O, nullptr, a.out, nullptr, T, nullptr, modL, 10240, a.in[I_GPOST2] + DM, nullptr, nullptr, 0, 0, nullptr, nullptr, lds);
        }
    }
}

extern "C" void kernel_launch(void* const* d_in, const int* in_sizes, int n_in, void* d_out, int out_size, void* d_ws, size_t ws_size, hipStream_t stream) {
    static int grid = 0;
    if (grid == 0) {
        if (n_in != 25 || out_size != NLAT * DM || ws_size < WS_END) { fprintf(stderr, "kernel_launch: unexpected shapes: n_in %d out %d ws %zu (need %zu)\n", n_in, out_size, ws_size, (size_t)WS_END); grid = -1; return; }
        int dev = 0, cus = 0, per_cu = 0;
        if (hipGetDevice(&dev) != hipSuccess || hipDeviceGetAttribute(&cus, hipDeviceAttributeMultiprocessorCount, dev) != hipSuccess) { grid = -1; return; }
        if (hipFuncSetAttribute((const void*)fwd_megakernel, hipFuncAttributeMaxDynamicSharedMemorySize, LDS_BYTES) != hipSuccess) { fprintf(stderr, "kernel_launch: hipFuncSetAttribute failed\n"); grid = -1; return; }
        if (hipOccupancyMaxActiveBlocksPerMultiprocessor(&per_cu, (const void*)fwd_megakernel, 512, LDS_BYTES) != hipSuccess || per_cu < 1) { fprintf(stderr, "kernel_launch: occupancy query says %d\n", per_cu); per_cu = 1; }
        (void)hipGetLastError();
        grid = cus * 1;
    }
    if (grid < 0) return;
    Args a{};
    for (int i = 0; i < 25; ++i) a.in[i] = (const float*)d_in[i];
    a.out = (float*)d_out; a.ws = (unsigned char*)d_ws;
    void* args[] = {&a};
    hipError_t e = hipLaunchCooperativeKernel((const void*)fwd_megakernel, dim3(grid), dim3(512), args, LDS_BYTES, stream);
    if (e != hipSuccess) fprintf(stderr, "kernel_launch: cooperative launch failed: %s (grid %d)\n", hipGetErrorString(e), grid);
}
```

```cpp
#include <hip/hip_runtime.h>
#include <hip/hip_cooperative_groups.h>
#include <cstdio>
#include <cstdint>
namespace cg = cooperative_groups;

constexpr int DM = 2048, NB = 8, SEQ = 2048, CTXL = 256, NLAT = NB * SEQ, NCTX = NB * CTXL, MTOT = NLAT + NCTX;
constexpr int INW = 11840, LDZ = 11840, NZP = 12032, DFF = 5632, LDO = 3072, LDQC = 1536, LDKVC = 2112;
constexpr int MODW = 6 * DM;
constexpr float EPS = 1e-6f;
constexpr int ZC_AQ = 0, ZC_AK = 1024, ZC_AV = 2048, ZC_BQ = 3072, ZC_GA = 4096, ZC_BK = 10240, ZC_BV = 10496, ZC_CQ = 10752, ZC_CKV = 11264, ZC_CKR = 11776;
constexpr size_t WS_MOD = 0;
constexpr size_t WS_BAR = 901120;
constexpr size_t WS_CX = 1u << 20;
constexpr size_t WS_WIN = WS_CX + (size_t)NCTX * DM * 4;
constexpr size_t WS_WUQ = WS_WIN + (size_t)NZP * DM * 2;
constexpr size_t WS_WUKV = WS_WUQ + (size_t)1536 * 512 * 2;
constexpr size_t WS_WBR = WS_WUKV + (size_t)2048 * 512 * 2;
constexpr size_t WS_WO = WS_WBR + (size_t)3 * 2048 * 1024 * 2;
constexpr size_t WS_W13 = WS_WO + (size_t)2048 * 2048 * 2;
constexpr size_t WS_W2 = WS_W13 + (size_t)2 * DFF * DM * 2;
constexpr size_t WS_H = WS_W2 + (size_t)DM * DFF * 2;
constexpr size_t WS_Z = WS_H + (size_t)MTOT * DM * 2;
constexpr size_t WS_T = WS_Z;
constexpr size_t WS_U = WS_Z + (size_t)MTOT * DM * 4;
constexpr size_t WS_TP = WS_U + (size_t)MTOT * DFF * 2;
constexpr size_t WS_KVC = WS_Z + (size_t)MTOT * LDZ * 2;
constexpr size_t WS_O = WS_KVC + (size_t)MTOT * LDKVC * 2;
constexpr size_t WS_H8 = WS_O + (size_t)MTOT * LDO * 2;
constexpr size_t WS_WG8 = WS_H8 + (size_t)MTOT * DM;
constexpr size_t WS_END = WS_WG8 + (size_t)6144 * DM;
static_assert(WS_END <= 921975872ull, "workspace budget (sum of the inputs)");
static_assert(WS_TP + (size_t)4 * NCTX * DM * 4 <= WS_KVC, "overlay");
constexpr int LDS_BYTES = 147456;

typedef unsigned short bf16_t;
typedef short bf16x8 __attribute__((ext_vector_type(8)));
typedef short s16x4 __attribute__((ext_vector_type(4)));
typedef float f32x4 __attribute__((ext_vector_type(4)));
typedef float f32x16 __attribute__((ext_vector_type(16)));
typedef unsigned u32x4 __attribute__((ext_vector_type(4)));
typedef unsigned u32x2 __attribute__((ext_vector_type(2)));
typedef int i32x8 __attribute__((ext_vector_type(8)));
typedef int i32x4 __attribute__((ext_vector_type(4)));
#define LAS __attribute__((address_space(3)))

__device__ __forceinline__ int opaque_tid() { int t = threadIdx.x; asm volatile("" : "+v"(t)); return t; }
__device__ __forceinline__ unsigned cvtpk(float lo, float hi) { unsigned r; asm volatile("v_cvt_pk_bf16_f32 %0, %1, %2" : "=v"(r) : "v"(lo), "v"(hi)); return r; }
__device__ __forceinline__ float bf2f(unsigned short s) { return __uint_as_float(((unsigned)s) << 16); }
__device__ __forceinline__ float bflo(unsigned w) { return __uint_as_float(w << 16); }
__device__ __forceinline__ float bfhi(unsigned w) { return __uint_as_float(w & 0xffff0000u); }
__device__ __forceinline__ float wave_sum(float v) {
#pragma unroll
    for (int o = 1; o < 64; o <<= 1) v += __shfl_xor(v, o);
    return v;
}
__device__ __forceinline__ float sigmoidf_(float x) { return __builtin_amdgcn_rcpf(1.f + __builtin_amdgcn_exp2f(-1.4426950408889634f * x)); }

namespace pg8 {
constexpr int BM = 256, BK = 64, HALF = 128, HTB = HALF * BK * 2, STAGE_BYTES = 8 * HTB, NXCD = 8, WGM = 8;
__device__ __forceinline__ int lds_byte(int r, int c) { const int st = (r >> 4) * 2 + (c >> 5), rr = r & 15, cc = c & 31, ob = rr * 64 + cc * 2; return st * 1024 + (ob ^ (((ob >> 9) & 1) << 5)); }
__device__ __forceinline__ void stage_rc(int b, int& R, int& C) { const int st = b / 1024, sb = b % 1024, swz = sb ^ (((sb >> 9) & 1) << 5); R = (st >> 1) * 16 + swz / 64; C = (st & 1) * 32 + (swz % 64) / 2; }
__device__ __forceinline__ int perm32(int rho) { const int n = rho >> 4, i = rho & 15; return 8 * (i >> 2) + 4 * n + (i & 3); }
struct Unit { int pm, pn, sub; };

struct TileSched {
    int nM, nN, nwg, G, c, nsub; const char* A; const char* B; size_t aT, bT, aS, bS;
    int pn_split, pn_skip, pn_boff;
    int nx;
    __device__ __forceinline__ bool next(int i, Unit& u) const {
        const int ti = i / nsub; u.sub = i - ti * nsub;
        const long L = (long)ti * G + c;
        if (L >= nwg) { const int k = (int)(L - nwg); if (k >= nx) return false; const int t = k / 13, idx = k - t * 13; u.pm = 64 + t;
            u.pn = idx < 8 ? 4 + idx : (idx < 10 ? 32 + idx : (idx < 12 ? 34 + idx : 46)); return true; }
        int wgid = (int)L; { const int q = nwg / NXCD, r = nwg % NXCD, xcd = wgid % NXCD, off = wgid / NXCD; wgid = (xcd < r ? xcd * (q + 1) : r * (q + 1) + (xcd - r) * q) + off; }
        const int nig = WGM * nN, gid = wgid / nig, fm = gid * WGM, gsz = (nM - fm) < WGM ? (nM - fm) : WGM;
        u.pm = fm + ((wgid % nig) % gsz); const int idx = (wgid % nig) / gsz; u.pn = idx < pn_split ? idx : idx + pn_skip; return true;
    }
    __device__ __forceinline__ const char* ptrA(const Unit& u) const { return A + (size_t)u.pm * aT + (size_t)u.sub * aS; }
    __device__ __forceinline__ const char* ptrB(const Unit& u) const { return B + (size_t)(u.pn - pn_boff) * bT + (size_t)u.sub * bS; }
};
struct DualSched {
    int G, c, n0, n1, nN0, nN1; const char *A0, *A1, *B0, *B1; size_t aT, bT;
    __device__ __forceinline__ bool next(int i, Unit& u) const {
        int L = i * G + c;
        if (L < n0) { u.sub = 0; u.pm = L / nN0; u.pn = L - u.pm * nN0; return true; }
        L -= n0; if (L >= n1) return false;
        u.sub = 1; u.pm = L / nN1; u.pn = L - u.pm * nN1; return true;
    }
    __device__ __forceinline__ const char* ptrA(const Unit& u) const { return (u.sub ? A1 : A0) + (size_t)u.pm * aT; }
    __device__ __forceinline__ const char* ptrB(const Unit& u) const { return (u.sub ? B1 : B0) + (size_t)u.pn * bT; }
};

struct EpiZ {
    static constexpr bool PERM = true;
    bf16_t* Z;
    __device__ __forceinline__ void operator()(const f32x4 (&acc)[2][2][4][2], const Unit& u, int wr, int wc, int fr, int fq) const {
        const int row0 = u.pm * BM + wr * 64 + fr, col0 = u.pn * BM + wc * 32 + 8 * fq;
#pragma unroll
        for (int ai = 0; ai < 2; ++ai)
#pragma unroll
            for (int m = 0; m < 4; ++m) { bf16_t* rowp = Z + (size_t)(row0 + ai * HALF + m * 16) * LDZ + col0;
#pragma unroll
                for (int bj = 0; bj < 2; ++bj) { const f32x4 v0 = acc[ai][bj][m][0], v1 = acc[ai][bj][m][1];
                    u32x4 w; w.x = cvtpk(v0[0], v0[1]); w.y = cvtpk(v0[2], v0[3]); w.z = cvtpk(v1[0], v1[1]); w.w = cvtpk(v1[2], v1[3]);
                    if (col0 + bj * HALF < LDZ) *(u32x4*)(rowp + bj * HALF) = w; } }
    }
};
struct EpiZ8 {
    static constexpr bool PERM = false, ALIGN = true;
    bf16_t* Z;
    __device__ __forceinline__ void operator()(const f32x4 (&acc)[2][2][4][2], const Unit& u, int wr, int wc, int fr, int fq) const {
        const int row0 = u.pm * BM + wr * 64 + fr, col0 = u.pn * BM + wc * 32 + 4 * fq;
#pragma unroll
        for (int ai = 0; ai < 2; ++ai)
#pragma unroll
            for (int m = 0; m < 4; ++m) { bf16_t* rowp = Z + (size_t)(row0 + ai * HALF + m * 16) * LDZ + col0;
#pragma unroll
                for (int bj = 0; bj < 2; ++bj)
#pragma unroll
                    for (int n = 0; n < 2; ++n) { const f32x4 v = acc[ai][bj][m][n]; u32x2 w; w.x = cvtpk(v[0], v[1]); w.y = cvtpk(v[2], v[3]); *(u32x2*)(rowp + bj * HALF + n * 16) = w; } }
    }
};
struct EpiQKV {
    static constexpr bool PERM = true;
    bf16_t* O0; bf16_t* O1; int ld0, ld1;
    __device__ __forceinline__ void operator()(const f32x4 (&acc)[2][2][4][2], const Unit& u, int wr, int wc, int fr, int fq) const {
        bf16_t* O = u.sub ? O1 : O0; const int ldc = u.sub ? ld1 : ld0;
        const int row0 = u.pm * BM + wr * 64 + fr, col0 = u.pn * BM + wc * 32 + 8 * fq;
#pragma unroll
        for (int ai = 0; ai < 2; ++ai)
#pragma unroll
            for (int m = 0; m < 4; ++m) { bf16_t* rowp = O + (size_t)(row0 + ai * HALF + m * 16) * ldc + col0;
#pragma unroll
                for (int bj = 0; bj < 2; ++bj) { const f32x4 v0 = acc[ai][bj][m][0], v1 = acc[ai][bj][m][1];
                    u32x4 w; w.x = cvtpk(v0[0], v0[1]); w.y = cvtpk(v0[2], v0[3]); w.z = cvtpk(v1[0], v1[1]); w.w = cvtpk(v1[2], v1[3]);
                    *(u32x4*)(rowp + bj * HALF) = w; } }
    }
};
struct EpiMerge {
    static constexpr bool PERM = true;
    bf16_t* Y; const bf16_t* Z;
    __device__ __forceinline__ void operator()(const f32x4 (&acc)[2][2][4][2], const Unit& u, int wr, int wc, int fr, int fq) const {
        const int row0 = u.pm * BM + wr * 64 + fr, col0 = u.pn * BM + wc * 32 + 8 * fq;
        const bool rmw = (u.sub > 0);
#pragma unroll
        for (int ai = 0; ai < 2; ++ai) {
            u32x4 g[4][2], pv[4][2];
#pragma unroll
            for (int m = 0; m < 4; ++m) { const size_t row = (size_t)(row0 + ai * HALF + m * 16);
#pragma unroll
                for (int bj = 0; bj < 2; ++bj) { g[m][bj] = *(const u32x4*)(Z + row * LDZ + ZC_GA + 2048 * u.sub + col0 + bj * HALF);
                    pv[m][bj] = rmw ? *(const u32x4*)(Y + row * DM + col0 + bj * HALF) : (u32x4){0u, 0u, 0u, 0u}; } }
            asm volatile("" ::: "memory");
#pragma unroll
            for (int m = 0; m < 4; ++m) { bf16_t* yp = Y + (size_t)(row0 + ai * HALF + m * 16) * DM + col0;
#pragma unroll
                for (int bj = 0; bj < 2; ++bj) { const f32x4 a0 = acc[ai][bj][m][0], a1 = acc[ai][bj][m][1]; const u32x4 gg = g[m][bj], p = pv[m][bj];
                    float v[8] = { a0[0] * sigmoidf_(bflo(gg.x)), a0[1] * sigmoidf_(bfhi(gg.x)), a0[2] * sigmoidf_(bflo(gg.y)), a0[3] * sigmoidf_(bfhi(gg.y)), a1[0] * sigmoidf_(bflo(gg.z)), a1[1] * sigmoidf_(bfhi(gg.z)), a1[2] * sigmoidf_(bflo(gg.w)), a1[3] * sigmoidf_(bfhi(gg.w)) };
                    v[0] += bflo(p.x); v[1] += bfhi(p.x); v[2] += bflo(p.y); v[3] += bfhi(p.y); v[4] += bflo(p.z); v[5] += bfhi(p.z); v[6] += bflo(p.w); v[7] += bfhi(p.w);
                    u32x4 w; w.x = cvtpk(v[0], v[1]); w.y = cvtpk(v[2], v[3]); w.z = cvtpk(v[4], v[5]); w.w = cvtpk(v[6], v[7]);
                    *(u32x4*)(yp + bj * HALF) = w; } }
        }
    }
};
struct EpiSwiglu {
    static constexpr bool PERM = false;
    bf16_t* U;
    __device__ __forceinline__ void operator()(const f32x4 (&acc)[2][2][4][2], const Unit& u, int wr, int wc, int fr, int fq) const {
        const int row0 = u.pm * BM + wr * 64 + fr, col0 = u.pn * 128 + wc * 16 + 4 * fq;
#pragma unroll
        for (int ai = 0; ai < 2; ++ai)
#pragma unroll
            for (int m = 0; m < 4; ++m) { bf16_t* rowp = U + (size_t)(row0 + ai * HALF + m * 16) * DFF + col0;
#pragma unroll
                for (int bj = 0; bj < 2; ++bj) { const f32x4 a = acc[ai][bj][m][0], g = acc[ai][bj][m][1]; float o[4];
#pragma unroll
                    for (int j = 0; j < 4; ++j) o[j] = a[j] * sigmoidf_(a[j]) * g[j];
                    u32x2 w; w.x = cvtpk(o[0], o[1]); w.y = cvtpk(o[2], o[3]);
                    *(u32x2*)(rowp + bj * 64) = w; } }
    }
};

struct CtxSplitSched {
    int G, c; const char* A; const char* B; size_t aT, bT, kqB;
    __device__ __forceinline__ bool next(int i, Unit& u) const { const int L = i * G + c; if (L >= 256) return false; u.sub = L & 3; const int t = L >> 2; u.pm = 64 + (t >> 3); u.pn = t & 7; return true; }
    __device__ __forceinline__ const char* ptrA(const Unit& u) const { return A + (size_t)u.pm * aT + (size_t)u.sub * kqB; }
    __device__ __forceinline__ const char* ptrB(const Unit& u) const { return B + (size_t)u.pn * bT + (size_t)u.sub * kqB; }
};
struct EpiSlab {
    static constexpr bool PERM = false;
    bf16_t* C;
    __device__ __forceinline__ void operator()(const f32x4 (&acc)[2][2][4][2], const Unit& u, int wr, int wc, int fr, int fq) const {
        const int row0 = (u.pm - 64) * BM + wr * 64 + fr, col0 = u.pn * BM + wc * 32 + 4 * fq;
        bf16_t* Cs = C + (size_t)u.sub * NCTX * DM;
#pragma unroll
        for (int ai = 0; ai < 2; ++ai)
#pragma unroll
            for (int m = 0; m < 4; ++m) { bf16_t* rowp = Cs + (size_t)(row0 + ai * HALF + m * 16) * DM + col0;
#pragma unroll
                for (int bj = 0; bj < 2; ++bj)
#pragma unroll
                    for (int n = 0; n < 2; ++n) { const f32x4 v = acc[ai][bj][m][n]; u32x2 w; w.x = cvtpk(v[0], v[1]); w.y = cvtpk(v[2], v[3]); *(u32x2*)(rowp + bj * HALF + n * 16) = w; } }
    }
};

template <bool F8 = false, class Epi, class Sched>
__device__ __forceinline__ void gemm_phase(LAS unsigned char* lds, const int lda, const int ldb, const int K, const Sched& S, const Epi& E) {
    const int tid = opaque_tid(), wid = __builtin_amdgcn_readfirstlane(tid >> 6), lane = tid & 63, wr = wid >> 2, wc = wid & 3, fr = lane & 15, fq = lane >> 4;
    const int nt = K / BK;
    unsigned voffA[2], voffB[2];
#pragma unroll
    for (int i = 0; i < 2; ++i) { int R, C; stage_rc(tid * 16 + i * 8192, R, C); const int Rb = Epi::PERM ? ((R & ~31) + perm32(R & 31)) : R;
        voffA[i] = (unsigned)(R * lda + C) * 2u; voffB[i] = (unsigned)(Rb * ldb + C) * 2u; }
    const size_t kstep = (size_t)(BK * 2);
    const size_t hstepA = (size_t)HALF * lda * 2, hstepB = (size_t)HALF * ldb * 2;
    const unsigned ldsw = (unsigned)wid * 1024u;
    const int aoff = lds_byte(wr * 64 + fr, fq * 8), boff = lds_byte(wc * 32 + fr, fq * 8);
#define PG8_SA(b, h) (((b) * 2 + (h)) * HTB)
#define PG8_SB(b, h) ((4 + (b) * 2 + (h)) * HTB)
#define PG8_STAGE(bufoff, gbase, voff) do { _Pragma("unroll") for (int _i = 0; _i < 2; ++_i) \
        __builtin_amdgcn_global_load_lds((const unsigned*)((const char*)(gbase) + (voff)[_i]), (LAS unsigned*)(lds + (bufoff) + ldsw + _i * 8192), 16, 0, 0); } while (0)
#define PG8_LDA(dst, b, h) do { if constexpr (F8) { _Pragma("unroll") for (int m = 0; m < 4; ++m) { const i32x4 _l = *(const LAS i32x4*)(lds + PG8_SA(b, h) + aoff + m * 2048), _u = *(const LAS i32x4*)(lds + PG8_SA(b, h) + aoff + m * 2048 + 1024); \
          dst##8[m] = __builtin_shufflevector(_l, _u, 0, 1, 2, 3, 4, 5, 6, 7); } } \
        else { _Pragma("unroll") for (int m = 0; m < 4; ++m) _Pragma("unroll") for (int k = 0; k < 2; ++k) dst[m][k] = *(const LAS bf16x8*)(lds + PG8_SA(b, h) + aoff + m * 2048 + k * 1024); } } while (0)
#define PG8_LDB(dst, b, h) do { if constexpr (F8) { _Pragma("unroll") for (int n = 0; n < 2; ++n) { const i32x4 _l = *(const LAS i32x4*)(lds + PG8_SB(b, h) + boff + n * 2048), _u = *(const LAS i32x4*)(lds + PG8_SB(b, h) + boff + n * 2048 + 1024); \
          dst##8[n] = __builtin_shufflevector(_l, _u, 0, 1, 2, 3, 4, 5, 6, 7); } } \
        else { _Pragma("unroll") for (int n = 0; n < 2; ++n) _Pragma("unroll") for (int k = 0; k < 2; ++k) dst[n][k] = *(const LAS bf16x8*)(lds + PG8_SB(b, h) + boff + n * 2048 + k * 1024); } } while (0)
#define PG8_MMA(ai, bj, At, Bt) do { __builtin_amdgcn_s_setprio(1); _Pragma("unroll") for (int m = 0; m < 4; ++m) _Pragma("unroll") for (int n = 0; n < 2; ++n) { \
        if constexpr (F8)   \
            asm volatile("v_mfma_scale_f32_16x16x128_f8f6f4 %0, %1, %2, %0, %3, %4 op_sel_hi:[0,0,0]" : "+v"(acc[ai][bj][m][n]) : "v"(Bt##8[n]), "v"(At##8[m]), "v"(f8s), "v"(f8s)); \
        else { _Pragma("unroll") for (int k = 0; k < 2; ++k) acc[ai][bj][m][n] = __builtin_amdgcn_mfma_f32_16x16x32_bf16(Bt[n][k], At[m][k], acc[ai][bj][m][n], 0, 0, 0); } } \
        __builtin_amdgcn_s_setprio(0); } while (0)
#define PG8_WAIT_V(n) asm volatile("s_waitcnt vmcnt(" #n ")" ::: "memory")
#define PG8_WAIT_L(n) asm volatile("s_waitcnt lgkmcnt(" #n ")" ::: "memory")
#define PG8_BAR __builtin_amdgcn_s_barrier()
#define PG8_SCHED __builtin_amdgcn_sched_barrier(0)
    Unit cur, nxt; int ui = 0;
    if (!S.next(0, cur)) return;
    f32x4 acc[2][2][4][2];
#pragma unroll
    for (int a = 0; a < 2; ++a)
#pragma unroll
        for (int b = 0; b < 2; ++b)
#pragma unroll
            for (int m = 0; m < 4; ++m)
#pragma unroll
                for (int n = 0; n < 2; ++n) acc[a][b][m][n] = (f32x4){0.f, 0.f, 0.f, 0.f};
    bf16x8 At[4][2], B0[2][2], B1[2][2];
    i32x8 At8[4], B08[2], B18[2];
    const int f8s = 0x7C7C7C7C;
    const char* cA = S.ptrA(cur); const char* cB = S.ptrB(cur);
    PG8_STAGE(PG8_SB(0, 0), cB, voffB); PG8_STAGE(PG8_SB(0, 1), cB + hstepB, voffB); PG8_STAGE(PG8_SA(0, 0), cA, voffA); PG8_STAGE(PG8_SA(0, 1), cA + hstepA, voffA);
    if (wr == 1) PG8_BAR;
    PG8_WAIT_V(2); PG8_BAR;
    PG8_STAGE(PG8_SB(1, 0), cB + kstep, voffB); PG8_STAGE(PG8_SA(1, 0), cA + kstep, voffA); PG8_STAGE(PG8_SB(1, 1), cB + hstepB + kstep, voffB);
    PG8_WAIT_V(6); PG8_BAR;
    for (;;) {
        const bool has_next = S.next(ui + 1, nxt);
        const char* nA = has_next ? S.ptrA(nxt) : cA; const char* nB = has_next ? S.ptrB(nxt) : cB;
        for (int t = 0; t < nt; t += 2) {
            const bool last = (t == nt - 2);
            const char* a1 = cA + (size_t)(t + 1) * kstep;
            const char* a2 = last ? nA : cA + (size_t)(t + 2) * kstep; const char* b2 = last ? nB : cB + (size_t)(t + 2) * kstep;
            const char* a3 = a2 + kstep; const char* b3 = b2 + kstep;
            PG8_LDB(B0, 0, 0); PG8_LDB(B1, 0, 1); PG8_SCHED; PG8_LDA(At, 0, 0); PG8_STAGE(PG8_SA(1, 1), a1 + hstepA, voffA);
            PG8_WAIT_V(8); PG8_WAIT_L(0); PG8_BAR; PG8_MMA(0, 0, At, B0); PG8_MMA(0, 1, At, B1); PG8_BAR; PG8_SCHED;
            PG8_LDA(At, 0, 1); PG8_STAGE(PG8_SB(0, 0), b2, voffB); PG8_STAGE(PG8_SB(0, 1), b2 + hstepB, voffB); PG8_STAGE(PG8_SA(0, 0), a2, voffA);
            PG8_WAIT_V(8); PG8_WAIT_L(0); PG8_BAR; PG8_MMA(1, 0, At, B0); PG8_MMA(1, 1, At, B1); PG8_BAR; PG8_SCHED;
            PG8_LDB(B0, 1, 0); PG8_LDB(B1, 1, 1); PG8_SCHED; PG8_LDA(At, 1, 0); PG8_STAGE(PG8_SA(0, 1), a2 + hstepA, voffA);
            PG8_WAIT_V(8); PG8_WAIT_L(0); PG8_BAR; PG8_MMA(0, 0, At, B0); PG8_MMA(0, 1, At, B1); PG8_BAR; PG8_SCHED;
            PG8_LDA(At, 1, 1); PG8_STAGE(PG8_SB(1, 0), b3, voffB); PG8_STAGE(PG8_SB(1, 1), b3 + hstepB, voffB); PG8_STAGE(PG8_SA(1, 0), a3, voffA);
            PG8_WAIT_V(8); PG8_WAIT_L(0); PG8_BAR; PG8_MMA(1, 0, At, B0); PG8_MMA(1, 1, At, B1); PG8_BAR; PG8_SCHED;
        }
        if (wr == 0) PG8_BAR;
        E(acc, cur, wr, wc, fr, fq);
        if (!has_next) break;
#pragma unroll
        for (int a = 0; a < 2; ++a)
#pragma unroll
            for (int b = 0; b < 2; ++b)
#pragma unroll
                for (int m = 0; m < 4; ++m)
#pragma unroll
                    for (int n = 0; n < 2; ++n) acc[a][b][m][n] = (f32x4){0.f, 0.f, 0.f, 0.f};
        cur = nxt; cA = nA; cB = nB; ++ui;
        if (wr == 1) PG8_BAR;
    }
    PG8_WAIT_V(0);
    PG8_BAR;
#undef PG8_SA
#undef PG8_SB
#undef PG8_STAGE
#undef PG8_LDA
#undef PG8_LDB
#undef PG8_MMA
#undef PG8_WAIT_V
#undef PG8_WAIT_L
#undef PG8_BAR
#undef PG8_SCHED
}
}

namespace att {
constexpr int SHM_V = 64 * 128 * 2;
constexpr int SHM_K = 64 * 192 * 2;
constexpr int OFF_K = 2 * SHM_V, OFF_WS = OFF_K + 2 * SHM_K, OFF_RPB = OFF_WS + 8 * 64 * 4, ATT_LDS = OFF_RPB + 2048;
constexpr float THR = 8.f;
__device__ __forceinline__ int crow(int r, int hi) { return (r & 3) + 8 * (r >> 2) + 4 * hi; }
__device__ __forceinline__ int v_st(int k, int c) { const int kk = (k & ~0xC) | ((k & 4) << 1) | ((k & 8) >> 1); return ((kk >> 3) * 4 + (c >> 5)) * 512 + ((kk & 7) * 32 + (c & 31)) * 2; }
__device__ __forceinline__ int v_rd_base(int lane) { return ((lane & 3) << 3) | (((lane >> 2) & 3) << 6) | (((lane >> 4) & 1) << 5) | (((lane >> 5) & 1) << 8); }
constexpr int v_rd_off(int d0, int ks, int half) { return d0 * 512 + ks * 4096 + half * 2048; }
template <int OFF> __device__ __forceinline__ s16x4 tr_read(int vb) {
    s16x4 r; asm volatile("ds_read_b64_tr_b16 %0, %1 offset:%2" : "=&v"(r) : "v"(vb), "i"(OFF) : "memory"); return r;
}
template <int D0> __device__ __forceinline__ void pv_one(f32x16& od, int vb, bf16x8 pa0, bf16x8 pa1, bf16x8 pa2, bf16x8 pa3) {
    const s16x4 l0 = tr_read<v_rd_off(D0, 0, 0)>(vb), h0 = tr_read<v_rd_off(D0, 0, 1)>(vb), l1 = tr_read<v_rd_off(D0, 1, 0)>(vb), h1 = tr_read<v_rd_off(D0, 1, 1)>(vb);
    const s16x4 l2 = tr_read<v_rd_off(D0, 2, 0)>(vb), h2 = tr_read<v_rd_off(D0, 2, 1)>(vb), l3 = tr_read<v_rd_off(D0, 3, 0)>(vb), h3 = tr_read<v_rd_off(D0, 3, 1)>(vb);
    asm volatile("s_waitcnt lgkmcnt(0)" ::: "memory"); __builtin_amdgcn_sched_barrier(0);
#define PK(L, H) (bf16x8){L[0], L[1], L[2], L[3], H[0], H[1], H[2], H[3]}
    od = __builtin_amdgcn_mfma_f32_32x32x16_bf16(pa0, PK(l0, h0), od, 0, 0, 0);
    od = __builtin_amdgcn_mfma_f32_32x32x16_bf16(pa1, PK(l1, h1), od, 0, 0, 0);
    od = __builtin_amdgcn_mfma_f32_32x32x16_bf16(pa2, PK(l2, h2), od, 0, 0, 0);
    od = __builtin_amdgcn_mfma_f32_32x32x16_bf16(pa3, PK(l3, h3), od, 0, 0, 0);
#undef PK
}

struct UnitP {
    const bf16_t* Q; int ldq;
    const bf16_t* K1; int ldk1;
    const bf16_t* K2; int ldk2;
    const bf16_t* V; int ldv;
    bf16_t* O; int ldo;
    int NT, nlat, row_lat0, row_ctx0;
    float C, thr_raw;
    int rope_q, qpos0;
    int qgrow0, krow0;
};

template <int DQK, bool NA>
__device__ __forceinline__ void attn_unit(const UnitP& P, char* lds) {
    constexpr int NQ = DQK / 16, KROWB = DQK * 2;
    const int tid = opaque_tid(), wid = __builtin_amdgcn_readfirstlane(tid >> 6), lane = tid & 63, r32 = lane & 31, hi = lane >> 5;
    char* V_lds = lds; char* K_lds = lds + OFF_K;
    float* wsf = (float*)(lds + OFF_WS) + wid * 64; float* li_l = wsf; float* al_l = wsf + 32;
    const float* rpbs = (const float*)(lds + OFF_RPB);
    float m_reg = -1e30f, l_reg = 0.f; f32x16 o[4];
#pragma unroll
    for (int d = 0; d < 4; ++d)
#pragma unroll
        for (int r = 0; r < 16; ++r) o[d][r] = 0.f;
    bf16x8 qr[NQ];
    { const bf16_t* Qw = P.Q + (size_t)(wid * 32 + r32) * P.ldq + hi * 8;
#pragma unroll
      for (int d0 = 0; d0 < NQ; ++d0) qr[d0] = *reinterpret_cast<const bf16x8*>(Qw + d0 * 16); }
    if constexpr (DQK == 192) {
        if (P.rope_q) {
            const int s = P.qpos0 + wid * 32 + r32; const float prow = (float)(s >> 6), pcol = (float)(s & 63);
#pragma unroll
            for (int e = 0; e < 8; ++e) {
                const float fr_ = __builtin_amdgcn_exp2f(-(float)(hi * 8 + e) * (13.287712379549449f / 16.f));
                const float ar = prow * fr_, ac = pcol * fr_;
                const float cr = __cosf(ar), sr = __sinf(ar), cc = __cosf(ac), sc = __sinf(ac);
                const float x1 = bf2f((unsigned short)qr[8][e]), x2 = bf2f((unsigned short)qr[9][e]), y1 = bf2f((unsigned short)qr[10][e]), y2 = bf2f((unsigned short)qr[11][e]);
                const unsigned w0 = cvtpk(x1 * cr - x2 * sr, x2 * cr + x1 * sr), w1 = cvtpk(y1 * cc - y2 * sc, y2 * cc + y1 * sc);
                qr[8][e] = (short)(w0 & 0xffffu); qr[9][e] = (short)(w0 >> 16); qr[10][e] = (short)(w1 & 0xffffu); qr[11][e] = (short)(w1 >> 16);
            }
        }
    }
    const int vb0 = (int)(uintptr_t)V_lds + v_rd_base(lane);
#define KSWZ(row, colB) ((row) * KROWB + ((colB) ^ (((row) & 7) << 4)))
#define TROW(t) ((t) < P.nlat ? P.row_lat0 + 64 * (t) : P.row_ctx0 + 64 * ((t) - P.nlat))
    LAS char* ldsl = (LAS char*)lds;
    constexpr int NKI = DQK / 64;
    int voffe[2]; const bf16_t* kbase[NKI]; int kld[NKI];
#pragma unroll
    for (int j = 0; j < 2; ++j) { const int X = (wid * 2 + j) * 1024 + lane * 16, st = X >> 9, kk = ((st >> 2) << 3) | ((X >> 6) & 7), c = ((st & 3) << 5) | ((X >> 1) & 31);
        const int k = (kk & ~0xC) | ((kk & 4) << 1) | ((kk & 8) >> 1); voffe[j] = k * P.ldv + c; }
#pragma unroll
    for (int j = 0; j < NKI; ++j) { const int X = (wid * NKI + j) * 1024 + lane * 16, row = X / KROWB, cb = X - row * KROWB, colB = cb ^ ((row & 7) << 4);
        if (DQK == 192 && colB >= 256) { kbase[j] = P.K2 + (size_t)row * P.ldk2 + ((colB - 256) >> 1); kld[j] = P.ldk2; }
        else { kbase[j] = P.K1 + (size_t)row * P.ldk1 + (colB >> 1); kld[j] = P.ldk1; } }
#define DMA(t, b) do { const size_t rb = (size_t)TROW(t); \
        _Pragma("unroll") for (int _j = 0; _j < 2; ++_j) __builtin_amdgcn_global_load_lds((const unsigned*)(P.V + rb * P.ldv + voffe[_j]), (LAS unsigned*)(ldsl + (b) * SHM_V + (wid * 2 + _j) * 1024), 16, 0, 0); \
        _Pragma("unroll") for (int _j = 0; _j < NKI; ++_j) __builtin_amdgcn_global_load_lds((const unsigned*)(kbase[_j] + rb * kld[_j]), (LAS unsigned*)(ldsl + OFF_K + (b) * SHM_K + (wid * NKI + _j) * 1024), 16, 0, 0); } while (0)
    const int qgrow = P.qgrow0 + (wid >> 1), qc = (wid & 1) * 32 + r32;
    const int r0w = min(max(qgrow - 4, 0), 24), c0 = min(max(qc - 8, 0), 48);
    DMA(0, 0); asm volatile("s_waitcnt vmcnt(0)" ::: "memory"); __syncthreads();
    for (int t = 0; t < P.NT; ++t) {
        if (t + 1 < P.NT) DMA(t + 1, (t + 1) & 1);
        bool act = true;
        if constexpr (NA) act = (t >= P.nlat) || ((unsigned)(P.krow0 + t - r0w) < 8u);
        if (act) {
            const char* Kb = K_lds + (t & 1) * SHM_K;
            f32x16 p0, p1;
#pragma unroll
            for (int r = 0; r < 16; ++r) { p0[r] = 0.f; p1[r] = 0.f; }
#pragma unroll
            for (int d0 = 0; d0 < NQ; ++d0) { const int cb = (d0 * 16 + hi * 8) * 2;
                const bf16x8 b0 = *reinterpret_cast<const bf16x8*>(Kb + KSWZ(r32, cb));
                const bf16x8 b1 = *reinterpret_cast<const bf16x8*>(Kb + KSWZ(32 + r32, cb));
                p0 = __builtin_amdgcn_mfma_f32_32x32x16_bf16(b0, qr[d0], p0, 0, 0, 0);
                p1 = __builtin_amdgcn_mfma_f32_32x32x16_bf16(b1, qr[d0], p1, 0, 0, 0); }
            if constexpr (NA) {
                if (t < P.nlat) {
                    const int dr = P.krow0 + t - qgrow + 7; const float* rp = rpbs + dr * 31;
                    int qcx = qc, c0x = c0, hix = hi; asm volatile("" : "+v"(qcx), "+v"(c0x), "+v"(hix));
#pragma unroll
                    for (int r = 0; r < 16; ++r) { const int kc0 = crow(r, hix), kc1 = 32 + kc0;
                        const float b0 = rp[min(max(kc0 - qcx + 15, 0), 30)], b1 = rp[min(max(kc1 - qcx + 15, 0), 30)];
                        p0[r] = ((unsigned)(kc0 - c0x) < 16u) ? p0[r] + b0 : -1e30f;
                        p1[r] = ((unsigned)(kc1 - c0x) < 16u) ? p1[r] + b1 : -1e30f;
                        if ((r & 3) == 3) asm volatile("" ::: "memory"); }
                }
            }
            float pmax = p0[0];
#pragma unroll
            for (int r = 1; r < 16; ++r) pmax = fmaxf(pmax, p0[r]);
#pragma unroll
            for (int r = 0; r < 16; ++r) pmax = fmaxf(pmax, p1[r]);
            { auto rr = __builtin_amdgcn_permlane32_swap(__float_as_uint(pmax), __float_as_uint(pmax), false, false);
              pmax = fmaxf(__uint_as_float(rr[0]), __uint_as_float(rr[1])); }
            float mn, alpha;
            if (__all(pmax - m_reg <= P.thr_raw)) { mn = m_reg; alpha = 1.f; }
            else { mn = fmaxf(m_reg, pmax); alpha = __builtin_amdgcn_exp2f((m_reg - mn) * P.C); m_reg = mn; }
            const float mnC = -mn * P.C;
            float ps = 0.f;
#pragma unroll
            for (int r = 0; r < 16; ++r) { p0[r] = __builtin_amdgcn_exp2f(fmaf(p0[r], P.C, mnC)); p1[r] = __builtin_amdgcn_exp2f(fmaf(p1[r], P.C, mnC)); ps += p0[r] + p1[r]; }
            { auto rr = __builtin_amdgcn_permlane32_swap(__float_as_uint(ps), __float_as_uint(ps), false, false);
              ps = __uint_as_float(rr[0]) + __uint_as_float(rr[1]); }
            l_reg = l_reg * alpha + ps;
            if (__any(alpha < 1.f)) { if (hi == 0) al_l[r32] = alpha; asm volatile("s_waitcnt lgkmcnt(0)" ::: "memory");
#pragma unroll
                for (int r = 0; r < 16; ++r) { const float a = al_l[crow(r, hi)];
#pragma unroll
                    for (int d = 0; d < 4; ++d) o[d][r] *= a; } }
            bf16x8 pa0, pa1, pa2, pa3;
#define PK4(Pv, BASE, OUT) do { unsigned a0 = cvtpk(Pv[BASE + 0], Pv[BASE + 1]), a1 = cvtpk(Pv[BASE + 2], Pv[BASE + 3]);   \
    unsigned b0 = cvtpk(Pv[BASE + 4], Pv[BASE + 5]), b1 = cvtpk(Pv[BASE + 6], Pv[BASE + 7]);                              \
    auto r0 = __builtin_amdgcn_permlane32_swap(a0, b0, false, false); auto r1 = __builtin_amdgcn_permlane32_swap(a1, b1, false, false); \
    u32x4 w = {r0[0], r1[0], r0[1], r1[1]}; OUT = *reinterpret_cast<bf16x8*>(&w); } while (0)
            PK4(p0, 0, pa0); PK4(p0, 8, pa1); PK4(p1, 0, pa2); PK4(p1, 8, pa3);
#undef PK4
            const int vb = vb0 + (t & 1) * SHM_V;
            pv_one<0>(o[0], vb, pa0, pa1, pa2, pa3); pv_one<1>(o[1], vb, pa0, pa1, pa2, pa3); pv_one<2>(o[2], vb, pa0, pa1, pa2, pa3); pv_one<3>(o[3], vb, pa0, pa1, pa2, pa3);
        }
        asm volatile("s_waitcnt vmcnt(0)" ::: "memory");
        __syncthreads();
    }
    if (hi == 0) li_l[r32] = l_reg;
    asm volatile("s_waitcnt lgkmcnt(0)" ::: "memory");
    bf16_t* Ow = P.O + (size_t)(wid * 32) * P.ldo;
#pragma unroll
    for (int r = 0; r < 16; ++r) { const int orow = crow(r, hi); const float rl = __builtin_amdgcn_rcpf(li_l[orow]);
#pragma unroll
        for (int d0 = 0; d0 < 4; ++d0) Ow[(size_t)orow * P.ldo + d0 * 32 + r32] = (bf16_t)(cvtpk(o[d0][r] * rl, 0.f) & 0xffffu); }
    __syncthreads();
#undef KSWZ
#undef TROW
#undef DMA
}
}

#define XB_TMO      128
#define XB_XCNT(j)  (256  + 64 * (j))
#define XB_XSUB(j)  (1280 + 64 * (j))
#define XB_XGEN(j)  (2304 + 64 * (j))
#define XB_TOP      3328
#define XB_TOPGEN   3392
#define XCD_BAR_WORDS 3456
#define XB_SPIN_CAP (1u << 22)
__device__ __forceinline__ unsigned xb_ld(unsigned* p)              { return __hip_atomic_load(p, __ATOMIC_RELAXED, __HIP_MEMORY_SCOPE_AGENT); }
__device__ __forceinline__ unsigned xb_add(unsigned* p, unsigned v) { return __hip_atomic_fetch_add(p, v, __ATOMIC_RELAXED, __HIP_MEMORY_SCOPE_AGENT); }
__device__ __forceinline__ unsigned xb_xcc_id() { return (unsigned)__builtin_amdgcn_readfirstlane((int)((unsigned)__builtin_amdgcn_s_getreg((3 << 11) | 20) & 0xFu)); }
#define XB_SPIN(cond, bar) do { unsigned _sp = 0; while (cond) { __builtin_amdgcn_s_sleep(1); \
    if ((++_sp & 255u) == 0u) { if (xb_ld(&(bar)[XB_TMO])) break; if (_sp > XB_SPIN_CAP) { atomicAdd(&(bar)[XB_TMO], 1u); break; } } } } while (0)
struct XcdBarrier { unsigned* bar; unsigned x; volatile LAS unsigned* st; };
__device__ __forceinline__ XcdBarrier xcd_barrier_post(unsigned* bar, volatile LAS unsigned* st) {
    XcdBarrier b; b.bar = bar; b.x = 0; b.st = st;
    if (threadIdx.x == 0) (void)xb_add(&bar[XB_XCNT(xb_xcc_id())], 1u);
    return b;
}
__device__ __forceinline__ void xcd_barrier_complete(unsigned* bar, unsigned x, unsigned& nloc, unsigned& nx) {
    const unsigned G = gridDim.x * gridDim.y * gridDim.z;
    unsigned sum, cnt, mine, sp = 0u;
    for (;;) {
        sum = 0u; cnt = 0u; mine = 0u;
#pragma unroll
        for (unsigned j = 0; j < 16; ++j) { const unsigned c = xb_ld(&bar[XB_XCNT(j)]); sum += c; cnt += (c > 0u) ? 1u : 0u; mine = (j == x) ? c : mine; }
        if (sum == G) break;
        __builtin_amdgcn_s_sleep(1);
        if ((++sp & 255u) == 0u) { if (xb_ld(&bar[XB_TMO])) break; if (sp > XB_SPIN_CAP) { atomicAdd(&bar[XB_TMO], 1u); break; } }
    }
    nloc = mine > 0u ? mine : 1u; nx = cnt > 0u ? cnt : 1u;
}
__device__ __forceinline__ void xcd_barrier(const XcdBarrier& b) {
    asm volatile("s_waitcnt vmcnt(0)" ::: "memory");
    __syncthreads();
    if (threadIdx.x == 0) {
        unsigned* bar = b.bar; const unsigned bx = xb_xcc_id();
        __builtin_amdgcn_s_waitcnt(0);
        unsigned nloc = b.st[0], nx = b.st[1];
        if (nloc == 0u) { xcd_barrier_complete(bar, bx, nloc, nx); b.st[0] = nloc; b.st[1] = nx; }
        const unsigned old = xb_add(&bar[XB_XSUB(bx)], 1u);
        const unsigned gen = old / nloc;
        if (old + 1u == (gen + 1u) * nloc) {
            __builtin_amdgcn_fence(__ATOMIC_RELEASE, "agent");
            asm volatile("s_waitcnt vmcnt(0)" ::: "memory");
            const unsigned og = xb_add(&bar[XB_TOP], 1u);
            const unsigned tg = og / nx;
            if (og + 1u == (tg + 1u) * nx) xb_add(&bar[XB_TOPGEN], 1u);
            else XB_SPIN(xb_ld(&bar[XB_TOPGEN]) == tg, bar);
            __builtin_amdgcn_fence(__ATOMIC_ACQUIRE, "agent");
            xb_add(&bar[XB_XGEN(bx)], 1u);
            asm volatile("s_waitcnt vmcnt(0)" ::: "memory");
        } else {
            XB_SPIN(xb_ld(&bar[XB_XGEN(bx)]) == gen, bar);
            __builtin_amdgcn_fence(__ATOMIC_ACQUIRE, "agent");
            asm volatile("s_waitcnt vmcnt(0)" ::: "memory");
        }
    }
    __syncthreads();
}

struct Args { const float* in[25]; float* out; unsigned char* ws; };
enum { I_X = 0, I_C, I_CTX, I_CCTX, I_WADA, I_BADA, I_GPRE1, I_GPOST1, I_GPRE2, I_GPOST2, I_WIN, I_RPB, I_GQN, I_GKN, I_MQN, I_MKVN, I_WUQ, I_WUKV, I_WBRA, I_WBRB, I_WBRC, I_WO, I_WFF1, I_WFF3, I_WFF2 };

struct TItem { const float* W; bf16_t* WT; int K, N, k0, n0, dbase; bool mode13, gate8; };
__device__ __forceinline__ TItem titem_get(const Args& a, int l, int it) {
    unsigned char* ws = a.ws; TItem d;
    constexpr int I_IN = 32 * 370, I_13 = 32 * 176, I_2 = 88 * 64, I_O = 32 * 64, I_BR = 16 * 64, I_UQ = 8 * 48;
    int r = it; d.mode13 = false; d.gate8 = false;
    if (r < I_IN) { const int kb = r / 370, nb = r % 370, n0 = nb * 32; d.W = a.in[I_WIN] + (size_t)l * DM * INW; d.K = DM; d.N = INW; d.WT = (bf16_t*)(ws + WS_WIN);
        d.k0 = kb * 64; d.n0 = n0; d.dbase = n0 < 4096 ? n0 : (n0 < 5696 ? n0 + 6144 : n0 - 1600);
        if (n0 >= 5696) { d.gate8 = true; d.dbase = n0 - 5696; d.WT = (bf16_t*)(ws + WS_WG8); }
        return d; }
    r -= I_IN;
    if (r < 2 * I_13) { const int which = r / I_13; r -= which * I_13; const int kb = r / 176, nb = r % 176; d.W = a.in[which ? I_WFF3 : I_WFF1] + (size_t)l * DM * DFF; d.K = DM; d.N = DFF; d.WT = (bf16_t*)(ws + WS_W13);
        d.k0 = kb * 64; d.n0 = nb * 32; d.dbase = 64 * nb + 16 * which; d.mode13 = true; return d; }
    r -= 2 * I_13;
    if (r < I_2) { const int kb = r / 64, nb = r % 64; d.W = a.in[I_WFF2] + (size_t)l * DFF * DM; d.K = DFF; d.N = DM; d.WT = (bf16_t*)(ws + WS_W2); d.k0 = kb * 64; d.n0 = nb * 32; d.dbase = nb * 32; return d; }
    r -= I_2;
    if (r < I_O) { const int kb = r / 64, nb = r % 64; d.W = a.in[I_WO] + (size_t)l * DM * DM; d.K = DM; d.N = DM; d.WT = (bf16_t*)(ws + WS_WO); d.k0 = kb * 64; d.n0 = nb * 32; d.dbase = nb * 32; return d; }
    r -= I_O;
    if (r < 3 * I_BR) { const int br = r / I_BR; r -= br * I_BR; const int kb = r / 64, nb = r % 64; d.W = a.in[I_WBRA + br] + (size_t)l * 1024 * DM; d.K = 1024; d.N = DM; d.WT = (bf16_t*)(ws + WS_WBR) + (size_t)br * 2048 * 1024;
        d.k0 = kb * 64; d.n0 = nb * 32; d.dbase = nb * 32; return d; }
    r -= 3 * I_BR;
    if (r < I_UQ) { const int kb = r / 48, nb = r % 48; d.W = a.in[I_WUQ] + (size_t)l * 512 * 1536; d.K = 512; d.N = 1536; d.WT = (bf16_t*)(ws + WS_WUQ); d.k0 = kb * 64; d.n0 = nb * 32; d.dbase = nb * 32; return d; }
    r -= I_UQ;
    { const int kb = r / 64, nb = r % 64; d.W = a.in[I_WUKV] + (size_t)l * 512 * 2048; d.K = 512; d.N = 2048; d.WT = (bf16_t*)(ws + WS_WUKV); d.k0 = kb * 64; d.n0 = nb * 32; d.dbase = nb * 32; return d; }
}
__device__ __forceinline__ void titem_load(const TItem& d, int lane, f32x4 (&v)[8]) {
    const int kq = lane >> 3, nq = (lane & 7) * 4;
    const float* Wp = d.W + (size_t)(d.k0 + kq) * d.N + d.n0 + nq;
#pragma unroll
    for (int i = 0; i < 8; ++i) v[i] = __builtin_nontemporal_load((const f32x4*)(Wp + (size_t)(8 * i) * d.N));
}
__device__ __forceinline__ void titem_store(const TItem& d, int lane, const f32x4 (&v)[8], LAS float* scr) {
    { const int kq = lane >> 3, nq = (lane & 7) * 4;
#pragma unroll
      for (int i = 0; i < 8; ++i) { LAS float* p = scr + (8 * i + kq) * 33 + nq; p[0] = v[i].x; p[1] = v[i].y; p[2] = v[i].z; p[3] = v[i].w; } }
    asm volatile("s_waitcnt lgkmcnt(0)" ::: "memory");
    const int c = lane & 7;
#pragma unroll
    for (int j = 0; j < 4; ++j) { const int n = (lane >> 3) + 8 * j; const LAS float* s = scr + (8 * c) * 33 + n;
        u32x4 o; o.x = cvtpk(s[0 * 33], s[1 * 33]); o.y = cvtpk(s[2 * 33], s[3 * 33]); o.z = cvtpk(s[4 * 33], s[5 * 33]); o.w = cvtpk(s[6 * 33], s[7 * 33]);
        const int drow = d.mode13 ? d.dbase + 32 * (n >> 4) + (n & 15) : d.dbase + n;
        if (d.gate8) { int w0 = 0, w1 = 0;
            w0 = __builtin_amdgcn_cvt_pk_fp8_f32(s[0 * 33] * 64.f, s[1 * 33] * 64.f, w0, false); w0 = __builtin_amdgcn_cvt_pk_fp8_f32(s[2 * 33] * 64.f, s[3 * 33] * 64.f, w0, true);
            w1 = __builtin_amdgcn_cvt_pk_fp8_f32(s[4 * 33] * 64.f, s[5 * 33] * 64.f, w1, false); w1 = __builtin_amdgcn_cvt_pk_fp8_f32(s[6 * 33] * 64.f, s[7 * 33] * 64.f, w1, true);
            *(u32x2*)((unsigned char*)d.WT + (size_t)drow * d.K + d.k0 + 8 * c) = (u32x2){(unsigned)w0, (unsigned)w1}; }
        else *(u32x4*)(d.WT + (size_t)drow * d.K + d.k0 + 8 * c) = o; }
    asm volatile("s_waitcnt lgkmcnt(0)" ::: "memory");
}
__device__ __forceinline__ void convert_weights(const Args& a, int l, int gw, int NGW, int lane, LAS float* scr) {
    lane = opaque_tid() & 63;
    constexpr int NITEMS = 32 * 370 + 2 * 32 * 176 + 88 * 64 + 32 * 64 + 3 * 16 * 64 + 8 * 48 + 8 * 64;
    if (gw >= NITEMS) return;
    TItem cur = titem_get(a, l, gw); f32x4 vc[8]; titem_load(cur, lane, vc);
    for (int it = gw; it < NITEMS; it += NGW) {
        const int nx = it + NGW; const bool has = nx < NITEMS;
        TItem nxt = cur; f32x4 vn[8];
        if (has) { nxt = titem_get(a, l, nx); titem_load(nxt, lane, vn); }
        titem_store(cur, lane, vc, scr);
        if (has) { cur = nxt;
#pragma unroll
            for (int i = 0; i < 8; ++i) vc[i] = vn[i]; }
    }
}

__device__ __forceinline__ void mod_phase(const Args& a, unsigned char* lds, int bid, int G, int tid) {
    if (bid >= 192) return;
    const int wid = tid >> 6, lane = tid & 63;
    float* sv = (float*)lds;
    float* red = (float*)(lds + 9 * 2048 * 4);
    for (int i = tid; i < 9 * 2048; i += 512) { const int j = i >> 11, d = i & 2047; const float v = (j < 8) ? a.in[I_C][j * 2048 + d] : a.in[I_CCTX][d]; sv[i] = v * sigmoidf_(v); }
    __syncthreads();
    for (int item = bid; item < 192; item += G) {
    const int l = item / 96, e0 = (item % 96) * 128;
    const float* W = a.in[I_WADA] + (size_t)l * DM * MODW + e0 + 2 * lane;
    float acc[9][2];
#pragma unroll
    for (int j = 0; j < 9; ++j) { acc[j][0] = 0.f; acc[j][1] = 0.f; }
    const int dbeg = wid * 256;
    for (int d = dbeg; d < dbeg + 256; d += 16) {
        float2 w[16];
#pragma unroll
        for (int q = 0; q < 16; ++q) w[q] = *(const float2*)(W + (size_t)(d + q) * MODW);
#pragma unroll
        for (int q = 0; q < 16; ++q) {
#pragma unroll
            for (int j = 0; j < 9; ++j) { const float s = sv[j * 2048 + d + q]; acc[j][0] = fmaf(s, w[q].x, acc[j][0]); acc[j][1] = fmaf(s, w[q].y, acc[j][1]); }
            if ((q & 1) == 1) asm volatile("" ::: "memory"); }
    }
#pragma unroll
    for (int j = 0; j < 9; ++j) { red[((wid * 9 + j) * 2 + 0) * 64 + lane] = acc[j][0]; red[((wid * 9 + j) * 2 + 1) * 64 + lane] = acc[j][1]; }
    __syncthreads();
    float* mod = (float*)(a.ws + WS_MOD);
    for (int i = tid; i < 9 * 128; i += 512) { const int j = i >> 7, t = i & 127, ln = t >> 1, q = t & 1; float s = 0.f;
#pragma unroll
        for (int w = 0; w < 8; ++w) s += red[((w * 9 + j) * 2 + q) * 64 + ln];
        mod[(size_t)(l * 9 + j) * MODW + e0 + t] = s + a.in[I_BADA][l * MODW + e0 + t]; }
    __syncthreads();
    }
}

template <bool HAS_T, bool HAS_H, bool SRC_BF = false, bool DST_BF = false>
__device__ __forceinline__ void row_phase(int bid, int G, int nrows, const void* xl_src, const float* xc_src, void* xl_dst, float* xc_dst,
                                          const bf16_t* T, const bf16_t* Tp, const float* modL, int gt_off, const float* g_post,
                                          const float* g_pre, const float* modN, int sh_off, int sc_off, bf16_t* H, unsigned char* H8, unsigned char* lds) {
    const int tid = opaque_tid(), lane = tid & 63, wave = tid >> 6;
    f32x4* P4 = (f32x4*)lds;
    for (int part = 0; part < 2; ++part) {
    int rb, re;
    if (part == 0) { const int per = (NLAT + G - 1) / G; rb = bid * per; re = min(rb + per, NLAT); }
    else { if (nrows <= NLAT) break; const int per = (nrows - NLAT + G - 1) / G; rb = NLAT + bid * per; re = min(rb + per, nrows); }
    for (int sb = rb; sb < re;) {
        const int j = sb < NLAT ? (sb >> 11) : 8;
        const int jend = j < 8 ? ((j + 1) << 11) : nrows, se = min(re, jend);
        __syncthreads();
        if constexpr (HAS_T) { P4[tid] = ((const f32x4*)(modL + (size_t)j * MODW + gt_off))[tid]; P4[512 + tid] = ((const f32x4*)g_post)[tid]; }
        if constexpr (HAS_H) { P4[1024 + tid] = ((const f32x4*)g_pre)[tid]; P4[1536 + tid] = ((const f32x4*)(modN + (size_t)j * MODW + sc_off))[tid]; P4[2048 + tid] = ((const f32x4*)(modN + (size_t)j * MODW + sh_off))[tid]; }
        __syncthreads();
        for (int r0 = sb + wave * 2; r0 < se; r0 += 16) {
            const bool two = (r0 + 1 < se); const int r1 = two ? r0 + 1 : r0;
            const bool lat = r0 < NLAT;
            f32x4 va[8], vb[8];
            if (SRC_BF && lat) {
                const u32x2* b0 = (const u32x2*)((const bf16_t*)xl_src + (size_t)r0 * DM) + lane; const u32x2* b1 = (const u32x2*)((const bf16_t*)xl_src + (size_t)r1 * DM) + lane;
#pragma unroll
                for (int q = 0; q < 8; ++q) { const u32x2 ta = __builtin_nontemporal_load(b0 + 64 * q), tb = __builtin_nontemporal_load(b1 + 64 * q);
                    va[q] = (f32x4){bflo(ta.x), bfhi(ta.x), bflo(ta.y), bfhi(ta.y)}; vb[q] = (f32x4){bflo(tb.x), bfhi(tb.x), bflo(tb.y), bfhi(tb.y)}; }
            } else {
                const f32x4* s0 = (const f32x4*)(lat ? (const float*)xl_src + (size_t)r0 * DM : xc_src + (size_t)(r0 - NLAT) * DM) + lane;
                const f32x4* s1 = (const f32x4*)(lat ? (const float*)xl_src + (size_t)r1 * DM : xc_src + (size_t)(r1 - NLAT) * DM) + lane;
#pragma unroll
                for (int q = 0; q < 8; ++q) { va[q] = __builtin_nontemporal_load(s0 + 64 * q); vb[q] = __builtin_nontemporal_load(s1 + 64 * q); }
            }
            if constexpr (HAS_T) {
                const u32x2* t0 = (const u32x2*)(T + (size_t)r0 * DM) + lane; const u32x2* t1 = (const u32x2*)(T + (size_t)r1 * DM) + lane;
                f32x4 fa[8], fb[8];
                if (lat || Tp == nullptr) {
#pragma unroll
                    for (int q = 0; q < 8; ++q) { const u32x2 ta = __builtin_nontemporal_load(t0 + 64 * q), tb = __builtin_nontemporal_load(t1 + 64 * q);
                        fa[q] = (f32x4){bflo(ta.x), bfhi(ta.x), bflo(ta.y), bfhi(ta.y)}; fb[q] = (f32x4){bflo(tb.x), bfhi(tb.x), bflo(tb.y), bfhi(tb.y)}; }
                } else {
                    const u32x2* p0 = (const u32x2*)(Tp + (size_t)(r0 - NLAT) * DM) + lane; const u32x2* p1 = (const u32x2*)(Tp + (size_t)(r1 - NLAT) * DM) + lane;
                    constexpr size_t SL = (size_t)NCTX * DM / 4;
                    u32x2 sa4[4][8];
#pragma unroll
                    for (int sl = 0; sl < 4; ++sl)
#pragma unroll
                        for (int q = 0; q < 8; ++q) sa4[sl][q] = p0[sl * SL + 64 * q];
                    asm volatile("" ::: "memory");
#pragma unroll
                    for (int q = 0; q < 8; ++q) { fa[q] = (f32x4){0.f, 0.f, 0.f, 0.f};
#pragma unroll
                        for (int sl = 0; sl < 4; ++sl) { const u32x2 t = sa4[sl][q]; fa[q] = fa[q] + (f32x4){bflo(t.x), bfhi(t.x), bflo(t.y), bfhi(t.y)}; } }
#pragma unroll
                    for (int sl = 0; sl < 4; ++sl)
#pragma unroll
                        for (int q = 0; q < 8; ++q) sa4[sl][q] = p1[sl * SL + 64 * q];
                    asm volatile("" ::: "memory");
#pragma unroll
                    for (int q = 0; q < 8; ++q) { fb[q] = (f32x4){0.f, 0.f, 0.f, 0.f};
#pragma unroll
                        for (int sl = 0; sl < 4; ++sl) { const u32x2 t = sa4[sl][q]; fb[q] = fb[q] + (f32x4){bflo(t.x), bfhi(t.x), bflo(t.y), bfhi(t.y)}; } }
                }
                float sa = 0.f, sbb = 0.f;
#pragma unroll
                for (int q = 0; q < 8; ++q) { sa += (fa[q].x * fa[q].x + fa[q].y * fa[q].y) + (fa[q].z * fa[q].z + fa[q].w * fa[q].w); sbb += (fb[q].x * fb[q].x + fb[q].y * fb[q].y) + (fb[q].z * fb[q].z + fb[q].w * fb[q].w); }
                const float ra = rsqrtf(wave_sum(sa) * (1.f / DM) + EPS), rbb = rsqrtf(wave_sum(sbb) * (1.f / DM) + EPS);
#pragma unroll
                for (int q = 0; q < 8; ++q) { const f32x4 w = P4[lane + 64 * q] * P4[512 + lane + 64 * q];
                    va[q] = va[q] + w * (fa[q] * ra); vb[q] = vb[q] + w * (fb[q] * rbb); }
                if (DST_BF && lat) {
                    u32x2* e0 = (u32x2*)((bf16_t*)xl_dst + (size_t)r0 * DM) + lane; u32x2* e1 = (u32x2*)((bf16_t*)xl_dst + (size_t)r1 * DM) + lane;
#pragma unroll
                    for (int q = 0; q < 8; ++q) { u32x2 wa; wa.x = cvtpk(va[q].x, va[q].y); wa.y = cvtpk(va[q].z, va[q].w); __builtin_nontemporal_store(wa, e0 + 64 * q);
                        if (two) { u32x2 wb; wb.x = cvtpk(vb[q].x, vb[q].y); wb.y = cvtpk(vb[q].z, vb[q].w); __builtin_nontemporal_store(wb, e1 + 64 * q); } }
                } else {
                    f32x4* d0 = (f32x4*)(lat ? (float*)xl_dst + (size_t)r0 * DM : xc_dst + (size_t)(r0 - NLAT) * DM) + lane;
                    f32x4* d1 = (f32x4*)(lat ? (float*)xl_dst + (size_t)r1 * DM : xc_dst + (size_t)(r1 - NLAT) * DM) + lane;
#pragma unroll
                    for (int q = 0; q < 8; ++q) { __builtin_nontemporal_store(va[q], d0 + 64 * q); if (two) __builtin_nontemporal_store(vb[q], d1 + 64 * q); }
                }
            }
            if constexpr (HAS_H) {
                float sa = 0.f, sbb = 0.f;
#pragma unroll
                for (int q = 0; q < 8; ++q) { sa += (va[q].x * va[q].x + va[q].y * va[q].y) + (va[q].z * va[q].z + va[q].w * va[q].w); sbb += (vb[q].x * vb[q].x + vb[q].y * vb[q].y) + (vb[q].z * vb[q].z + vb[q].w * vb[q].w); }
                const float ra = rsqrtf(wave_sum(sa) * (1.f / DM) + EPS), rbb = rsqrtf(wave_sum(sbb) * (1.f / DM) + EPS);
                u32x2* h0 = (u32x2*)(H + (size_t)r0 * DM) + lane; u32x2* h1 = (u32x2*)(H + (size_t)r1 * DM) + lane;
#pragma unroll
                for (int q = 0; q < 8; ++q) { const f32x4 g = P4[1024 + lane + 64 * q] * (P4[1536 + lane + 64 * q] + 1.f), sh = P4[2048 + lane + 64 * q];
                    const f32x4 ha = (va[q] * ra) * g + sh, hb = (vb[q] * rbb) * g + sh;
                    u32x2 wa; wa.x = cvtpk(ha.x, ha.y); wa.y = cvtpk(ha.z, ha.w); h0[64 * q] = wa;
                    if (two) { u32x2 wb; wb.x = cvtpk(hb.x, hb.y); wb.y = cvtpk(hb.z, hb.w); h1[64 * q] = wb; }
                    if (H8) { int ea = 0, eb = 0;
                        ea = __builtin_amdgcn_cvt_pk_fp8_f32(ha.x, ha.y, ea, false); ea = __builtin_amdgcn_cvt_pk_fp8_f32(ha.z, ha.w, ea, true);
                        eb = __builtin_amdgcn_cvt_pk_fp8_f32(hb.x, hb.y, eb, false); eb = __builtin_amdgcn_cvt_pk_fp8_f32(hb.z, hb.w, eb, true);
                        ((int*)(H8 + (size_t)r0 * DM))[lane + 64 * q] = ea; if (two) ((int*)(H8 + (size_t)r1 * DM))[lane + 64 * q] = eb; } }
            }
        }
        sb = se;
    }
    }
    __syncthreads();
}

__device__ __forceinline__ float half_sum(float v) {
#pragma unroll
    for (int o = 1; o < 32; o <<= 1) v += __shfl_xor(v, o);
    return v;
}
__device__ __forceinline__ void prep_phase(const Args& a, int l, int gw, int NGW, int lane_in) {
    const int lane = opaque_tid() & 63, half = lane >> 5, hl = lane & 31;
    bf16_t* Z = (bf16_t*)(a.ws + WS_Z);
    const float* gqn = a.in[I_GQN] + l * 128; const float* gkn = a.in[I_GKN] + l * 128;
    const float* mqn = a.in[I_MQN] + l * 512; const float* mkvn = a.in[I_MKVN] + l * 512;
    constexpr float L2T = 13.287712379549449f;
    float gq[4], gk[4], gf[4];
#pragma unroll
    for (int e = 0; e < 4; ++e) { gq[e] = gqn[4 * hl + e]; gk[e] = gkn[4 * hl + e]; gf[e] = __builtin_amdgcn_exp2f(-(float)(((4 * hl) & 31) + e) * (L2T / 32.f)); }
    const bool is_x1 = ((hl & 15) < 8);
    const float kf0 = __builtin_amdgcn_exp2f(-(float)((2 * hl) & 15) * (L2T / 16.f)), kf1 = __builtin_amdgcn_exp2f(-(float)(((2 * hl) & 15) + 1) * (L2T / 16.f));
    for (int rp = gw; rp < MTOT / 2; rp += NGW) {
        const int r = 2 * rp + half;
        bf16_t* zr = Z + (size_t)r * LDZ;
        const bool lat = r < NLAT; const int s = r & 2047; const float prow = (float)(s >> 6), pcol = (float)(s & 63);
        const float pos = (hl >> 4) ? pcol : prow;
        float gc[4], gs[4];
#pragma unroll
        for (int e = 0; e < 4; ++e) { gc[e] = lat ? __cosf(pos * gf[e]) : 1.f; gs[e] = lat ? __sinf(pos * gf[e]) : 0.f; if (is_x1) gs[e] = -gs[e]; }
        u32x2 wq[10]; u32x4 wa[2], wb[2];
#pragma unroll
        for (int hh = 0; hh < 10; ++hh) wq[hh] = ((const u32x2*)(zr + (hh < 8 ? ZC_BQ + hh * 128 : ZC_BK + (hh - 8) * 128)))[hl];
#pragma unroll
        for (int w2 = 0; w2 < 2; ++w2) { const u32x4* p = (const u32x4*)(zr + (w2 ? ZC_CKV : ZC_CQ)) + 2 * hl; wa[w2] = p[0]; wb[w2] = p[1]; }
        const unsigned wk = ((const unsigned*)(zr + ZC_CKR))[hl];
        asm volatile("" ::: "memory");
        float ssq[10];
#pragma unroll
        for (int hh = 0; hh < 10; ++hh) { const float x0 = bflo(wq[hh].x), x1 = bfhi(wq[hh].x), x2 = bflo(wq[hh].y), x3 = bfhi(wq[hh].y); ssq[hh] = (x0 * x0 + x1 * x1) + (x2 * x2 + x3 * x3); }
#pragma unroll
        for (int o = 1; o < 32; o <<= 1)
#pragma unroll
            for (int hh = 0; hh < 10; ++hh) ssq[hh] += __shfl_xor(ssq[hh], o);
#pragma unroll
        for (int hh = 0; hh < 10; ++hh) {
            const float x[4] = { bflo(wq[hh].x), bfhi(wq[hh].x), bflo(wq[hh].y), bfhi(wq[hh].y) };
            const float rstd = rsqrtf(ssq[hh] * (1.f / 128.f) + EPS);
            float y[4], o[4];
#pragma unroll
            for (int e = 0; e < 4; ++e) y[e] = x[e] * rstd * (hh < 8 ? gq[e] : gk[e]);
#pragma unroll
            for (int e = 0; e < 4; ++e) { const float q = __shfl_xor(y[e], 8); o[e] = y[e] * gc[e] + q * gs[e]; }
            u32x2 ow; ow.x = cvtpk(o[0], o[1]); ow.y = cvtpk(o[2], o[3]);
            ((u32x2*)(zr + (hh < 8 ? ZC_BQ + hh * 128 : ZC_BK + (hh - 8) * 128)))[hl] = ow;
        }
#pragma unroll
        for (int w2 = 0; w2 < 2; ++w2) {
            u32x4* p = (u32x4*)(zr + (w2 ? ZC_CKV : ZC_CQ)) + 2 * hl; const float* g = (w2 ? mkvn : mqn) + 16 * hl;
            const u32x4 va = wa[w2], vb = wb[w2];
            float x[16] = { bflo(va.x), bfhi(va.x), bflo(va.y), bfhi(va.y), bflo(va.z), bfhi(va.z), bflo(va.w), bfhi(va.w), bflo(vb.x), bfhi(vb.x), bflo(vb.y), bfhi(vb.y), bflo(vb.z), bfhi(vb.z), bflo(vb.w), bfhi(vb.w) };
            float ss = 0.f;
#pragma unroll
            for (int e = 0; e < 16; ++e) ss += x[e] * x[e];
            const float rstd = rsqrtf(half_sum(ss) * (1.f / 512.f) + EPS);
#pragma unroll
            for (int e = 0; e < 16; ++e) x[e] = x[e] * rstd * g[e];
            u32x4 oa, ob; oa.x = cvtpk(x[0], x[1]); oa.y = cvtpk(x[2], x[3]); oa.z = cvtpk(x[4], x[5]); oa.w = cvtpk(x[6], x[7]);
            ob.x = cvtpk(x[8], x[9]); ob.y = cvtpk(x[10], x[11]); ob.z = cvtpk(x[12], x[13]); ob.w = cvtpk(x[14], x[15]);
            p[0] = oa; p[1] = ob;
        }
        {
            float c0 = lat ? __cosf(pos * kf0) : 1.f, s0 = lat ? __sinf(pos * kf0) : 0.f, c1 = lat ? __cosf(pos * kf1) : 1.f, s1 = lat ? __sinf(pos * kf1) : 0.f;
            if (is_x1) { s0 = -s0; s1 = -s1; }
            const float y0 = bflo(wk), y1 = bfhi(wk);
            const float q0 = __shfl_xor(y0, 8), q1 = __shfl_xor(y1, 8);
            if (lat) ((unsigned*)(zr + ZC_CKR))[hl] = cvtpk(y0 * c0 + q0 * s0, y1 * c1 + q1 * s1);
        }
    }
}

__device__ __forceinline__ void attn_phase(const Args& a, int l, bool ctx_out, int vcu, int G, char* lds) {
    const bf16_t* Z = (const bf16_t*)(a.ws + WS_Z); const bf16_t* QC = (const bf16_t*)(a.ws + WS_H); const bf16_t* KVC = (const bf16_t*)(a.ws + WS_KVC);
    bf16_t* O = (bf16_t*)(a.ws + WS_O);
    const float C128 = 0.08838834764831845f * 1.4426950408889634f, C192 = 0.07216878364870323f * 1.4426950408889634f;
    const float T128 = att::THR / 0.08838834764831845f, T192 = att::THR / 0.07216878364870323f;
    for (int uidx = vcu; uidx < 512; uidx += G) {
        const int b = (uidx & 255) >> 5, j = uidx & 31, rd = uidx >> 8, qb = j & 7;
        const size_t qrow = (size_t)b * SEQ + qb * 256;
        {
            const int kvh = rd, head = kvh * 4 + (j >> 3);
            att::UnitP P; P.Q = Z + qrow * LDZ + ZC_BQ + head * 128; P.ldq = LDZ; P.K1 = Z + ZC_BK + kvh * 128; P.ldk1 = LDZ; P.K2 = nullptr; P.ldk2 = 0;
            P.V = Z + ZC_BV + kvh * 128; P.ldv = LDZ; P.O = O + qrow * LDO + 1024 + head * 128; P.ldo = LDO;
            P.NT = 36; P.nlat = 32; P.row_lat0 = b * SEQ; P.row_ctx0 = NLAT + b * CTXL; P.C = C128; P.thr_raw = T128; P.rope_q = 0; P.qpos0 = 0; P.qgrow0 = 0; P.krow0 = 0;
            att::attn_unit<128, false>(P, lds);
        }
        const int head = rd * 4 + (j >> 3);
        {
            att::UnitP P; P.Q = QC + qrow * LDQC + head * 192; P.ldq = LDQC; P.K1 = KVC + head * 256; P.ldk1 = LDKVC; P.K2 = Z + ZC_CKR; P.ldk2 = LDZ;
            P.V = KVC + head * 256 + 128; P.ldv = LDKVC; P.O = O + qrow * LDO + 2048 + head * 128; P.ldo = LDO;
            P.NT = 36; P.nlat = 32; P.row_lat0 = b * SEQ; P.row_ctx0 = NLAT + b * CTXL; P.C = C192; P.thr_raw = T192; P.rope_q = 1; P.qpos0 = qb * 256; P.qgrow0 = 0; P.krow0 = 0;
            att::attn_unit<192, false>(P, lds);
        }
        {
            const int g0 = 4 * qb, krow0 = min(max(g0 - 4, 0), 24), klast = min(max(g0 + 3 - 4, 0), 24) + 7, nr = klast - krow0 + 1;
            float* rpbs = (float*)(lds + att::OFF_RPB);
            const float* rpb = a.in[I_RPB] + ((size_t)l * 8 + head) * 465;
            for (int i = opaque_tid(); i < 465; i += 512) rpbs[i] = rpb[i] * 11.313708498984761f;
            att::UnitP P; P.Q = Z + qrow * LDZ + ZC_AQ + head * 128; P.ldq = LDZ; P.K1 = Z + ZC_AK + head * 128; P.ldk1 = LDZ; P.K2 = nullptr; P.ldk2 = 0;
            P.V = Z + ZC_AV + head * 128; P.ldv = LDZ; P.O = O + qrow * LDO + head * 128; P.ldo = LDO;
            P.NT = nr + 4; P.nlat = nr; P.row_lat0 = b * SEQ + krow0 * 64; P.row_ctx0 = NLAT + b * CTXL; P.C = C128; P.thr_raw = T128; P.rope_q = 0; P.qpos0 = 0; P.qgrow0 = g0; P.krow0 = krow0;
            att::attn_unit<128, true>(P, lds);
        }
    }
    if (ctx_out) {
        for (int u = vcu; u < 192; u += G) {
            const int mixer = u / 64, b = (u % 64) >> 3, head = u & 7;
            const size_t qrow = (size_t)NLAT + (size_t)b * CTXL;
            att::UnitP P; P.NT = 4; P.nlat = 0; P.row_lat0 = 0; P.row_ctx0 = NLAT + b * CTXL; P.rope_q = 0; P.qpos0 = 0; P.qgrow0 = 0; P.krow0 = 0; P.K2 = nullptr; P.ldk2 = 0; P.ldo = LDO;
            if (mixer == 0) { P.Q = Z + qrow * LDZ + ZC_AQ + head * 128; P.ldq = LDZ; P.K1 = Z + ZC_AK + head * 128; P.ldk1 = LDZ; P.V = Z + ZC_AV + head * 128; P.ldv = LDZ;
                P.O = O + qrow * LDO + head * 128; P.C = C128; P.thr_raw = T128; att::attn_unit<128, false>(P, lds); }
            else if (mixer == 1) { const int kvh = head >> 2; P.Q = Z + qrow * LDZ + ZC_BQ + head * 128; P.ldq = LDZ; P.K1 = Z + ZC_BK + kvh * 128; P.ldk1 = LDZ; P.V = Z + ZC_BV + kvh * 128; P.ldv = LDZ;
                P.O = O + qrow * LDO + 1024 + head * 128; P.C = C128; P.thr_raw = T128; att::attn_unit<128, false>(P, lds); }
            else { P.Q = QC + qrow * LDQC + head * 192; P.ldq = LDQC; P.K1 = KVC + head * 256; P.ldk1 = LDKVC; P.K2 = Z + ZC_CKR; P.ldk2 = LDZ; P.V = KVC + head * 256 + 128; P.ldv = LDKVC;
                P.O = O + qrow * LDO + 2048 + head * 128; P.C = C192; P.thr_raw = T192; att::attn_unit<192, false>(P, lds); }
        }
    }
}

__global__ void __launch_bounds__(512, 2) fwd_megakernel(Args a) {
    extern __shared__ __attribute__((aligned(16))) unsigned char lds[];
    cg::grid_group grid = cg::this_grid();
    const int tid = threadIdx.x, lane = tid & 63, wave = __builtin_amdgcn_readfirstlane(tid >> 6);
    const int G = gridDim.x, bid = blockIdx.x;
    const int vcu = (G % 8 == 0) ? (bid % 8) * (G / 8) + bid / 8 : bid;
    const int gw = vcu * 8 + wave, NGW = G * 8;
    unsigned char* ws = a.ws;
    LAS unsigned char* ldsl = (LAS unsigned char*)lds;
    LAS float* scr = (LAS float*)(ldsl + wave * 16384);
    float* mod = (float*)(ws + WS_MOD); float* CX = (float*)(ws + WS_CX);
    bf16_t* H = (bf16_t*)(ws + WS_H); bf16_t* Z = (bf16_t*)(ws + WS_Z); bf16_t* QC = (bf16_t*)(ws + WS_H); bf16_t* KVC = (bf16_t*)(ws + WS_KVC);
    bf16_t* Y = (bf16_t*)(ws + WS_KVC); bf16_t* O = (bf16_t*)(ws + WS_O); bf16_t* T = (bf16_t*)(ws + WS_T); bf16_t* U = (bf16_t*)(ws + WS_U); bf16_t* TP = (bf16_t*)(ws + WS_TP);

    unsigned* barw = (unsigned*)(ws + WS_BAR);
    volatile LAS unsigned* bst = (volatile LAS unsigned*)(ldsl + 131072 + 64);
    if (bid == 0) for (int i = tid; i < XCD_BAR_WORDS; i += 512) barw[i] = 0u;
    if (tid < 2) bst[tid] = 0u;
    __syncthreads();
    mod_phase(a, lds, bid, G, tid);
    convert_weights(a, 0, gw, NGW, lane, scr);
    grid.sync();
    const XcdBarrier xb = xcd_barrier_post(barw, bst);
#define GSYNC() xcd_barrier(xb)
    row_phase<false, true>(bid, G, MTOT, a.in[I_X], a.in[I_CTX], nullptr, nullptr, nullptr, nullptr, nullptr, 0, nullptr, a.in[I_GPRE1], mod, 0, 2048, H, ws + WS_H8, lds);
    GSYNC();
    for (int l = 0; l < 2; ++l) {
        const bool ctx_out = (l == 0);
        const int nMr = ctx_out ? MTOT / 256 : NLAT / 256;
        const float* modL = mod + (size_t)l * 9 * MODW;
        { pg8::TileSched S; S.nM = ctx_out ? MTOT / 256 : NLAT / 256; S.nN = 23; S.nwg = S.nM * S.nN; S.G = G; S.c = bid; S.nsub = 1; S.A = (const char*)H; S.B = (const char*)(ws + WS_WIN);
          S.aT = (size_t)256 * DM * 2; S.bT = (size_t)256 * DM * 2; S.aS = 0; S.bS = 0; S.nx = ctx_out ? 0 : 104;
          S.pn_split = 16; S.pn_skip = 24; S.pn_boff = 0;
          pg8::EpiZ E{Z}; pg8::gemm_phase(ldsl, DM, DM, DM, S, E); }
        { pg8::TileSched S; S.nM = ctx_out ? MTOT / 256 : NLAT / 256; S.nN = 24; S.nwg = S.nM * S.nN; S.G = G; S.c = bid; S.nsub = 1; S.A = (const char*)(ws + WS_H8); S.B = (const char*)(ws + WS_WG8);
          S.aT = (size_t)256 * DM; S.bT = (size_t)256 * DM; S.aS = 0; S.bS = 0; S.nx = 0; S.pn_split = 0; S.pn_skip = 16; S.pn_boff = 16;
          pg8::EpiZ8 E{Z}; pg8::gemm_phase<true>(ldsl, DM / 2, DM / 2, DM / 2, S, E); }
        GSYNC();
        prep_phase(a, l, gw, NGW, lane);
        GSYNC();
        { pg8::DualSched S; S.G = G; S.c = bid; S.n0 = (MTOT / 256) * 6; S.n1 = (MTOT / 256) * 8; S.nN0 = 6; S.nN1 = 8;
          S.A0 = (const char*)(Z + ZC_CQ); S.A1 = (const char*)(Z + ZC_CKV); S.B0 = (const char*)(ws + WS_WUQ); S.B1 = (const char*)(ws + WS_WUKV);
          S.aT = (size_t)256 * LDZ * 2; S.bT = (size_t)256 * 512 * 2;
          pg8::EpiQKV E{QC, KVC, LDQC, LDKVC}; pg8::gemm_phase(ldsl, LDZ, 512, 512, S, E); }
        GSYNC();
        attn_phase(a, l, ctx_out, vcu, G, (char*)lds);
        GSYNC();
        { pg8::TileSched S; S.nM = nMr; S.nN = 8; S.nwg = S.nM * S.nN; S.G = G; S.c = bid; S.nsub = 3; S.A = (const char*)O; S.B = (const char*)(ws + WS_WBR);
          S.aT = (size_t)256 * LDO * 2; S.bT = (size_t)256 * 1024 * 2; S.aS = (size_t)1024 * 2; S.bS = (size_t)2048 * 1024 * 2; S.nx = 0; S.pn_split = 1 << 30; S.pn_skip = 0; S.pn_boff = 0;
          pg8::EpiMerge E{Y, Z}; pg8::gemm_phase(ldsl, LDO, 1024, 1024, S, E); }
        GSYNC();
        { pg8::TileSched S; S.nM = NLAT / 256; S.nN = 8; S.nwg = S.nM * S.nN; S.G = G; S.c = bid; S.nsub = 1; S.A = (const char*)Y; S.B = (const char*)(ws + WS_WO);
          S.aT = (size_t)256 * DM * 2; S.bT = (size_t)256 * DM * 2; S.aS = 0; S.bS = 0; S.nx = 0; S.pn_split = 1 << 30; S.pn_skip = 0; S.pn_boff = 0;
          pg8::EpiQKV E{T, T, DM, DM}; pg8::gemm_phase(ldsl, DM, DM, DM, S, E); }
        if (ctx_out) { pg8::CtxSplitSched S; S.G = G; S.c = bid; S.A = (const char*)Y; S.B = (const char*)(ws + WS_WO); S.aT = (size_t)256 * DM * 2; S.bT = (size_t)256 * DM * 2; S.kqB = (size_t)(DM / 4) * 2;
          pg8::EpiSlab E{TP}; pg8::gemm_phase(ldsl, DM, DM, DM / 4, S, E); }
        GSYNC();
        if (l == 0) row_phase<true, true, false, true>(bid, G, MTOT, a.in[I_X], a.in[I_CTX], O, CX, T, ctx_out ? TP : nullptr, modL, 4096, a.in[I_GPOST1] + l * DM,
                              a.in[I_GPRE2] + l * DM, modL, 6144, 8192, H, nullptr, lds);
        else        row_phase<true, true, true, true>(bid, G, NLAT, a.out, a.in[I_CTX], O, CX, T, ctx_out ? TP : nullptr, modL, 4096, a.in[I_GPOST1] + l * DM,
                              a.in[I_GPRE2] + l * DM, modL, 6144, 8192, H, nullptr, lds);
        GSYNC();
        { pg8::TileSched S; S.nM = nMr; S.nN = 2 * DFF / 256; S.nwg = S.nM * S.nN; S.G = G; S.c = bid; S.nsub = 1; S.A = (const char*)H; S.B = (const char*)(ws + WS_W13);
          S.aT = (size_t)256 * DM * 2; S.bT = (size_t)256 * DM * 2; S.aS = 0; S.bS = 0; S.nx = 0; S.pn_split = 1 << 30; S.pn_skip = 0; S.pn_boff = 0;
          pg8::EpiSwiglu E{U}; pg8::gemm_phase(ldsl, DM, DM, DM, S, E); }
        GSYNC();
        { pg8::TileSched S; S.nM = NLAT / 256; S.nN = 8; S.nwg = S.nM * S.nN; S.G = G; S.c = bid; S.nsub = 1; S.A = (const char*)U; S.B = (const char*)(ws + WS_W2);
          S.aT = (size_t)256 * DFF * 2; S.bT = (size_t)256 * DFF * 2; S.aS = 0; S.bS = 0; S.nx = 0; S.pn_split = 1 << 30; S.pn_skip = 0; S.pn_boff = 0;
          pg8::EpiQKV E{T, T, DM, DM}; pg8::gemm_phase(ldsl, DFF, DFF, DFF, S, E); }
        if (ctx_out) { pg8::CtxSplitSched S; S.G = G; S.c = bid; S.A = (const char*)U; S.B = (const char*)(ws + WS_W2); S.aT = (size_t)256 * DFF * 2; S.bT = (size_t)256 * DFF * 2; S.kqB = (size_t)(DFF / 4) * 2;
          pg8::EpiSlab E{TP}; pg8::gemm_phase(ldsl, DFF, DFF, DFF / 4, S, E); }
        GSYNC();
        if (l == 0) {
            row_phase<true, true, true, true>(bid, G, MTOT, O, CX, a.out, CX, T, TP, modL, 10240, a.in[I_GPOST2], a.in[I_GPRE1] + DM, mod + (size_t)9 * MODW, 0, 2048, H, ws + WS_H8, lds);
            convert_weights(a, 1, gw, NGW, lane, scr);
            GSYNC();
        } else {
            row_phase<true, false, true, false>(bid, G, NLAT, O, nullptr, a.out, nullptr, T, nullptr, modL, 10240, a.in[I_GPOST2] + DM, nullptr, nullptr, 0, 0, nullptr, nullptr, lds);
        }
    }
}

extern "C" void kernel_launch(void* const* d_in, const int* in_sizes, int n_in, void* d_out, int out_size, void* d_ws, size_t ws_size, hipStream_t stream) {
    static int grid = 0;
    if (grid == 0) {
        if (n_in != 25 || out_size != NLAT * DM || ws_size < WS_END) { fprintf(stderr, "kernel_launch: unexpected shapes: n_in %d out %d ws %zu (need %zu)\n", n_in, out_size, ws_size, (size_t)WS_END); grid = -1; return; }
        int dev = 0, cus = 0, per_cu = 0;
        if (hipGetDevice(&dev) != hipSuccess || hipDeviceGetAttribute(&cus, hipDeviceAttributeMultiprocessorCount, dev) != hipSuccess) { grid = -1; return; }
        if (hipFuncSetAttribute((const void*)fwd_megakernel, hipFuncAttributeMaxDynamicSharedMemorySize, LDS_BYTES) != hipSuccess) { fprintf(stderr, "kernel_launch: hipFuncSetAttribute failed\n"); grid = -1; return; }
        if (hipOccupancyMaxActiveBlocksPerMultiprocessor(&per_cu, (const void*)fwd_megakernel, 512, LDS_BYTES) != hipSuccess || per_cu < 1) { fprintf(stderr, "kernel_launch: occupancy query says %d\n", per_cu); per_cu = 1; }
        (void)hipGetLastError();
        grid = cus * 1;
    }
    if (grid < 0) return;
    Args a{};
    for (int i = 0; i < 25; ++i) a.in[i] = (const float*)d_in[i];
    a.out = (float*)d_out; a.ws = (unsigned char*)d_ws;
    void* args[] = {&a};
    hipError_t e = hipLaunchCooperativeKernel((const void*)fwd_megakernel, dim3(grid), dim3(512), args, LDS_BYTES, stream);
    if (e != hipSuccess) fprintf(stderr, "kernel_launch: cooperative launch failed: %s (grid %d)\n", hipGetErrorString(e), grid);
}
```
